# Optimizing an MI355X kernel written in HIP

```python
import math
import jax, jax.numpy as jnp
from jax import lax
import numpy as np

D_MODEL = 2048
BATCH = 4
SEQ = 4096
DEPTH = 1

HEAD_DIM = 128
A_Q_HEADS = 8
A_KV_HEADS = 2
A_GROUP = A_Q_HEADS // A_KV_HEADS
WINDOW = 128
A_BLOCK = 128
B_HEADS = 8
GRID_W = 64
WIN_H = 8
WIN_W = 16
Q_COL_BLOCK = 16
K_COL_SPAN = Q_COL_BLOCK + WIN_W
D_FF = 5632
CONV_W = 3
ROPE_THETA = 10000.0
EPS = 1e-6
NEG = -1e30

A_Q_DIM = A_Q_HEADS * HEAD_DIM
A_KV_DIM = A_KV_HEADS * HEAD_DIM
B_DIM = B_HEADS * HEAD_DIM
IN_SPLITS = [A_Q_DIM, A_KV_DIM, A_KV_DIM, B_DIM, B_DIM, B_DIM, D_MODEL, D_MODEL]
IN_COLS = sum(IN_SPLITS)

kernel_name = "hybrid_window_gqa_natten_convglu"


def rmsnorm(x, g):
    xf = x.astype(jnp.float32)
    y = xf * lax.rsqrt(jnp.mean(xf * xf, axis=-1, keepdims=True) + EPS)
    return (y * g.astype(jnp.float32)).astype(x.dtype)


def rope(x, pos):
    half = x.shape[-1] // 2
    inv_freq = ROPE_THETA ** (-jnp.arange(half, dtype=jnp.float32) * (2.0 / x.shape[-1]))
    ang = pos[:, None] * inv_freq[None, :]
    cos = jnp.cos(ang)[None, :, None, :]
    sin = jnp.sin(ang)[None, :, None, :]
    xf = x.astype(jnp.float32)
    x1, x2 = xf[..., :half], xf[..., half:]
    return jnp.concatenate([x1 * cos - x2 * sin, x2 * cos + x1 * sin], axis=-1).astype(x.dtype)


def window_attention(q, k, v, sink):
    b, s_len, _, d = q.shape
    nb = s_len // A_BLOCK
    qb = q.reshape(b, nb, A_BLOCK, A_KV_HEADS, A_GROUP, d)
    pad = ((0, 0), (A_BLOCK, A_BLOCK), (0, 0), (0, 0))
    kp = jnp.pad(k, pad).reshape(b, nb + 2, A_BLOCK, A_KV_HEADS, d)
    vp = jnp.pad(v, pad).reshape(b, nb + 2, A_BLOCK, A_KV_HEADS, d)
    kb = jnp.concatenate([kp[:, 0:nb], kp[:, 1:nb + 1], kp[:, 2:nb + 2]], axis=2)
    vb = jnp.concatenate([vp[:, 0:nb], vp[:, 1:nb + 1], vp[:, 2:nb + 2]], axis=2)
    s = jnp.einsum('bnqhgd,bnkhd->bnhgqk', qb, kb,
                   preferred_element_type=jnp.float32) * (1.0 / math.sqrt(d))
    qpos = np.arange(nb)[:, None] * A_BLOCK + np.arange(A_BLOCK)[None, :]
    kpos = (np.arange(nb)[:, None] - 1) * A_BLOCK + np.arange(3 * A_BLOCK)[None, :]
    valid = ((np.abs(qpos[:, :, None] - kpos[:, None, :]) <= WINDOW)
             & (kpos >= 0)[:, None, :] & (kpos < s_len)[:, None, :])
    s = jnp.where(jnp.asarray(valid)[None, :, None, None], s, NEG)
    sink_b = sink.astype(jnp.float32).reshape(A_KV_HEADS, A_GROUP)[None, None, :, :, None, None]
    m = jnp.maximum(jnp.max(s, axis=-1, keepdims=True), sink_b)
    p = jnp.exp(s - m)
    p = p / (jnp.sum(p, axis=-1, keepdims=True) + jnp.exp(sink_b - m))
    o = jnp.einsum('bnhgqk,bnkhd->bnqhgd', p.astype(v.dtype), vb)
    return o.reshape(b, s_len, A_Q_HEADS * d)


def neighbourhood_attention(q, k, v, rpb):
    b, s_len, h, d = q.shape
    rows = s_len // GRID_W
    kh = min(WIN_H, rows)
    rb = kh
    nrb = -(-rows // rb)
    rows_p = nrb * rb
    kspan = min(rb + kh, rows)
    ncb = GRID_W // Q_COL_BLOCK
    nq = rb * Q_COL_BLOCK
    nk = kspan * K_COL_SPAN

    qg = jnp.pad(q.reshape(b, rows, GRID_W, h, d), ((0, 0), (0, rows_p - rows), (0, 0), (0, 0), (0, 0)))
    qb = qg.reshape(b, nrb, rb, ncb, Q_COL_BLOCK, h, d).transpose(0, 1, 3, 2, 4, 5, 6)
    qb = qb.reshape(b, nrb, ncb, nq, h, d)

    r0 = np.arange(nrb) * rb
    krows = np.clip(r0 - kh // 2, 0, rows - kspan)[:, None] + np.arange(kspan)[None, :]
    c0 = np.arange(ncb) * Q_COL_BLOCK
    kcols = np.clip(c0 - WIN_W // 2, 0, GRID_W - K_COL_SPAN)[:, None] + np.arange(K_COL_SPAN)[None, :]

    kg = k.reshape(b, rows, GRID_W, h, d)
    vg = v.reshape(b, rows, GRID_W, h, d)
    ridx = krows[:, None, :, None]
    cidx = kcols[None, :, None, :]
    kb = kg[:, ridx, cidx].reshape(b, nrb, ncb, nk, h, d)
    vb = vg[:, ridx, cidx].reshape(b, nrb, ncb, nk, h, d)

    shp_q = (nrb, ncb, rb, Q_COL_BLOCK)
    shp_k = (nrb, ncb, kspan, K_COL_SPAN)
    qr = np.broadcast_to((r0[:, None] + np.arange(rb)[None, :])[:, None, :, None], shp_q).reshape(nrb, ncb, nq)
    qc = np.broadcast_to((c0[:, None] + np.arange(Q_COL_BLOCK)[None, :])[None, :, None, :], shp_q).reshape(nrb, ncb, nq)
    kr = np.broadcast_to(krows[:, None, :, None], shp_k).reshape(nrb, ncb, nk)
    kc = np.broadcast_to(kcols[None, :, None, :], shp_k).reshape(nrb, ncb, nk)
    qr, qc = qr[..., :, None], qc[..., :, None]
    kr, kc = kr[..., None, :], kc[..., None, :]
    rs = np.clip(qr - kh // 2, 0, rows - kh)
    cs = np.clip(qc - WIN_W // 2, 0, GRID_W - WIN_W)
    valid = (kr >= rs) & (kr < rs + kh) & (kc >= cs) & (kc < cs + WIN_W)
    idx_r = np.clip(kr - qr + WIN_H - 1, 0, 2 * WIN_H - 2).astype(np.int32)
    idx_c = np.clip(kc - qc + WIN_W - 1, 0, 2 * WIN_W - 2).astype(np.int32)
    bias = rpb.astype(jnp.float32)[:, idx_r, idx_c].transpose(1, 2, 0, 3, 4)

    s = jnp.einsum('bncqhd,bnckhd->bnchqk', qb, kb,
                   preferred_element_type=jnp.float32) * (1.0 / math.sqrt(d))
    s = jnp.where(jnp.asarray(valid)[None, :, :, None], s + bias[None], NEG)
    p = jax.nn.softmax(s, axis=-1)
    o = jnp.einsum('bnchqk,bnckhd->bncqhd', p.astype(v.dtype), vb)
    o = o.reshape(b, nrb, ncb, rb, Q_COL_BLOCK, h, d).transpose(0, 1, 3, 2, 4, 5, 6)
    o = o.reshape(b, rows_p, GRID_W, h * d)[:, :rows]
    return o.reshape(b, s_len, h * d)


def setup_inputs(seed: int = 0) -> dict:
    key = jax.random.key(seed)
    ks = jax.random.split(key, 20)
    f32 = jnp.float32

    def nrm(k, shape, scale):
        return jax.random.normal(k, shape, f32) * scale

    L = DEPTH
    return {
        "x": jax.random.normal(ks[0], (BATCH, SEQ, D_MODEL), f32),
        "norm_mix": 1.0 + nrm(ks[1], (L, D_MODEL), 0.02),
        "w_in": nrm(ks[2], (L, D_MODEL, IN_COLS), D_MODEL ** -0.5),
        "a_q_norm": 1.0 + nrm(ks[3], (L, HEAD_DIM), 0.02),
        "a_k_norm": 1.0 + nrm(ks[4], (L, HEAD_DIM), 0.02),
        "a_sink": nrm(ks[5], (L, A_Q_HEADS), 0.5),
        "b_q_norm": 1.0 + nrm(ks[6], (L, HEAD_DIM), 0.02),
        "b_k_norm": 1.0 + nrm(ks[7], (L, HEAD_DIM), 0.02),
        "b_rpb": nrm(ks[8], (L, B_HEADS, 2 * WIN_H - 1, 2 * WIN_W - 1), 0.1),
        "w_branch_a": nrm(ks[9], (L, A_Q_DIM, D_MODEL), A_Q_DIM ** -0.5),
        "w_branch_b": nrm(ks[10], (L, B_DIM, D_MODEL), B_DIM ** -0.5),
        "w_out": nrm(ks[11], (L, D_MODEL, D_MODEL), D_MODEL ** -0.5),
        "norm_ffn": 1.0 + nrm(ks[12], (L, D_MODEL), 0.02),
        "w_up": nrm(ks[13], (L, D_MODEL, 2 * D_FF), D_MODEL ** -0.5),
        "conv_w": nrm(ks[14], (L, CONV_W, 2 * D_FF), CONV_W ** -0.5),
        "conv_b": nrm(ks[15], (L, 2 * D_FF), 0.01),
        "w_down": nrm(ks[16], (L, D_FF, D_MODEL), D_FF ** -0.5),
    }


def reference(x, norm_mix, w_in, a_q_norm, a_k_norm, a_sink, b_q_norm, b_k_norm, b_rpb,
              w_branch_a, w_branch_b, w_out, norm_ffn, w_up, conv_w, conv_b, w_down):
    b, s_len, _ = x.shape
    pos = jnp.arange(s_len, dtype=jnp.float32)
    split_points = np.cumsum(IN_SPLITS)[:-1].tolist()
    for l in range(DEPTH):
        h = rmsnorm(x, norm_mix[l])
        proj = h @ w_in[l]
        qa, ka, va, qb, kb, vb, ga, gb = jnp.split(proj, split_points, axis=-1)

        qa = rope(rmsnorm(qa.reshape(b, s_len, A_Q_HEADS, HEAD_DIM), a_q_norm[l]), pos)
        ka = rope(rmsnorm(ka.reshape(b, s_len, A_KV_HEADS, HEAD_DIM), a_k_norm[l]), pos)
        va = va.reshape(b, s_len, A_KV_HEADS, HEAD_DIM)
        out_a = window_attention(qa, ka, va, a_sink[l])

        qb = rmsnorm(qb.reshape(b, s_len, B_HEADS, HEAD_DIM), b_q_norm[l])
        kb = rmsnorm(kb.reshape(b, s_len, B_HEADS, HEAD_DIM), b_k_norm[l])
        vb = vb.reshape(b, s_len, B_HEADS, HEAD_DIM)
        out_b = neighbourhood_attention(qb, kb, vb, b_rpb[l])

        merged = (jax.nn.sigmoid(ga) * (out_a @ w_branch_a[l])
                  + jax.nn.sigmoid(gb) * (out_b @ w_branch_b[l]))
        x = x + merged @ w_out[l]

        h2 = rmsnorm(x, norm_ffn[l])
        u = h2 @ w_up[l]
        up = jnp.pad(u, ((0, 0), (1, 1), (0, 0)))
        cw = conv_w[l]
        u = up[:, :-2] * cw[0] + up[:, 1:-1] * cw[1] + up[:, 2:] * cw[2] + conv_b[l]
        gate, val = jnp.split(u, 2, axis=-1)
        x = x + (jax.nn.silu(gate) * val) @ w_down[l]
    return x
```

```cpp
#define OPTMASK 31
#define FUSED 1
#define PROBE 0
#include <hip/hip_runtime.h>
#include <cstdint>
#include <cstdio>

typedef unsigned short bf16_t;
typedef float f32x4 __attribute__((ext_vector_type(4)));
typedef unsigned u32x4 __attribute__((ext_vector_type(4)));
typedef unsigned u32x2 __attribute__((ext_vector_type(2)));

constexpr int BATCH = 4, SEQ = 4096, DM = 2048, M = BATCH * SEQ;
constexpr int HD = 128, AQH = 8, AKVH = 2, BH = 8;
constexpr int NQKV = 4608, NGATE = 4096, NIN = NQKV + NGATE;
constexpr int C_QA = 0, C_KA = 1024, C_VA = 1280, C_QB = 1536, C_KB = 2560, C_VB = 3584;
constexpr int DFF = 5632, NUP = 2 * DFF;
constexpr int GW = 64, GROWS = SEQ / GW;
constexpr float EPS = 1e-6f;

constexpr size_t MiB = 1u << 20;
constexpr size_t WS_CTL = 0;
constexpr size_t WS_ROPE = 1 * MiB;
constexpr size_t WS_SSQ = 3 * MiB;
constexpr size_t WS_NORMS = 3 * MiB + 768 * 1024;
constexpr size_t WS_HALO = 4 * MiB;
constexpr size_t WS_W = 16 * MiB;
constexpr size_t WS_QKV = 132 * MiB;
constexpr size_t WS_G = 276 * MiB;
constexpr size_t WS_MG = 132 * MiB;
constexpr size_t WS_ACT = 132 * MiB;
constexpr size_t WS_X1B = 340 * MiB;
constexpr size_t WS_UCH = 404 * MiB;
constexpr size_t WS_END = 492 * MiB;

__device__ __forceinline__ float bf2f(bf16_t v) { return __uint_as_float((unsigned)v << 16); }
__device__ __forceinline__ bf16_t f2bf(float f) { unsigned u = __float_as_uint(f); return (bf16_t)((u + 0x7fffu + ((u >> 16) & 1u)) >> 16); }
__device__ __forceinline__ float wave_sum(float v) {
#pragma unroll
    for (int o = 1; o < 64; o <<= 1) v += __shfl_xor(v, o);
    return v;
}
__device__ __forceinline__ float wave_max(float v) {
#pragma unroll
    for (int o = 1; o < 64; o <<= 1) v = fmaxf(v, __shfl_xor(v, o));
    return v;
}

namespace nv {

__global__ void k_rope_table(float* tab) {
    const int idx = blockIdx.x * blockDim.x + threadIdx.x;
    if (idx >= SEQ * 64) return;
    const int pos = idx >> 6, j = idx & 63;
    const double inv = exp2(-(double)j * (1.0 / 64.0) * 13.287712379549449);
    const double ang = (double)pos * inv;
    const double TWO_PI = 6.283185307179586476925286766559;
    const double k = rint(ang / TWO_PI);
    const float r = (float)(ang - k * TWO_PI);
    tab[idx] = cosf(r);
    tab[SEQ * 64 + idx] = sinf(r);
}

__global__ void k_rmsnorm_rows(const float* __restrict__ x, const float* __restrict__ g, bf16_t* __restrict__ out, int rows) {
    const int lane = threadIdx.x & 63, wpb = blockDim.x >> 6;
    for (int r = blockIdx.x * wpb + (threadIdx.x >> 6); r < rows; r += gridDim.x * wpb) {
        const f32x4* xr = (const f32x4*)(x + (size_t)r * DM) + lane;
        f32x4 v[8]; float s = 0.f;
#pragma unroll
        for (int j = 0; j < 8; ++j) { v[j] = xr[64 * j]; s += v[j].x * v[j].x + v[j].y * v[j].y + v[j].z * v[j].z + v[j].w * v[j].w; }
        const float rs = rsqrtf(wave_sum(s) * (1.f / DM) + EPS);
#pragma unroll
        for (int j = 0; j < 8; ++j) {
            const f32x4 gv = ((const f32x4*)g)[lane + 64 * j];
            u32x2 o; o.x = (unsigned)f2bf(v[j].x * rs * gv.x) | ((unsigned)f2bf(v[j].y * rs * gv.y) << 16);
            o.y = (unsigned)f2bf(v[j].z * rs * gv.z) | ((unsigned)f2bf(v[j].w * rs * gv.w) << 16);
            ((u32x2*)(out + (size_t)r * DM))[lane + 64 * j] = o;
        }
    }
}

struct NEpi { bf16_t* Cb; const bf16_t* gate; const float* resid; float* Cf; int mode, ldc, ldg, ldf; };
static inline NEpi mk_epi(int mode, bf16_t* Cb, int ldc, const bf16_t* gate, int ldg, const float* resid, float* Cf, int ldf) { NEpi e{}; e.Cb = Cb; e.gate = gate; e.resid = resid; e.Cf = Cf; e.mode = mode; e.ldc = ldc; e.ldg = ldg; e.ldf = ldf; return e; }
__global__ void __launch_bounds__(256) k_ngemm(const bf16_t* __restrict__ A, int lda, const float* __restrict__ W, int ldw, int Mr, int N, int K, NEpi E) {
    __shared__ float As[16][68];
    __shared__ float Bs[16][68];
    const int tid = threadIdx.x, tx = tid & 15, ty = tid >> 4;
    const int ntn = N / 64, ntm = Mr / 64;
    for (int tile = blockIdx.x; tile < ntn * ntm; tile += gridDim.x) {
        const int tm = tile / ntn, tn = tile % ntn;
        float acc[4][4];
#pragma unroll
        for (int i = 0; i < 4; ++i)
#pragma unroll
            for (int j = 0; j < 4; ++j) acc[i][j] = 0.f;
        const int ar = tid >> 2, ak = (tid & 3) * 4;
        const int bk = tid >> 4, bn = (tid & 15) * 4;
        const bf16_t* Ap = A + (size_t)(tm * 64 + ar) * lda + ak;
        const float* Wp = W + (size_t)bk * ldw + tn * 64 + bn;
        for (int k0 = 0; k0 < K; k0 += 16) {
            const u32x2 av = *(const u32x2*)(Ap + k0);
            const f32x4 wv = *(const f32x4*)(Wp + (size_t)k0 * ldw);
            __syncthreads();
            As[ak + 0][ar] = __uint_as_float(av.x << 16); As[ak + 1][ar] = __uint_as_float(av.x & 0xffff0000u);
            As[ak + 2][ar] = __uint_as_float(av.y << 16); As[ak + 3][ar] = __uint_as_float(av.y & 0xffff0000u);
            *(f32x4*)&Bs[bk][bn] = wv;
            __syncthreads();
#pragma unroll
            for (int k = 0; k < 16; ++k) {
                const f32x4 a = *(const f32x4*)&As[k][ty * 4];
                const f32x4 b = *(const f32x4*)&Bs[k][tx * 4];
#pragma unroll
                for (int i = 0; i < 4; ++i)
#pragma unroll
                    for (int j = 0; j < 4; ++j) acc[i][j] = fmaf(a[i], b[j], acc[i][j]);
            }
        }
#pragma unroll
        for (int i = 0; i < 4; ++i) {
            const int row = tm * 64 + ty * 4 + i, col = tn * 64 + tx * 4;
#pragma unroll
            for (int j = 0; j < 4; ++j) {
                float v = acc[i][j];
                if (E.mode == 0) E.Cb[(size_t)row * E.ldc + col + j] = f2bf(v);
                else if (E.mode == 1) E.Cb[(size_t)row * E.ldc + col + j] = f2bf(v * bf2f(E.gate[(size_t)row * E.ldg + col + j]));
                else if (E.mode == 2) { bf16_t* p = E.Cb + (size_t)row * E.ldc + col + j; *p = f2bf(bf2f(*p) + v * bf2f(E.gate[(size_t)row * E.ldg + col + j])); }
                else E.Cf[(size_t)row * E.ldf + col + j] = E.resid[(size_t)row * E.ldf + col + j] + v;
            }
        }
    }
}

__global__ void k_proj_post(bf16_t* __restrict__ QKV, bf16_t* __restrict__ G, const float* __restrict__ aqn, const float* __restrict__ akn,
                            const float* __restrict__ bqn, const float* __restrict__ bkn, const float* __restrict__ rope, int do_qkv, int do_g) {
    const int lane = threadIdx.x & 63, wpb = blockDim.x >> 6;
    for (int r = blockIdx.x * wpb + (threadIdx.x >> 6); r < M; r += gridDim.x * wpb) {
        const int pos = r % SEQ;
        bf16_t* q = QKV + (size_t)r * NQKV;
        const float cs = rope[pos * 64 + lane], sn = rope[SEQ * 64 + pos * 64 + lane];
        for (int h = 0; h < (do_qkv ? 36 : 0); ++h) {
            if ((h >= 10 && h < 12) || h >= 28) continue;
            bf16_t* p = q + h * 128;
            const float x1 = bf2f(p[lane]), x2 = bf2f(p[lane + 64]);
            const float rs = rsqrtf(wave_sum(x1 * x1 + x2 * x2) * (1.f / 128.f) + EPS);
            const float* g = h < 8 ? aqn : h < 10 ? akn : h < 20 ? bqn : bkn;
            const float y1 = x1 * rs * g[lane], y2 = x2 * rs * g[lane + 64];
            if (h < 10) { p[lane] = f2bf(y1 * cs - y2 * sn); p[lane + 64] = f2bf(y2 * cs + y1 * sn); }
            else { p[lane] = f2bf(y1); p[lane + 64] = f2bf(y2); }
        }
        bf16_t* gp = G + (size_t)r * NGATE;
        for (int j = 0; j < (do_g ? NGATE / 64 : 0); ++j) { const float v = bf2f(gp[lane + 64 * j]); gp[lane + 64 * j] = f2bf(1.f / (1.f + __expf(-v))); }
    }
}

__global__ void __launch_bounds__(256) k_attn_a(const bf16_t* __restrict__ QKV, const float* __restrict__ sink, bf16_t* __restrict__ OA) {
    __shared__ float qs[4][128];
    __shared__ float ps[4][320];
    const int lane = threadIdx.x & 63, w = threadIdx.x >> 6;
    for (int item = blockIdx.x * 4 + w; item < M * AQH; item += gridDim.x * 4) {
        const int t = item >> 3, h = item & 7, b = t / SEQ, s = t % SEQ, kvh = h >> 2;
        const bf16_t* q = QKV + (size_t)t * NQKV + C_QA + h * 128;
        qs[w][lane] = bf2f(q[lane]); qs[w][lane + 64] = bf2f(q[lane + 64]);
        const int k0 = s - 128 < 0 ? 0 : s - 128, k1 = s + 128 > SEQ - 1 ? SEQ - 1 : s + 128, nk = k1 - k0 + 1;
        float sc[5]; float mx = -1e30f;
#pragma unroll
        for (int i = 0; i < 5; ++i) {
            const int kk = lane + 64 * i; sc[i] = -1e30f;
            if (kk < nk) {
                const bf16_t* kp = QKV + (size_t)(b * SEQ + k0 + kk) * NQKV + C_KA + kvh * 128;
                float d = 0.f;
                for (int c = 0; c < 16; ++c) { const u32x4 kv = *(const u32x4*)(kp + 8 * c);
#pragma unroll
                    for (int e = 0; e < 4; ++e) { d += qs[w][8 * c + 2 * e] * __uint_as_float(kv[e] << 16) + qs[w][8 * c + 2 * e + 1] * __uint_as_float(kv[e] & 0xffff0000u); } }
                sc[i] = d * 0.08838834764831845f;
            }
            mx = fmaxf(mx, sc[i]);
        }
        const float sk = sink[h];
        mx = fmaxf(wave_max(mx), sk);
        float sum = 0.f;
#pragma unroll
        for (int i = 0; i < 5; ++i) { const int kk = lane + 64 * i; if (kk < nk) { const float p = __expf(sc[i] - mx); ps[w][kk] = p; sum += p; } }
        sum = wave_sum(sum) + __expf(sk - mx);
        const float inv = 1.f / sum;
        float o0 = 0.f, o1 = 0.f;
        const bf16_t* vp = QKV + (size_t)(b * SEQ + k0) * NQKV + C_VA + kvh * 128;
        for (int kk = 0; kk < nk; ++kk) { const float p = ps[w][kk]; o0 += p * bf2f(vp[(size_t)kk * NQKV + lane]); o1 += p * bf2f(vp[(size_t)kk * NQKV + lane + 64]); }
        bf16_t* o = OA + (size_t)t * 1024 + h * 128;
        o[lane] = f2bf(o0 * inv); o[lane + 64] = f2bf(o1 * inv);
    }
}

__global__ void __launch_bounds__(256) k_attn_b(const bf16_t* __restrict__ QKV, const float* __restrict__ rpb, bf16_t* __restrict__ OB) {
    __shared__ float qs[4][128];
    __shared__ float ps[4][128];
    const int lane = threadIdx.x & 63, w = threadIdx.x >> 6;
    for (int item = blockIdx.x * 4 + w; item < M * BH; item += gridDim.x * 4) {
        const int t = item >> 3, h = item & 7, b = t / SEQ, s = t % SEQ, qr = s / GW, qc = s % GW;
        const bf16_t* q = QKV + (size_t)t * NQKV + C_QB + h * 128;
        qs[w][lane] = bf2f(q[lane]); qs[w][lane + 64] = bf2f(q[lane + 64]);
        int rs = qr - 4; rs = rs < 0 ? 0 : (rs > GROWS - 8 ? GROWS - 8 : rs);
        int cs = qc - 8; cs = cs < 0 ? 0 : (cs > GW - 16 ? GW - 16 : cs);
        float sc[2]; float mx = -1e30f;
#pragma unroll
        for (int i = 0; i < 2; ++i) {
            const int kk = lane + 64 * i, kr = rs + (kk >> 4), kc = cs + (kk & 15);
            const bf16_t* kp = QKV + (size_t)(b * SEQ + kr * GW + kc) * NQKV + C_KB + h * 128;
            float d = 0.f;
            for (int c = 0; c < 16; ++c) { const u32x4 kv = *(const u32x4*)(kp + 8 * c);
#pragma unroll
                for (int e = 0; e < 4; ++e) { d += qs[w][8 * c + 2 * e] * __uint_as_float(kv[e] << 16) + qs[w][8 * c + 2 * e + 1] * __uint_as_float(kv[e] & 0xffff0000u); } }
            sc[i] = d * 0.08838834764831845f + rpb[(h * 15 + (kr - qr + 7)) * 31 + (kc - qc + 15)];
            mx = fmaxf(mx, sc[i]);
        }
        mx = wave_max(mx);
        float sum = 0.f;
#pragma unroll
        for (int i = 0; i < 2; ++i) { const float p = __expf(sc[i] - mx); ps[w][lane + 64 * i] = p; sum += p; }
        sum = wave_sum(sum);
        const float inv = 1.f / sum;
        float o0 = 0.f, o1 = 0.f;
        for (int kk = 0; kk < 128; ++kk) {
            const int kr = rs + (kk >> 4), kc = cs + (kk & 15);
            const bf16_t* vp = QKV + (size_t)(b * SEQ + kr * GW + kc) * NQKV + C_VB + h * 128;
            const float p = ps[w][kk]; o0 += p * bf2f(vp[lane]); o1 += p * bf2f(vp[lane + 64]);
        }
        bf16_t* o = OB + (size_t)t * 1024 + h * 128;
        o[lane] = f2bf(o0 * inv); o[lane + 64] = f2bf(o1 * inv);
    }
}

__global__ void k_conv_glu(const bf16_t* __restrict__ U, const float* __restrict__ cw, const float* __restrict__ cb, bf16_t* __restrict__ ACT) {
    const size_t n = (size_t)SEQ * DFF;
    for (size_t idx = (size_t)blockIdx.x * blockDim.x + threadIdx.x; idx < n; idx += (size_t)gridDim.x * blockDim.x) {
        const int s = (int)(idx / DFF), j = (int)(idx % DFF);
        float gt = cb[j], vl = cb[j + DFF];
#pragma unroll
        for (int t = 0; t < 3; ++t) {
            const int ss = s + t - 1;
            if (ss >= 0 && ss < SEQ) { gt += cw[t * NUP + j] * bf2f(U[(size_t)ss * NUP + j]); vl += cw[t * NUP + j + DFF] * bf2f(U[(size_t)ss * NUP + j + DFF]); }
        }
        ACT[(size_t)s * DFF + j] = f2bf(gt / (1.f + __expf(-gt)) * vl);
    }
}

}

namespace pg8 {
#define PG8_LAS __attribute__((address_space(3)))
typedef short bf16x8 __attribute__((ext_vector_type(8)));
constexpr int BM = 256, BK = 64, HALF = 128, HTB = HALF * BK * 2  , STAGE_BYTES = 8 * HTB, NXCD = 8, WGM = 8;

__host__ __device__ __forceinline__ int lds_byte(int r, int c) { const int st = (r >> 4) * 2 + (c >> 5), rr = r & 15, cc = c & 31, ob = rr * 64 + cc * 2; return st * 1024 + (ob ^ (((ob >> 9) & 1) << 5)); }
__host__ __device__ __forceinline__ void stage_rc(int b, int& R, int& C) { const int st = b / 1024, sb = b % 1024, swz = sb ^ (((sb >> 9) & 1) << 5); R = (st >> 1) * 16 + swz / 64; C = (st & 1) * 32 + (swz % 64) / 2; }

struct Unit { int pm, pn, sel; };
struct Gemm { const bf16_t* A; const bf16_t* Bt; const bf16_t* A2; const bf16_t* Bt2; int M, N, K; };

struct StaticOrder {
    int nM, nN, nwg, G, c, pair;
    __host__ __device__ void init(int M, int N, int G_, int c_, int pair_ = 0) { nM = M / BM; nN = N / BM; nwg = nM * nN; G = G_; c = c_; pair = pair_; }
    __host__ __device__ bool next(int i, Unit& u) const {
        const int ii = pair ? (i >> 1) : i; u.sel = pair ? (i & 1) : 0;
        const long L = (long)ii * G + c; if (L >= nwg) return false;
        int wgid = (int)L; { const int q = nwg / NXCD, r = nwg % NXCD, xcd = wgid % NXCD, off = wgid / NXCD; wgid = (xcd < r ? xcd * (q + 1) : r * (q + 1) + (xcd - r) * q) + off; }
        const int nig = WGM * nN, gid = wgid / nig, fm = gid * WGM, gsz = (nM - fm) < WGM ? (nM - fm) : WGM;
        u.pm = fm + ((wgid % nig) % gsz); u.pn = (wgid % nig) / gsz; return true;
    }
};

typedef float f32x2_t __attribute__((ext_vector_type(2))); typedef __bf16 bf16x2_t __attribute__((ext_vector_type(2)));
__device__ __forceinline__ unsigned cvt_pk_bf16(float lo, float hi) { f32x2_t v = {lo, hi}; bf16x2_t b = __builtin_convertvector(v, bf16x2_t); return __builtin_bit_cast(unsigned, b); }
__device__ __forceinline__ u32x4 pack8(const f32x4& a, const f32x4& b) { u32x4 w; w.x = cvt_pk_bf16(a[0], a[1]); w.y = cvt_pk_bf16(a[2], a[3]); w.z = cvt_pk_bf16(b[0], b[1]); w.w = cvt_pk_bf16(b[2], b[3]); return w; }
__device__ __forceinline__ void unpack8(const u32x4& w, f32x4& a, f32x4& b) {
    a[0] = __uint_as_float(w.x << 16); a[1] = __uint_as_float(w.x & 0xffff0000u); a[2] = __uint_as_float(w.y << 16); a[3] = __uint_as_float(w.y & 0xffff0000u);
    b[0] = __uint_as_float(w.z << 16); b[1] = __uint_as_float(w.z & 0xffff0000u); b[2] = __uint_as_float(w.w << 16); b[3] = __uint_as_float(w.w & 0xffff0000u); }
#define PG8_XBAR() do { asm volatile("s_waitcnt lgkmcnt(0)" ::: "memory"); __builtin_amdgcn_s_barrier(); asm volatile("" ::: "memory"); } while (0)


struct EpiProj {
    bf16_t* QKV; bf16_t* G; const float* norms; const float* rope;
    __device__ __forceinline__ void operator()(f32x4 (&acc)[2][2][4][2], const Unit& u, int wr, int wc, int fr, int fq, PG8_LAS unsigned char* xl) const {
        const int pn = u.pn, hd = wc >> 1, w1 = wc & 1;
        const int colt = 128 * hd + 32 * w1 + 8 * fq;
        const int row0 = u.pm * BM + wr * 64 + fr;
        if (pn >= 18) {
            bf16_t* base = G + (size_t)row0 * NGATE + (pn - 18) * 256 + colt;
#pragma unroll
            for (int ai = 0; ai < 2; ++ai)
#pragma unroll
                for (int m = 0; m < 4; ++m) { bf16_t* rowp = base + (size_t)(ai * 128 + m * 16) * NGATE;
#pragma unroll
                    for (int bj = 0; bj < 2; ++bj) { f32x4 v0 = acc[ai][bj][m][0], v1 = acc[ai][bj][m][1];
#pragma unroll
                        for (int e = 0; e < 4; ++e) { v0[e] = __builtin_amdgcn_rcpf(1.f + __builtin_amdgcn_exp2f(-1.4426950408889634f * v0[e])); v1[e] = __builtin_amdgcn_rcpf(1.f + __builtin_amdgcn_exp2f(-1.4426950408889634f * v1[e])); }
                        *(u32x4*)(rowp + 64 * bj) = pack8(v0, v1); } }
            return;
        }
        bf16_t* base = QKV + (size_t)row0 * NQKV + pn * 256 + colt;
        if (pn == 5 || pn >= 14) {
#pragma unroll
            for (int ai = 0; ai < 2; ++ai)
#pragma unroll
                for (int m = 0; m < 4; ++m) { bf16_t* rowp = base + (size_t)(ai * 128 + m * 16) * NQKV;
#pragma unroll
                    for (int bj = 0; bj < 2; ++bj) *(u32x4*)(rowp + 64 * bj) = pack8(acc[ai][bj][m][0], acc[ai][bj][m][1]); }
            return;
        }
        const bool do_rope = pn < 5;
        const float* g = norms + 128 * (pn < 4 ? 0 : pn == 4 ? 1 : pn < 10 ? 2 : 3);
        float ss[2][4];
#pragma unroll
        for (int ai = 0; ai < 2; ++ai)
#pragma unroll
            for (int m = 0; m < 4; ++m) { float s = 0.f;
#pragma unroll
                for (int bj = 0; bj < 2; ++bj)
#pragma unroll
                    for (int n = 0; n < 2; ++n) { const f32x4 v = acc[ai][bj][m][n]; s += (v[0] * v[0] + v[1] * v[1]) + (v[2] * v[2] + v[3] * v[3]); }
                s += __shfl_xor(s, 16); s += __shfl_xor(s, 32); ss[ai][m] = s; }
        PG8_LAS float* X = (PG8_LAS float*)xl;
        if (fq == 0) {
#pragma unroll
            for (int ai = 0; ai < 2; ++ai)
#pragma unroll
                for (int m = 0; m < 4; ++m) X[(ai * 128 + wr * 64 + m * 16 + fr) * 4 + wc] = ss[ai][m];
        }
        PG8_XBAR();
#pragma unroll
        for (int ai = 0; ai < 2; ++ai)
#pragma unroll
            for (int m = 0; m < 4; ++m) ss[ai][m] = __builtin_amdgcn_rsqf((ss[ai][m] + X[(ai * 128 + wr * 64 + m * 16 + fr) * 4 + (wc ^ 1)]) * (1.f / 128.f) + EPS);
        const float* gp = g + 32 * w1 + 8 * fq;
        const f32x4 g00 = *(const f32x4*)(gp), g01 = *(const f32x4*)(gp + 4), g10 = *(const f32x4*)(gp + 64), g11 = *(const f32x4*)(gp + 68);
#pragma unroll
        for (int ai = 0; ai < 2; ++ai)
#pragma unroll
            for (int m = 0; m < 4; ++m) {
                const float r = ss[ai][m];
                f32x4 a0 = acc[ai][0][m][0] * r * g00, a1 = acc[ai][0][m][1] * r * g01, b0 = acc[ai][1][m][0] * r * g10, b1 = acc[ai][1][m][1] * r * g11;
                if (do_rope) {
                    const int pos = (row0 + ai * 128 + m * 16) & (SEQ - 1);
                    const float* cp = rope + (size_t)pos * 64 + 32 * w1 + 8 * fq;
                    const f32x4 c0 = *(const f32x4*)(cp), c1 = *(const f32x4*)(cp + 4), s0 = *(const f32x4*)(cp + SEQ * 64), s1 = *(const f32x4*)(cp + SEQ * 64 + 4);
                    const f32x4 ta0 = a0 * c0 - b0 * s0, tb0 = b0 * c0 + a0 * s0, ta1 = a1 * c1 - b1 * s1, tb1 = b1 * c1 + a1 * s1;
                    a0 = ta0; b0 = tb0; a1 = ta1; b1 = tb1;
                }
                bf16_t* rowp = base + (size_t)(ai * 128 + m * 16) * NQKV;
                *(u32x4*)(rowp) = pack8(a0, a1); *(u32x4*)(rowp + 64) = pack8(b0, b1);
                if (m & 1) asm volatile("" ::: "memory");
            }
    }
};

struct EpiBranch {
    bf16_t* MG; const bf16_t* G;
    __device__ __forceinline__ void operator()(f32x4 (&acc)[2][2][4][2], const Unit& u, int wr, int wc, int fr, int fq, PG8_LAS unsigned char* xl) const {
        const int row0 = u.pm * BM + wr * 64 + fr, colt = u.pn * 256 + 32 * wc + 8 * fq;
#pragma unroll
        for (int ai = 0; ai < 2; ++ai)
#pragma unroll
            for (int m = 0; m < 4; ++m) { const size_t row = (size_t)(row0 + ai * 128 + m * 16);
#pragma unroll
                for (int bj = 0; bj < 2; ++bj) {
                    const u32x4 gw = *(const u32x4*)(G + row * NGATE + u.sel * 2048 + colt + 128 * bj);
                    f32x4 g0, g1; unpack8(gw, g0, g1);
                    f32x4 v0 = acc[ai][bj][m][0] * g0, v1 = acc[ai][bj][m][1] * g1;
                    bf16_t* op = MG + row * DM + colt + 128 * bj;
                    if (u.sel) { const u32x4 ow = *(const u32x4*)op; f32x4 o0, o1; unpack8(ow, o0, o1); v0 += o0; v1 += o1; }
                    *(u32x4*)op = pack8(v0, v1);
                } }
    }
};

struct EpiOut {
    const float* x; float* X1; bf16_t* X1B; float* SSQ;
    __device__ __forceinline__ void operator()(f32x4 (&acc)[2][2][4][2], const Unit& u, int wr, int wc, int fr, int fq, PG8_LAS unsigned char* xl) const {
        const int row0 = u.pm * BM + wr * 64 + fr, colt = u.pn * 256 + 32 * wc + 8 * fq;
        PG8_LAS float* X = (PG8_LAS float*)xl;
#pragma unroll
        for (int ai = 0; ai < 2; ++ai)
#pragma unroll
            for (int m = 0; m < 4; ++m) { const size_t row = (size_t)(row0 + ai * 128 + m * 16); float s = 0.f;
#pragma unroll
                for (int bj = 0; bj < 2; ++bj) {
                    const size_t off = row * DM + colt + 128 * bj;
                    const f32x4 v0 = *(const f32x4*)(x + off) + acc[ai][bj][m][0], v1 = *(const f32x4*)(x + off + 4) + acc[ai][bj][m][1];
                    *(f32x4*)(X1 + off) = v0; *(f32x4*)(X1 + off + 4) = v1;
                    *(u32x4*)(X1B + off) = pack8(v0, v1);
                    s += (v0[0] * v0[0] + v0[1] * v0[1]) + (v0[2] * v0[2] + v0[3] * v0[3]) + (v1[0] * v1[0] + v1[1] * v1[1]) + (v1[2] * v1[2] + v1[3] * v1[3]);
                }
                s += __shfl_xor(s, 16); s += __shfl_xor(s, 32);
                if (fq == 0) X[(ai * 128 + wr * 64 + m * 16 + fr) * 4 + wc] = s; }
        PG8_XBAR();
        if (wc == 0 && fq == 0) {
#pragma unroll
            for (int ai = 0; ai < 2; ++ai)
#pragma unroll
                for (int m = 0; m < 4; ++m) { const int r = ai * 128 + wr * 64 + m * 16 + fr; const f32x4 p = *(const PG8_LAS f32x4*)(X + r * 4);
                    SSQ[(size_t)(u.pm * BM + r) * 8 + u.pn] = (p[0] + p[1]) + (p[2] + p[3]); }
        }
    }
};

struct EpiUp {
    bf16_t* ACT; float* HALO; const float* SSQ; const float* cw; const float* cb;
    __device__ __forceinline__ void operator()(f32x4 (&acc)[2][2][4][2], const Unit& u, int wr, int wc, int fr, int fq, PG8_LAS unsigned char* xl) const {
        const int lane = fq * 16 + fr, wid = wr * 4 + wc;
        const int row0 = u.pm * BM + wr * 64 + fr;
        const int ucol = u.pn * 128 + wc * 32 + 8 * fq;
        PG8_LAS f32x4* E = (PG8_LAS f32x4*)xl;
        PG8_LAS float* CF = (PG8_LAS float*)(xl + 8192);
        {
            const float* src = (wid < 6 ? cw + (size_t)(wid >> 1) * NUP : cb) + (wid & 1) * DFF + u.pn * 128;
            const float c0 = src[lane], c1 = src[lane + 64];
            CF[wid * 128 + lane] = c0; CF[wid * 128 + lane + 64] = c1;
        }
#pragma unroll
        for (int ai = 0; ai < 2; ++ai)
#pragma unroll
            for (int m = 0; m < 4; ++m) { const float* sp = SSQ + (size_t)(row0 + ai * 128 + m * 16) * 8; const f32x4 a = *(const f32x4*)sp, b = *(const f32x4*)(sp + 4);
                const float r = __builtin_amdgcn_rsqf(((a[0] + a[1]) + (a[2] + a[3]) + (b[0] + b[1]) + (b[2] + b[3])) * (1.f / DM) + EPS);
#pragma unroll
                for (int bj = 0; bj < 2; ++bj)
#pragma unroll
                    for (int n = 0; n < 2; ++n) acc[ai][bj][m][n] *= r;
                if (m & 1) asm volatile("" ::: "memory"); }
        if (wr == 0 && fr < 2) {
#pragma unroll
            for (int bj = 0; bj < 2; ++bj)
#pragma unroll
                for (int n = 0; n < 2; ++n) *(f32x4*)(HALO + (size_t)(u.pm * 4 + fr) * NUP + bj * DFF + ucol + 4 * n) = acc[0][bj][0][n];
        }
        if (wr == 1 && fr >= 14) {
#pragma unroll
            for (int bj = 0; bj < 2; ++bj)
#pragma unroll
                for (int n = 0; n < 2; ++n) *(f32x4*)(HALO + (size_t)(u.pm * 4 + fr - 12) * NUP + bj * DFF + ucol + 4 * n) = acc[1][bj][3][n];
        }
        if (fr == 0) {
#pragma unroll
            for (int ai = 0; ai < 2; ++ai)
#pragma unroll
                for (int bj = 0; bj < 2; ++bj)
#pragma unroll
                    for (int n = 0; n < 2; ++n) E[((wid * 2 + ai) * 2 + 0) * 16 + 8 * bj + 4 * n + fq] = acc[ai][bj][0][n];
        }
        if (fr == 15) {
#pragma unroll
            for (int ai = 0; ai < 2; ++ai)
#pragma unroll
                for (int bj = 0; bj < 2; ++bj)
#pragma unroll
                    for (int n = 0; n < 2; ++n) E[((wid * 2 + ai) * 2 + 1) * 16 + 8 * bj + 4 * n + fq] = acc[ai][bj][3][n];
        }
        PG8_XBAR();
        __builtin_amdgcn_sched_barrier(0);
        const int srcR = ((lane & 48) | ((fr + 15) & 15)) * 4, srcL = ((lane & 48) | ((fr + 1) & 15)) * 4;
        const bool f0 = fr == 0, f15 = fr == 15;
        const PG8_LAS float* Ef = (const PG8_LAS float*)E;
        const PG8_LAS float* cfp = CF + 32 * wc + 8 * fq;
#pragma unroll
        for (int n = 0; n < 2; ++n) {
#pragma unroll
            for (int e = 0; e < 4; ++e) {
                float cf[8];
#pragma unroll
                for (int k = 0; k < 8; ++k) cf[k] = cfp[k * 128 + 4 * n + e];
#pragma unroll
                for (int ai = 0; ai < 2; ++ai) {
                    const bool pext = (wr == 0 && ai == 0), next_ext = (wr == 1 && ai == 1);
                    const int pidx = wr == 1 ? (((wid - 4) * 2 + ai) * 2 + 1) * 16 : (((wid + 4) * 2 + 0) * 2 + 1) * 16;
                    const int nidx = wr == 0 ? (((wid + 4) * 2 + ai) * 2 + 0) * 16 : (((wid - 4) * 2 + 1) * 2 + 0) * 16;
                    float o[2][4];
                    float Uv[2][4];
#pragma unroll
                    for (int bj = 0; bj < 2; ++bj)
#pragma unroll
                        for (int m = 0; m < 4; ++m) Uv[bj][m] = acc[ai][bj][m][n][e];
                    asm volatile("" : "+v"(Uv[0][0]), "+v"(Uv[0][1]), "+v"(Uv[0][2]), "+v"(Uv[0][3]), "+v"(Uv[1][0]), "+v"(Uv[1][1]), "+v"(Uv[1][2]), "+v"(Uv[1][3]));
#pragma unroll
                    for (int bj = 0; bj < 2; ++bj) {
                        const float pe = pext ? 0.f : Ef[(pidx + 8 * bj + 4 * n + fq) * 4 + e];
                        const float ne = next_ext ? 0.f : Ef[(nidx + 8 * bj + 4 * n + fq) * 4 + e];
                        float rR[4], rL[4];
#pragma unroll
                        for (int m = 0; m < 4; ++m) {
                            rR[m] = __int_as_float(__builtin_amdgcn_ds_bpermute(srcR, __float_as_int(Uv[bj][m]))); rL[m] = __int_as_float(__builtin_amdgcn_ds_bpermute(srcL, __float_as_int(Uv[bj][m]))); }
#pragma unroll
                        for (int m = 0; m < 4; ++m) {
                            const float pv = f0 ? (m == 0 ? pe : rR[m == 0 ? 0 : m - 1]) : rR[m];
                            const float nx = f15 ? (m == 3 ? ne : rL[m == 3 ? 3 : m + 1]) : rL[m];
                            o[bj][m] = fmaf(cf[bj], pv, fmaf(cf[2 + bj], Uv[bj][m], fmaf(cf[4 + bj], nx, cf[6 + bj])));
                        }
                    }
                    float rs[4];
#pragma unroll
                    for (int m = 0; m < 4; ++m) { const float gt = o[0][m]; rs[m] = gt * __builtin_amdgcn_rcpf(1.f + __builtin_amdgcn_exp2f(-1.4426950408889634f * gt)) * o[1][m]; }
                    asm volatile("" : "+v"(rs[0]), "+v"(rs[1]), "+v"(rs[2]), "+v"(rs[3]));
#pragma unroll
                    for (int m = 0; m < 4; ++m) acc[ai][0][m][n][e] = rs[m];
                    __builtin_amdgcn_sched_barrier(0);
                }
            }
        }
#pragma unroll
        for (int ai = 0; ai < 2; ++ai)
#pragma unroll
            for (int m = 0; m < 4; ++m) { *(u32x4*)(ACT + (size_t)(row0 + ai * 128 + m * 16) * DFF + ucol) = pack8(acc[ai][0][m][0], acc[ai][0][m][1]);
                if (m & 1) asm volatile("" ::: "memory"); }
    }
};

struct EpiDown {
    float* out;
    __device__ __forceinline__ void operator()(f32x4 (&acc)[2][2][4][2], const Unit& u, int wr, int wc, int fr, int fq, PG8_LAS unsigned char* xl) const {
        const int row0 = u.pm * BM + wr * 64 + fr, col0 = u.pn * 256 + 32 * wc + 4 * fq;
#pragma unroll
        for (int ai = 0; ai < 2; ++ai)
#pragma unroll
            for (int m = 0; m < 4; ++m) { float* rowp = out + (size_t)(row0 + ai * 128 + m * 16) * DM + col0;
#pragma unroll
                for (int bj = 0; bj < 2; ++bj)
#pragma unroll
                    for (int n = 0; n < 2; ++n) { f32x4* p = (f32x4*)(rowp + 128 * bj + 16 * n); *p = *p + acc[ai][bj][m][n]; } }
    }
};

template <class Epi, class Sched>
__device__ __forceinline__ void gemm_phase(PG8_LAS unsigned char* lds, PG8_LAS unsigned char* xl, const Gemm g, const Sched& S, const Epi& E) {
    const int tid = threadIdx.x, wid = __builtin_amdgcn_readfirstlane(tid >> 6), lane = tid & 63, wr = wid >> 2, wc = wid & 3, fr = lane & 15, fq = lane >> 4;
    const int K = g.K, nt = K / BK;
    unsigned voffA[2];
#pragma unroll
    for (int i = 0; i < 2; ++i) { int R, C; stage_rc(tid * 16 + i * 8192, R, C); voffA[i] = (unsigned)(R * K + C) * 2u; }
    const size_t kstep = (size_t)(BK * 2);
    const size_t hstep = (size_t)HALF * K * 2;
    const size_t tstep = 2 * hstep;
    const unsigned ldsw = (unsigned)wid * 1024u;
    const int aoff = lds_byte(wr * 64 + fr, fq * 8), boff = lds_byte(wc * 32 + fr, fq * 8);
#define PG8_SA(b, h) (((b) * 2 + (h)) * HTB)
#define PG8_SB(b, h) ((4 + (b) * 2 + (h)) * HTB)
#define PG8_STAGE(bufoff, gbase) do { _Pragma("unroll") for (int _i = 0; _i < 2; ++_i) \
        __builtin_amdgcn_global_load_lds((const unsigned*)((const char*)(gbase) + voffA[_i]), (PG8_LAS unsigned*)(lds + (bufoff) + ldsw + _i * 8192), 16, 0, 0); } while (0)
#define PG8_LDA(dst, b, h) do { _Pragma("unroll") for (int m = 0; m < 4; ++m) _Pragma("unroll") for (int k = 0; k < 2; ++k) dst[m][k] = *(const PG8_LAS bf16x8*)(lds + PG8_SA(b, h) + aoff + m * 2048 + k * 1024); } while (0)
#define PG8_LDB(dst, b, h) do { _Pragma("unroll") for (int n = 0; n < 2; ++n) _Pragma("unroll") for (int k = 0; k < 2; ++k) dst[n][k] = *(const PG8_LAS bf16x8*)(lds + PG8_SB(b, h) + boff + n * 2048 + k * 1024); } while (0)
#define PG8_MMA(ai, bj, At, Bt) do { __builtin_amdgcn_s_setprio(1); _Pragma("unroll") for (int m = 0; m < 4; ++m) _Pragma("unroll") for (int n = 0; n < 2; ++n) _Pragma("unroll") for (int k = 0; k < 2; ++k) \
        acc[ai][bj][m][n] = __builtin_amdgcn_mfma_f32_16x16x32_bf16(Bt[n][k], At[m][k], acc[ai][bj][m][n], 0, 0, 0); __builtin_amdgcn_s_setprio(0); } while (0)
#define PG8_WAIT_V(n) asm volatile("s_waitcnt vmcnt(" #n ")" ::: "memory")
#define PG8_WAIT_L(n) asm volatile("s_waitcnt lgkmcnt(" #n ")" ::: "memory")
#define PG8_BAR __builtin_amdgcn_s_barrier()
#define PG8_SCHED __builtin_amdgcn_sched_barrier(0)
#define PG8_UA(u) ((const char*)((u).sel ? g.A2 : g.A) + (size_t)(u).pm * tstep)
#define PG8_UB(u) ((const char*)((u).sel ? g.Bt2 : g.Bt) + (size_t)(u).pn * tstep)
    Unit cur, nxt; int ui = 0;
    if (!S.next(0, cur)) return;
    f32x4 acc[2][2][4][2];
#pragma unroll
    for (int a = 0; a < 2; ++a)
#pragma unroll
        for (int b = 0; b < 2; ++b)
#pragma unroll
            for (int m = 0; m < 4; ++m)
#pragma unroll
                for (int n = 0; n < 2; ++n) acc[a][b][m][n] = (f32x4){0.f, 0.f, 0.f, 0.f};
    bf16x8 At[4][2], B0[2][2], B1[2][2];
    const char* cA = PG8_UA(cur); const char* cB = PG8_UB(cur);
    PG8_STAGE(PG8_SB(0, 0), cB); PG8_STAGE(PG8_SB(0, 1), cB + hstep); PG8_STAGE(PG8_SA(0, 0), cA); PG8_STAGE(PG8_SA(0, 1), cA + hstep);
    if (wr == 1) PG8_BAR;
    PG8_WAIT_V(2); PG8_BAR;
    PG8_STAGE(PG8_SB(1, 0), cB + kstep); PG8_STAGE(PG8_SA(1, 0), cA + kstep); PG8_STAGE(PG8_SB(1, 1), cB + hstep + kstep);
    PG8_WAIT_V(6); PG8_BAR;
    for (;;) {
        const bool has_next = S.next(ui + 1, nxt);
        const char* nA = has_next ? PG8_UA(nxt) : cA; const char* nB = has_next ? PG8_UB(nxt) : cB;
        for (int t = 0; t < nt; t += 2) {
            const bool last = (t == nt - 2);
            const char* a1 = cA + (size_t)(t + 1) * kstep;
            const char* a2 = last ? nA : cA + (size_t)(t + 2) * kstep; const char* b2 = last ? nB : cB + (size_t)(t + 2) * kstep;
            const char* a3 = a2 + kstep; const char* b3 = b2 + kstep;
            PG8_LDB(B0, 0, 0); PG8_LDB(B1, 0, 1); PG8_SCHED; PG8_LDA(At, 0, 0); PG8_STAGE(PG8_SA(1, 1), a1 + hstep);
            PG8_WAIT_V(8); PG8_WAIT_L(0); PG8_BAR; PG8_MMA(0, 0, At, B0); PG8_MMA(0, 1, At, B1); PG8_BAR; PG8_SCHED;
            PG8_LDA(At, 0, 1); PG8_STAGE(PG8_SB(0, 0), b2); PG8_STAGE(PG8_SB(0, 1), b2 + hstep); PG8_STAGE(PG8_SA(0, 0), a2);
            PG8_WAIT_V(8); PG8_WAIT_L(0); PG8_BAR; PG8_MMA(1, 0, At, B0); PG8_MMA(1, 1, At, B1); PG8_BAR; PG8_SCHED;
            PG8_LDB(B0, 1, 0); PG8_LDB(B1, 1, 1); PG8_SCHED; PG8_LDA(At, 1, 0); PG8_STAGE(PG8_SA(0, 1), a2 + hstep);
            PG8_WAIT_V(8); PG8_WAIT_L(0); PG8_BAR; PG8_MMA(0, 0, At, B0); PG8_MMA(0, 1, At, B1); PG8_BAR; PG8_SCHED;
            PG8_LDA(At, 1, 1); PG8_STAGE(PG8_SB(1, 0), b3); PG8_STAGE(PG8_SB(1, 1), b3 + hstep); PG8_STAGE(PG8_SA(1, 0), a3);
            PG8_WAIT_V(8); PG8_WAIT_L(0); PG8_BAR; PG8_MMA(1, 0, At, B0); PG8_MMA(1, 1, At, B1); PG8_BAR; PG8_SCHED;
        }
        if (wr == 0) PG8_BAR;
        E(acc, cur, wr, wc, fr, fq, xl);
        if (!has_next) break;
#pragma unroll
        for (int a = 0; a < 2; ++a)
#pragma unroll
            for (int b = 0; b < 2; ++b)
#pragma unroll
                for (int m = 0; m < 4; ++m)
#pragma unroll
                    for (int n = 0; n < 2; ++n) acc[a][b][m][n] = (f32x4){0.f, 0.f, 0.f, 0.f};
        cur = nxt; cA = nA; cB = nB; ++ui;
        if (wr == 1) PG8_BAR;
    }
    PG8_WAIT_V(0);
    PG8_BAR;
#undef PG8_SA
#undef PG8_SB
#undef PG8_STAGE
#undef PG8_LDA
#undef PG8_LDB
#undef PG8_MMA
#undef PG8_WAIT_V
#undef PG8_WAIT_L
#undef PG8_BAR
#undef PG8_SCHED
#undef PG8_UA
#undef PG8_UB
}
}

constexpr int NWAVES = 8;
constexpr int N_PHASES = 8;
constexpr int RING_OFF = 0, RING_BYTES = 131072;
constexpr int LDSCTL_OFF = RING_BYTES, MISC_OFF = LDSCTL_OFF + 320, XCH_OFF = RING_BYTES + 1024;
constexpr int LDS_BYTES = 147456;
static_assert(XCH_OFF + 12288 <= LDS_BYTES, "LDS map");
constexpr int CW_BAR = 4096;
constexpr size_t WO_IN = 0, WO_A = (size_t)NIN * DM * 2, WO_B = WO_A + (size_t)DM * 1024 * 2, WO_OUT = WO_B + (size_t)DM * 1024 * 2, WO_UP = WO_OUT + (size_t)DM * DM * 2, WO_DN = WO_UP + (size_t)NUP * DM * 2;
static_assert(WS_W + WO_DN + (size_t)DM * DFF * 2 <= WS_QKV, "weights fit");

#define GAS __attribute__((address_space(1)))
#define LAS __attribute__((address_space(3)))
typedef GAS unsigned gu32;
#define RLX_AGENT __ATOMIC_RELAXED, __HIP_MEMORY_SCOPE_AGENT
#define LDS_WAIT() asm volatile("s_waitcnt lgkmcnt(0)" ::: "memory")

#define XB_TMO      128
#define XB_XCNT(j)  (256  + 64 * (j))
#define XB_XSUB(j)  (1280 + 64 * (j))
#define XB_XGEN(j)  (2304 + 64 * (j))
#define XB_TOP      3328
#define XB_TOPGEN   3392
#define XCD_BAR_WORDS 3456
#define XB_SPIN_CAP (1u << 18)
__device__ __forceinline__ unsigned xb_ld(unsigned* p)              { return __hip_atomic_load(p, __ATOMIC_RELAXED, __HIP_MEMORY_SCOPE_AGENT); }
__device__ __forceinline__ unsigned xb_add(unsigned* p, unsigned v) { return __hip_atomic_fetch_add(p, v, __ATOMIC_RELAXED, __HIP_MEMORY_SCOPE_AGENT); }
__device__ __forceinline__ unsigned xb_xcc_id() { return (unsigned)__builtin_amdgcn_s_getreg((3 << 11) | 20) & 0xFu; }
#define XB_SPIN(cond, bar) do { unsigned _sp = 0; while (cond) { __builtin_amdgcn_s_sleep(1); \
    if ((++_sp & 255u) == 0u) { if (xb_ld(&(bar)[XB_TMO])) break; if (_sp > XB_SPIN_CAP) { atomicAdd(&(bar)[XB_TMO], 1u); break; } } } } while (0)
struct XcdBarrier { unsigned* bar; unsigned x; volatile LAS unsigned* st; };
__device__ __forceinline__ XcdBarrier xcd_barrier_post(unsigned* bar, volatile LAS unsigned* st) {
    XcdBarrier b; b.bar = bar; b.x = xb_xcc_id(); b.st = st;
    if (threadIdx.x == 0) (void)xb_add(&bar[XB_XCNT(b.x)], 1u);
    return b;
}
__device__ __forceinline__ void xcd_barrier_complete(unsigned* bar, unsigned x, unsigned& nloc, unsigned& nx) {
    const unsigned G = gridDim.x * gridDim.y * gridDim.z;
    unsigned sum, cnt, mine, sp = 0u;
    for (;;) {
        sum = 0u; cnt = 0u; mine = 0u;
#pragma unroll
        for (unsigned j = 0; j < 16; ++j) { const unsigned c = xb_ld(&bar[XB_XCNT(j)]); sum += c; cnt += (c > 0u) ? 1u : 0u; mine = (j == x) ? c : mine; }
        if (sum == G) break;
        __builtin_amdgcn_s_sleep(1);
        if ((++sp & 255u) == 0u) { if (xb_ld(&bar[XB_TMO])) break; if (sp > XB_SPIN_CAP) { atomicAdd(&bar[XB_TMO], 1u); break; } }
    }
    nloc = mine > 0u ? mine : 1u; nx = cnt > 0u ? cnt : 1u;
}
__device__ __forceinline__ void xcd_barrier(const XcdBarrier& b) {
    asm volatile("s_waitcnt vmcnt(0)" ::: "memory");
    __syncthreads();
    if (threadIdx.x == 0) {
        unsigned* bar = b.bar;
        __builtin_amdgcn_s_waitcnt(0);
        unsigned nloc = b.st[0], nx = b.st[1];
        if (nloc == 0u) { xcd_barrier_complete(bar, b.x, nloc, nx); b.st[0] = nloc; b.st[1] = nx; }
        const unsigned old = xb_add(&bar[XB_XSUB(b.x)], 1u);
        const unsigned gen = old / nloc;
        if (old + 1u == (gen + 1u) * nloc) {
            __builtin_amdgcn_fence(__ATOMIC_RELEASE, "agent");
            asm volatile("s_waitcnt vmcnt(0)" ::: "memory");
            const unsigned og = xb_add(&bar[XB_TOP], 1u);
            const unsigned tg = og / nx;
            if (og + 1u == (tg + 1u) * nx) xb_add(&bar[XB_TOPGEN], 1u);
            else XB_SPIN(xb_ld(&bar[XB_TOPGEN]) == tg, bar);
            __builtin_amdgcn_fence(__ATOMIC_ACQUIRE, "agent");
            xb_add(&bar[XB_XGEN(b.x)], 1u);
            asm volatile("s_waitcnt vmcnt(0)" ::: "memory");
        } else {
            XB_SPIN(xb_ld(&bar[XB_XGEN(b.x)]) == gen, bar);
            __builtin_amdgcn_fence(__ATOMIC_ACQUIRE, "agent");
            asm volatile("s_waitcnt vmcnt(0)" ::: "memory");
        }
    }
    __syncthreads();
}

__device__ __forceinline__ unsigned pk2(float lo, float hi) { return (unsigned)f2bf(lo) | ((unsigned)f2bf(hi) << 16); }
__device__ __forceinline__ int map_head(int c) { const int cc = c & 255; return (c & ~255) + 128 * ((cc >> 6) & 1) + 32 * (2 * (cc >> 7) + ((cc >> 5) & 1)) + 16 * ((cc >> 2) & 1) + 4 * ((cc >> 3) & 3) + (cc & 3); }
__device__ __forceinline__ int map_p32(int c) { return (c & ~31) + 16 * ((c >> 2) & 1) + 4 * ((c >> 3) & 3) + (c & 3); }
__device__ __forceinline__ int map_up(int c) { const int half = c >= DFF ? 1 : 0, cc = c - half * DFF, j = cc & 127; return 256 * (cc >> 7) + 128 * half + (j & ~31) + 16 * ((j >> 2) & 1) + 4 * ((j >> 3) & 3) + (j & 3); }
template <int MAP>
__device__ __forceinline__ void p0_transpose_item(const float* __restrict__ W, int K, int N, bf16_t* __restrict__ WT, const float* __restrict__ ksc, LAS float* scr, int item, int lane) {
    const int nblk = N / 32, kb = item / nblk, nb = item % nblk, k0 = 64 * kb, n0 = 32 * nb;
#pragma unroll 8
    for (int i = 0; i < 32; ++i) { const int kk = 2 * i + (lane >> 5); float v = W[(size_t)(k0 + kk) * N + n0 + (lane & 31)]; if (ksc) v *= ksc[k0 + kk]; scr[kk * 33 + (lane & 31)] = v; }
    LDS_WAIT(); asm volatile("" ::: "memory");
    const int c = lane & 7;
#pragma unroll
    for (int j = 0; j < 4; ++j) { const int n = (lane >> 3) + 8 * j; const LAS float* s = scr + (8 * c) * 33 + n;
        u32x4 o; o.x = pk2(s[0 * 33], s[1 * 33]); o.y = pk2(s[2 * 33], s[3 * 33]); o.z = pk2(s[4 * 33], s[5 * 33]); o.w = pk2(s[6 * 33], s[7 * 33]);
        const int src = n0 + n; const int dst = MAP == 0 ? map_head(src) : MAP == 1 ? map_p32(src) : MAP == 2 ? map_up(src) : src;
        *(u32x4*)(WT + (size_t)dst * K + k0 + 8 * c) = o; }
    LDS_WAIT(); asm volatile("" ::: "memory");
}

struct Args { const float* in[17]; float* out; unsigned char* ws; int ph_lo, ph_hi, li, pad; };

__device__ __forceinline__ void attn_a_item(const bf16_t* __restrict__ QKV, const float* __restrict__ sink, bf16_t* __restrict__ OA, int item, LAS float* scr, int lane) {
    LAS float* qs = scr; LAS float* ps = scr + 128;
    const int t = item >> 3, h = item & 7, b = t / SEQ, s = t % SEQ, kvh = h >> 2;
    const bf16_t* q = QKV + (size_t)t * NQKV + C_QA + h * 128;
    qs[lane] = bf2f(q[lane]); qs[lane + 64] = bf2f(q[lane + 64]);
    const int k0 = s - 128 < 0 ? 0 : s - 128, k1 = s + 128 > SEQ - 1 ? SEQ - 1 : s + 128, nk = k1 - k0 + 1;
    float sc[5]; float mx = -1e30f;
#pragma unroll
    for (int i = 0; i < 5; ++i) {
        const int kk = lane + 64 * i; sc[i] = -1e30f;
        if (kk < nk) {
            const bf16_t* kp = QKV + (size_t)(b * SEQ + k0 + kk) * NQKV + C_KA + kvh * 128;
            float d = 0.f;
            for (int c = 0; c < 16; ++c) { const u32x4 kv = *(const u32x4*)(kp + 8 * c);
#pragma unroll
                for (int e = 0; e < 4; ++e) { d += qs[8 * c + 2 * e] * __uint_as_float(kv[e] << 16) + qs[8 * c + 2 * e + 1] * __uint_as_float(kv[e] & 0xffff0000u); } }
            sc[i] = d * 0.08838834764831845f;
        }
        mx = fmaxf(mx, sc[i]);
    }
    const float sk = sink[h];
    mx = fmaxf(wave_max(mx), sk);
    float sum = 0.f;
#pragma unroll
    for (int i = 0; i < 5; ++i) { const int kk = lane + 64 * i; if (kk < nk) { const float p = __expf(sc[i] - mx); ps[kk] = p; sum += p; } }
    sum = wave_sum(sum) + __expf(sk - mx);
    const float inv = 1.f / sum;
    float o0 = 0.f, o1 = 0.f;
    const bf16_t* vp = QKV + (size_t)(b * SEQ + k0) * NQKV + C_VA + kvh * 128;
    for (int kk = 0; kk < nk; ++kk) { const float p = ps[kk]; o0 += p * bf2f(vp[(size_t)kk * NQKV + lane]); o1 += p * bf2f(vp[(size_t)kk * NQKV + lane + 64]); }
    bf16_t* o = OA + (size_t)t * 1024 + h * 128;
    o[lane] = f2bf(o0 * inv); o[lane + 64] = f2bf(o1 * inv);
}
__device__ __forceinline__ void attn_b_item(const bf16_t* __restrict__ QKV, const float* __restrict__ rpb, bf16_t* __restrict__ OB, int item, LAS float* scr, int lane) {
    LAS float* qs = scr; LAS float* ps = scr + 128;
    const int t = item >> 3, h = item & 7, b = t / SEQ, s = t % SEQ, qr = s / GW, qc = s % GW;
    const bf16_t* q = QKV + (size_t)t * NQKV + C_QB + h * 128;
    qs[lane] = bf2f(q[lane]); qs[lane + 64] = bf2f(q[lane + 64]);
    int rs = qr - 4; rs = rs < 0 ? 0 : (rs > GROWS - 8 ? GROWS - 8 : rs);
    int cs = qc - 8; cs = cs < 0 ? 0 : (cs > GW - 16 ? GW - 16 : cs);
    float sc[2]; float mx = -1e30f;
#pragma unroll
    for (int i = 0; i < 2; ++i) {
        const int kk = lane + 64 * i, kr = rs + (kk >> 4), kc = cs + (kk & 15);
        const bf16_t* kp = QKV + (size_t)(b * SEQ + kr * GW + kc) * NQKV + C_KB + h * 128;
        float d = 0.f;
        for (int c = 0; c < 16; ++c) { const u32x4 kv = *(const u32x4*)(kp + 8 * c);
#pragma unroll
            for (int e = 0; e < 4; ++e) { d += qs[8 * c + 2 * e] * __uint_as_float(kv[e] << 16) + qs[8 * c + 2 * e + 1] * __uint_as_float(kv[e] & 0xffff0000u); } }
        sc[i] = d * 0.08838834764831845f + rpb[(h * 15 + (kr - qr + 7)) * 31 + (kc - qc + 15)];
        mx = fmaxf(mx, sc[i]);
    }
    mx = wave_max(mx);
    float sum = 0.f;
#pragma unroll
    for (int i = 0; i < 2; ++i) { const float p = __expf(sc[i] - mx); ps[lane + 64 * i] = p; sum += p; }
    sum = wave_sum(sum);
    const float inv = 1.f / sum;
    float o0 = 0.f, o1 = 0.f;
    for (int kk = 0; kk < 128; ++kk) {
        const int kr = rs + (kk >> 4), kc = cs + (kk & 15);
        const bf16_t* vp = QKV + (size_t)(b * SEQ + kr * GW + kc) * NQKV + C_VB + h * 128;
        const float p = ps[kk]; o0 += p * bf2f(vp[lane]); o1 += p * bf2f(vp[lane + 64]);
    }
    bf16_t* o = OB + (size_t)t * 1024 + h * 128;
    o[lane] = f2bf(o0 * inv); o[lane + 64] = f2bf(o1 * inv);
}

__global__ void __launch_bounds__(NWAVES * 64, 2) mk_fwd(Args args) {
    extern __shared__ __attribute__((aligned(16))) unsigned char lds[];
    LAS unsigned char* L = (LAS unsigned char*)lds;
    volatile LAS unsigned* MISC = (volatile LAS unsigned*)(L + MISC_OFF);
    const int tid = threadIdx.x, lane = tid & 63, wave = __builtin_amdgcn_readfirstlane(tid >> 6);
    const int G = gridDim.x; const int bx = blockIdx.x; const int vcu = (G % 8 == 0) ? (bx % 8) * (G / 8) + bx / 8 : bx;
    unsigned char* ws = args.ws;
    gu32* ctl = (gu32*)(ws + WS_CTL);
    const float* x = args.in[0]; float* out = args.out;
    bf16_t* Wt = (bf16_t*)(ws + WS_W);
    bf16_t* Win_t = (bf16_t*)(ws + WS_W + WO_IN); bf16_t* Wa_t = (bf16_t*)(ws + WS_W + WO_A); bf16_t* Wb_t = (bf16_t*)(ws + WS_W + WO_B);
    bf16_t* Wo_t = (bf16_t*)(ws + WS_W + WO_OUT); bf16_t* Wup_t = (bf16_t*)(ws + WS_W + WO_UP); bf16_t* Wdn_t = (bf16_t*)(ws + WS_W + WO_DN);
    float* rope = (float*)(ws + WS_ROPE); float* NORMS = (float*)(ws + WS_NORMS); float* SSQ = (float*)(ws + WS_SSQ); float* HALO = (float*)(ws + WS_HALO);
    bf16_t* QKV = (bf16_t*)(ws + WS_QKV); bf16_t* Gt = (bf16_t*)(ws + WS_G); bf16_t* MG = (bf16_t*)(ws + WS_MG); bf16_t* ACT = (bf16_t*)(ws + WS_ACT); bf16_t* X1B = (bf16_t*)(ws + WS_X1B);
    bf16_t* XN = (bf16_t*)out; bf16_t* OA = (bf16_t*)((unsigned char*)out + 64 * MiB); bf16_t* OB = (bf16_t*)((unsigned char*)out + 96 * MiB);
    (void)Wt;
    for (int u = tid; u < (LDS_BYTES - LDSCTL_OFF) / 4; u += NWAVES * 64) ((LAS unsigned*)(L + LDSCTL_OFF))[u] = 0u;
    __syncthreads();
    const int lo = args.ph_lo, hi = args.ph_hi;
    XcdBarrier bar; bar.bar = (unsigned*)(ctl + CW_BAR) + args.li * XCD_BAR_WORDS; bar.x = 0; bar.st = nullptr;
    if (hi - lo > 1) bar = xcd_barrier_post((unsigned*)(ctl + CW_BAR) + args.li * XCD_BAR_WORDS, MISC + 8);
#ifndef PHMASK
#define PHMASK 255
#endif
#define IN(k) (((PHMASK >> (k)) & 1) && lo <= (k) && (k) < hi)
#define SEAM(k) do { if (IN(k) && IN((k) + 1)) xcd_barrier(bar); } while (0)
    const int gw = vcu * NWAVES + wave, NGW = G * NWAVES;

    if (IN(0)) {
        LAS float* scr = (LAS float*)(L + RING_OFF + wave * 16384);
        constexpr int I_IN = (DM / 64) * (NIN / 32), I_A = (1024 / 64) * (DM / 32), I_O = (DM / 64) * (DM / 32), I_U = (DM / 64) * (NUP / 32), I_D = (DFF / 64) * (DM / 32);
        constexpr int NITEMS = I_IN + 2 * I_A + I_O + I_U + I_D;
        for (int it = gw; it < NITEMS; it += NGW) {
            int r = it;
            if (r < I_IN) { p0_transpose_item<0>(args.in[2], DM, NIN, Win_t, nullptr, scr, r, lane); continue; } r -= I_IN;
            if (r < I_A) { p0_transpose_item<1>(args.in[9], 1024, DM, Wa_t, nullptr, scr, r, lane); continue; } r -= I_A;
            if (r < I_A) { p0_transpose_item<1>(args.in[10], 1024, DM, Wb_t, nullptr, scr, r, lane); continue; } r -= I_A;
            if (r < I_O) { p0_transpose_item<1>(args.in[11], DM, DM, Wo_t, nullptr, scr, r, lane); continue; } r -= I_O;
            if (r < I_U) { p0_transpose_item<2>(args.in[13], DM, NUP, Wup_t, args.in[12], scr, r, lane); continue; } r -= I_U;
            p0_transpose_item<3>(args.in[16], DFF, DM, Wdn_t, nullptr, scr, r, lane);
        }
        if (bx == 0) { const int k = tid >> 7, j = tid & 127; NORMS[tid] = args.in[k == 0 ? 3 : k == 1 ? 4 : k == 2 ? 6 : 7][j]; }
        const float* g = args.in[1];
        for (int m = gw; m < M; m += NGW) {
            const f32x4* xr = (const f32x4*)(x + (size_t)m * DM) + lane;
            f32x4 v[8]; float s = 0.f;
#pragma unroll
            for (int j = 0; j < 8; ++j) { v[j] = xr[64 * j]; s += (v[j].x * v[j].x + v[j].y * v[j].y) + (v[j].z * v[j].z + v[j].w * v[j].w); }
            const float rs = rsqrtf(wave_sum(s) * (1.f / DM) + EPS);
#pragma unroll
            for (int j = 0; j < 8; ++j) { const f32x4 gv = ((const f32x4*)g)[lane + 64 * j];
                u32x2 o; o.x = pk2(v[j].x * rs * gv.x, v[j].y * rs * gv.y); o.y = pk2(v[j].z * rs * gv.z, v[j].w * rs * gv.w);
                ((u32x2*)(XN + (size_t)m * DM))[lane + 64 * j] = o; }
        }
        for (int idx = vcu * (NWAVES * 64) + tid; idx < SEQ * 64; idx += G * NWAVES * 64) {
            const int pos = idx >> 6, j = idx & 63;
            const double inv = exp2(-(double)j * (1.0 / 64.0) * 13.287712379549449);
            const double ang = (double)pos * inv;
            const double TWO_PI = 6.283185307179586476925286766559;
            const double k = rint(ang / TWO_PI);
            const float r = (float)(ang - k * TWO_PI);
            rope[idx] = cosf(r); rope[SEQ * 64 + idx] = sinf(r);
        }
    }
    SEAM(0);
    if (IN(1)) {
        pg8::Gemm g{XN, Win_t, XN, Win_t, M, NIN, DM}; pg8::StaticOrder S; S.init(M, NIN, G, bx);
        pg8::EpiProj E{QKV, Gt, NORMS, rope};
        pg8::gemm_phase(L + RING_OFF, L + XCH_OFF, g, S, E);
    }
    SEAM(1);
    if (IN(2)) {
        LAS float* scr = (LAS float*)(L + RING_OFF + wave * 2048);
        for (int it = gw; it < M * 8; it += NGW) attn_a_item(QKV, args.in[5], OA, it, scr, lane);
        for (int it = gw; it < M * 8; it += NGW) attn_b_item(QKV, args.in[8], OB, it, scr, lane);
    }
    SEAM(2);
    if (IN(3)) {
        pg8::Gemm g{OA, Wa_t, OB, Wb_t, M, DM, 1024}; pg8::StaticOrder S; S.init(M, DM, G, bx, 1);
        pg8::EpiBranch E{MG, Gt};
        pg8::gemm_phase(L + RING_OFF, L + XCH_OFF, g, S, E);
    }
    SEAM(3);
    if (IN(4)) {
        pg8::Gemm g{MG, Wo_t, MG, Wo_t, M, DM, DM}; pg8::StaticOrder S; S.init(M, DM, G, bx);
        pg8::EpiOut E{x, out, X1B, SSQ};
        pg8::gemm_phase(L + RING_OFF, L + XCH_OFF, g, S, E);
    }
    SEAM(4);
    if (IN(5)) {
        pg8::Gemm g{X1B, Wup_t, X1B, Wup_t, M, NUP, DM}; pg8::StaticOrder S; S.init(M, NUP, G, bx);
        pg8::EpiUp E{ACT, HALO, SSQ, args.in[14], args.in[15]};
        pg8::gemm_phase(L + RING_OFF, L + XCH_OFF, g, S, E);
    }
    SEAM(5);
    if (IN(6)) {
        const float* cw = args.in[14]; const float* cb = args.in[15];
        for (int idx = vcu * (NWAVES * 64) + tid; idx < 128 * (DFF / 4); idx += G * NWAVES * 64) {
            const int rr = idx / (DFF / 4), j = (idx % (DFF / 4)) * 4, pm = rr >> 1, side = rr & 1;
            const int row = pm * 256 + (side ? 255 : 0);
            const float* hc = HALO + (size_t)(pm * 4 + (side ? 3 : 0)) * NUP;
            const float* hp = side ? HALO + (size_t)(pm * 4 + 2) * NUP : ((pm & 15) == 0 ? nullptr : HALO + (size_t)((pm - 1) * 4 + 3) * NUP);
            const float* hn = side ? ((pm & 15) == 15 ? nullptr : HALO + (size_t)((pm + 1) * 4 + 0) * NUP) : HALO + (size_t)(pm * 4 + 1) * NUP;
            f32x4 o[2];
#pragma unroll
            for (int bj = 0; bj < 2; ++bj) {
                const int c = bj * DFF + j;
                f32x4 a = *(const f32x4*)(cb + c) + *(const f32x4*)(cw + NUP + c) * *(const f32x4*)(hc + c);
                if (hp) a += *(const f32x4*)(cw + c) * *(const f32x4*)(hp + c);
                if (hn) a += *(const f32x4*)(cw + 2 * NUP + c) * *(const f32x4*)(hn + c);
                o[bj] = a;
            }
            u32x2 w; float r[4];
#pragma unroll
            for (int e = 0; e < 4; ++e) r[e] = o[0][e] / (1.f + __expf(-o[0][e])) * o[1][e];
            w.x = pk2(r[0], r[1]); w.y = pk2(r[2], r[3]);
            *(u32x2*)(ACT + (size_t)row * DFF + j) = w;
        }
    }
    SEAM(6);
    if (IN(7)) {
        pg8::Gemm g{ACT, Wdn_t, ACT, Wdn_t, M, DM, DFF}; pg8::StaticOrder S; S.init(M, DM, G, bx);
        pg8::EpiDown E{out};
        pg8::gemm_phase(L + RING_OFF, L + XCH_OFF, g, S, E);
    }
#undef IN
#undef SEAM
}

#ifndef OPTMASK
#define OPTMASK 31
#endif
#ifndef FUSED
#define FUSED 1
#endif
extern "C" void kernel_launch(void* const* d_in, const int* in_sizes, int n_in, void* d_out, int out_size, void* d_ws, size_t ws_size, hipStream_t stream) {
    if (n_in != 17 || out_size != M * DM || ws_size < WS_END) { fprintf(stderr, "kernel_launch: unexpected shapes (n_in %d out %d ws %zu)\n", n_in, out_size, ws_size); return; }
    static int grid = 0;
    if (grid == 0) {
        int dev = 0, cus = 0, per_cu = 0;
        if (hipGetDevice(&dev) != hipSuccess || hipDeviceGetAttribute(&cus, hipDeviceAttributeMultiprocessorCount, dev) != hipSuccess) { grid = -1; return; }
        if (hipFuncSetAttribute((const void*)mk_fwd, hipFuncAttributeMaxDynamicSharedMemorySize, LDS_BYTES) != hipSuccess) { fprintf(stderr, "kernel_launch: hipFuncSetAttribute failed\n"); grid = -1; return; }
        if (hipOccupancyMaxActiveBlocksPerMultiprocessor(&per_cu, (const void*)mk_fwd, NWAVES * 64, LDS_BYTES) != hipSuccess || per_cu < 1) { fprintf(stderr, "kernel_launch: occupancy query says %d\n", per_cu); }
        (void)hipGetLastError();
        grid = cus;
    }
    if (grid < 0) return;
    const float* x = (const float*)d_in[0]; const float* norm_mix = (const float*)d_in[1]; const float* w_in = (const float*)d_in[2];
    const float* aqn = (const float*)d_in[3]; const float* akn = (const float*)d_in[4]; const float* sink = (const float*)d_in[5];
    const float* bqn = (const float*)d_in[6]; const float* bkn = (const float*)d_in[7]; const float* rpb = (const float*)d_in[8];
    const float* wba = (const float*)d_in[9]; const float* wbb = (const float*)d_in[10]; const float* w_out = (const float*)d_in[11];
    const float* norm_ffn = (const float*)d_in[12]; const float* w_up = (const float*)d_in[13]; const float* conv_w = (const float*)d_in[14];
    const float* conv_b = (const float*)d_in[15]; const float* w_down = (const float*)d_in[16];
    unsigned char* ws = (unsigned char*)d_ws; float* out = (float*)d_out;
    float* rope = (float*)(ws + WS_ROPE);
    bf16_t* QKV = (bf16_t*)(ws + WS_QKV); bf16_t* G = (bf16_t*)(ws + WS_G); bf16_t* MG = (bf16_t*)(ws + WS_MG); bf16_t* ACT = (bf16_t*)(ws + WS_ACT);
    bf16_t* X1B = (bf16_t*)(ws + WS_X1B); bf16_t* UCH = (bf16_t*)(ws + WS_UCH);
    bf16_t* XN = (bf16_t*)d_out; bf16_t* OA = (bf16_t*)((unsigned char*)d_out + 64 * MiB); bf16_t* OB = (bf16_t*)((unsigned char*)d_out + 96 * MiB);
    (void)hipMemsetAsync(ws + WS_CTL, 0, 1 * MiB, stream);
    Args a{};
    for (int i = 0; i < 17; ++i) a.in[i] = (const float*)d_in[i];
    a.out = out; a.ws = ws;
    int li = 0;
#define MK(lo_, hi_) do { a.ph_lo = (lo_); a.ph_hi = (hi_); a.li = li++; hipLaunchKernelGGL(mk_fwd, dim3(grid), dim3(NWAVES * 64), LDS_BYTES, stream, a); } while (0)
    if (FUSED && OPTMASK == 31) { MK(0, N_PHASES); return; }
    if (OPTMASK & 1) { MK(0, 1); MK(1, 2);
#if defined(PROBE) && PROBE == 1
        { nv::NEpi e = nv::mk_epi(0, QKV, NQKV, nullptr, 0, nullptr, nullptr, 0); nv::k_ngemm<<<4096, 256, 0, stream>>>(XN, DM, w_in, NIN, M, NQKV, DM, e); }
        nv::k_proj_post<<<2048, 256, 0, stream>>>(QKV, G, aqn, akn, bqn, bkn, rope, 1, 0);
#elif defined(PROBE) && PROBE == 2
        { nv::NEpi e = nv::mk_epi(0, G, NGATE, nullptr, 0, nullptr, nullptr, 0); nv::k_ngemm<<<4096, 256, 0, stream>>>(XN, DM, w_in + NQKV, NIN, M, NGATE, DM, e); }
        nv::k_proj_post<<<2048, 256, 0, stream>>>(QKV, G, aqn, akn, bqn, bkn, rope, 0, 1);
#endif
    }
    else {
        if (OPTMASK) MK(0, 1);
        nv::k_rope_table<<<SEQ * 64 / 256, 256, 0, stream>>>(rope);
        nv::k_rmsnorm_rows<<<2048, 256, 0, stream>>>(x, norm_mix, XN, M);
        { nv::NEpi e = nv::mk_epi(0, QKV, NQKV, nullptr, 0, nullptr, nullptr, 0); nv::k_ngemm<<<4096, 256, 0, stream>>>(XN, DM, w_in, NIN, M, NQKV, DM, e); }
        { nv::NEpi e = nv::mk_epi(0, G, NGATE, nullptr, 0, nullptr, nullptr, 0); nv::k_ngemm<<<4096, 256, 0, stream>>>(XN, DM, w_in + NQKV, NIN, M, NGATE, DM, e); }
        nv::k_proj_post<<<2048, 256, 0, stream>>>(QKV, G, aqn, akn, bqn, bkn, rope, 1, 1);
    }
    if (OPTMASK & 2) MK(2, 3);
    else { nv::k_attn_a<<<4096, 256, 0, stream>>>(QKV, sink, OA); nv::k_attn_b<<<4096, 256, 0, stream>>>(QKV, rpb, OB); }
    if (OPTMASK & 4) MK(3, 4);
    else {
        { nv::NEpi e = nv::mk_epi(1, MG, DM, G, NGATE, nullptr, nullptr, 0); nv::k_ngemm<<<4096, 256, 0, stream>>>(OA, 1024, wba, DM, M, DM, 1024, e); }
        { nv::NEpi e = nv::mk_epi(2, MG, DM, G + 2048, NGATE, nullptr, nullptr, 0); nv::k_ngemm<<<4096, 256, 0, stream>>>(OB, 1024, wbb, DM, M, DM, 1024, e); }
    }
    if (OPTMASK & 8) { MK(4, 5); MK(5, 6); MK(6, 7); }
    else {
        { nv::NEpi e = nv::mk_epi(3, nullptr, 0, nullptr, 0, x, out, DM); nv::k_ngemm<<<4096, 256, 0, stream>>>(MG, DM, w_out, DM, M, DM, DM, e); }
        nv::k_rmsnorm_rows<<<2048, 256, 0, stream>>>(out, norm_ffn, X1B, M);
        for (int b = 0; b < BATCH; ++b) {
            nv::NEpi e = nv::mk_epi(0, UCH, NUP, nullptr, 0, nullptr, nullptr, 0);
            nv::k_ngemm<<<4096, 256, 0, stream>>>(X1B + (size_t)b * SEQ * DM, DM, w_up, NUP, SEQ, NUP, DM, e);
            nv::k_conv_glu<<<4096, 256, 0, stream>>>(UCH, conv_w, conv_b, ACT + (size_t)b * SEQ * DFF);
        }
    }
    if (OPTMASK & 16) MK(7, 8);
    else { nv::NEpi e = nv::mk_epi(3, nullptr, 0, nullptr, 0, out, out, DM); nv::k_ngemm<<<4096, 256, 0, stream>>>(ACT, DFF, w_down, DM, M, DM, DFF, e); }
#undef MK
}
```

```cpp
#define OPTMASK 31
#define FUSED 1
#define PROBE 0
#define DUP -1
#include <hip/hip_runtime.h>
#include <cstdint>
#include <cstdio>

typedef unsigned short bf16_t;
typedef float f32x4 __attribute__((ext_vector_type(4)));
typedef unsigned u32x4 __attribute__((ext_vector_type(4)));
typedef unsigned u32x2 __attribute__((ext_vector_type(2)));

constexpr int BATCH = 4, SEQ = 4096, DM = 2048, M = BATCH * SEQ;
constexpr int HD = 128, AQH = 8, AKVH = 2, BH = 8;
constexpr int NQKV = 4608, NGATE = 4096, NIN = NQKV + NGATE;
constexpr int C_QA = 0, C_KA = 1024, C_VA = 1280, C_QB = 1536, C_KB = 2560, C_VB = 3584;
constexpr int DFF = 5632, NUP = 2 * DFF;
constexpr int GW = 64, GROWS = SEQ / GW;
constexpr float EPS = 1e-6f;

constexpr size_t MiB = 1u << 20;
constexpr size_t WS_CTL = 0;
constexpr size_t WS_ROPE = 1 * MiB;
constexpr size_t WS_SSQ = 3 * MiB;
constexpr size_t WS_NORMS = 3 * MiB + 768 * 1024;
constexpr size_t WS_HALO = 4 * MiB;
constexpr size_t WS_W = 16 * MiB;
constexpr size_t WS_QKV = 132 * MiB;
constexpr size_t WS_G = 276 * MiB;
constexpr size_t WS_MG = 132 * MiB;
constexpr size_t WS_ACT = 132 * MiB;
constexpr size_t WS_X1B = 340 * MiB;
constexpr size_t WS_UCH = 404 * MiB;
constexpr size_t WS_END = 492 * MiB;

__device__ __forceinline__ float bf2f(bf16_t v) { return __uint_as_float((unsigned)v << 16); }
__device__ __forceinline__ bf16_t f2bf(float f) { unsigned u = __float_as_uint(f); return (bf16_t)((u + 0x7fffu + ((u >> 16) & 1u)) >> 16); }
__device__ __forceinline__ float wave_sum(float v) {
#pragma unroll
    for (int o = 1; o < 64; o <<= 1) v += __shfl_xor(v, o);
    return v;
}
__device__ __forceinline__ float wave_max(float v) {
#pragma unroll
    for (int o = 1; o < 64; o <<= 1) v = fmaxf(v, __shfl_xor(v, o));
    return v;
}

namespace nv {

__global__ void k_rope_table(float* tab) {
    const int idx = blockIdx.x * blockDim.x + threadIdx.x;
    if (idx >= SEQ * 64) return;
    const int pos = idx >> 6, j = idx & 63;
    const double inv = exp2(-(double)j * (1.0 / 64.0) * 13.287712379549449);
    const double ang = (double)pos * inv;
    const double TWO_PI = 6.283185307179586476925286766559;
    const double k = rint(ang / TWO_PI);
    const float r = (float)(ang - k * TWO_PI);
    tab[idx] = cosf(r);
    tab[SEQ * 64 + idx] = sinf(r);
}

__global__ void k_rmsnorm_rows(const float* __restrict__ x, const float* __restrict__ g, bf16_t* __restrict__ out, int rows) {
    const int lane = threadIdx.x & 63, wpb = blockDim.x >> 6;
    for (int r = blockIdx.x * wpb + (threadIdx.x >> 6); r < rows; r += gridDim.x * wpb) {
        const f32x4* xr = (const f32x4*)(x + (size_t)r * DM) + lane;
        f32x4 v[8]; float s = 0.f;
#pragma unroll
        for (int j = 0; j < 8; ++j) { v[j] = xr[64 * j]; s += v[j].x * v[j].x + v[j].y * v[j].y + v[j].z * v[j].z + v[j].w * v[j].w; }
        const float rs = rsqrtf(wave_sum(s) * (1.f / DM) + EPS);
#pragma unroll
        for (int j = 0; j < 8; ++j) {
            const f32x4 gv = ((const f32x4*)g)[lane + 64 * j];
            u32x2 o; o.x = (unsigned)f2bf(v[j].x * rs * gv.x) | ((unsigned)f2bf(v[j].y * rs * gv.y) << 16);
            o.y = (unsigned)f2bf(v[j].z * rs * gv.z) | ((unsigned)f2bf(v[j].w * rs * gv.w) << 16);
            ((u32x2*)(out + (size_t)r * DM))[lane + 64 * j] = o;
        }
    }
}

struct NEpi { bf16_t* Cb; const bf16_t* gate; const float* resid; float* Cf; int mode, ldc, ldg, ldf; };
static inline NEpi mk_epi(int mode, bf16_t* Cb, int ldc, const bf16_t* gate, int ldg, const float* resid, float* Cf, int ldf) { NEpi e{}; e.Cb = Cb; e.gate = gate; e.resid = resid; e.Cf = Cf; e.mode = mode; e.ldc = ldc; e.ldg = ldg; e.ldf = ldf; return e; }
__global__ void __launch_bounds__(256) k_ngemm(const bf16_t* __restrict__ A, int lda, const float* __restrict__ W, int ldw, int Mr, int N, int K, NEpi E) {
    __shared__ float As[16][68];
    __shared__ float Bs[16][68];
    const int tid = threadIdx.x, tx = tid & 15, ty = tid >> 4;
    const int ntn = N / 64, ntm = Mr / 64;
    for (int tile = blockIdx.x; tile < ntn * ntm; tile += gridDim.x) {
        const int tm = tile / ntn, tn = tile % ntn;
        float acc[4][4];
#pragma unroll
        for (int i = 0; i < 4; ++i)
#pragma unroll
            for (int j = 0; j < 4; ++j) acc[i][j] = 0.f;
        const int ar = tid >> 2, ak = (tid & 3) * 4;
        const int bk = tid >> 4, bn = (tid & 15) * 4;
        const bf16_t* Ap = A + (size_t)(tm * 64 + ar) * lda + ak;
        const float* Wp = W + (size_t)bk * ldw + tn * 64 + bn;
        for (int k0 = 0; k0 < K; k0 += 16) {
            const u32x2 av = *(const u32x2*)(Ap + k0);
            const f32x4 wv = *(const f32x4*)(Wp + (size_t)k0 * ldw);
            __syncthreads();
            As[ak + 0][ar] = __uint_as_float(av.x << 16); As[ak + 1][ar] = __uint_as_float(av.x & 0xffff0000u);
            As[ak + 2][ar] = __uint_as_float(av.y << 16); As[ak + 3][ar] = __uint_as_float(av.y & 0xffff0000u);
            *(f32x4*)&Bs[bk][bn] = wv;
            __syncthreads();
#pragma unroll
            for (int k = 0; k < 16; ++k) {
                const f32x4 a = *(const f32x4*)&As[k][ty * 4];
                const f32x4 b = *(const f32x4*)&Bs[k][tx * 4];
#pragma unroll
                for (int i = 0; i < 4; ++i)
#pragma unroll
                    for (int j = 0; j < 4; ++j) acc[i][j] = fmaf(a[i], b[j], acc[i][j]);
            }
        }
#pragma unroll
        for (int i = 0; i < 4; ++i) {
            const int row = tm * 64 + ty * 4 + i, col = tn * 64 + tx * 4;
#pragma unroll
            for (int j = 0; j < 4; ++j) {
                float v = acc[i][j];
                if (E.mode == 0) E.Cb[(size_t)row * E.ldc + col + j] = f2bf(v);
                else if (E.mode == 1) E.Cb[(size_t)row * E.ldc + col + j] = f2bf(v * bf2f(E.gate[(size_t)row * E.ldg + col + j]));
                else if (E.mode == 2) { bf16_t* p = E.Cb + (size_t)row * E.ldc + col + j; *p = f2bf(bf2f(*p) + v * bf2f(E.gate[(size_t)row * E.ldg + col + j])); }
                else E.Cf[(size_t)row * E.ldf + col + j] = E.resid[(size_t)row * E.ldf + col + j] + v;
            }
        }
    }
}

__global__ void k_proj_post(bf16_t* __restrict__ QKV, bf16_t* __restrict__ G, const float* __restrict__ aqn, const float* __restrict__ akn,
                            const float* __restrict__ bqn, const float* __restrict__ bkn, const float* __restrict__ rope, int do_qkv, int do_g) {
    const int lane = threadIdx.x & 63, wpb = blockDim.x >> 6;
    for (int r = blockIdx.x * wpb + (threadIdx.x >> 6); r < M; r += gridDim.x * wpb) {
        const int pos = r % SEQ;
        bf16_t* q = QKV + (size_t)r * NQKV;
        const float cs = rope[pos * 64 + lane], sn = rope[SEQ * 64 + pos * 64 + lane];
        for (int h = 0; h < (do_qkv ? 36 : 0); ++h) {
            if ((h >= 10 && h < 12) || h >= 28) continue;
            bf16_t* p = q + h * 128;
            const float x1 = bf2f(p[lane]), x2 = bf2f(p[lane + 64]);
            const float rs = rsqrtf(wave_sum(x1 * x1 + x2 * x2) * (1.f / 128.f) + EPS);
            const float* g = h < 8 ? aqn : h < 10 ? akn : h < 20 ? bqn : bkn;
            const float y1 = x1 * rs * g[lane], y2 = x2 * rs * g[lane + 64];
            if (h < 10) { p[lane] = f2bf(y1 * cs - y2 * sn); p[lane + 64] = f2bf(y2 * cs + y1 * sn); }
            else { p[lane] = f2bf(y1); p[lane + 64] = f2bf(y2); }
        }
        bf16_t* gp = G + (size_t)r * NGATE;
        for (int j = 0; j < (do_g ? NGATE / 64 : 0); ++j) { const float v = bf2f(gp[lane + 64 * j]); gp[lane + 64 * j] = f2bf(1.f / (1.f + __expf(-v))); }
    }
}

__global__ void __launch_bounds__(256) k_attn_a(const bf16_t* __restrict__ QKV, const float* __restrict__ sink, bf16_t* __restrict__ OA) {
    __shared__ float qs[4][128];
    __shared__ float ps[4][320];
    const int lane = threadIdx.x & 63, w = threadIdx.x >> 6;
    for (int item = blockIdx.x * 4 + w; item < M * AQH; item += gridDim.x * 4) {
        const int t = item >> 3, h = item & 7, b = t / SEQ, s = t % SEQ, kvh = h >> 2;
        const bf16_t* q = QKV + (size_t)t * NQKV + C_QA + h * 128;
        qs[w][lane] = bf2f(q[lane]); qs[w][lane + 64] = bf2f(q[lane + 64]);
        const int k0 = s - 128 < 0 ? 0 : s - 128, k1 = s + 128 > SEQ - 1 ? SEQ - 1 : s + 128, nk = k1 - k0 + 1;
        float sc[5]; float mx = -1e30f;
#pragma unroll
        for (int i = 0; i < 5; ++i) {
            const int kk = lane + 64 * i; sc[i] = -1e30f;
            if (kk < nk) {
                const bf16_t* kp = QKV + (size_t)(b * SEQ + k0 + kk) * NQKV + C_KA + kvh * 128;
                float d = 0.f;
                for (int c = 0; c < 16; ++c) { const u32x4 kv = *(const u32x4*)(kp + 8 * c);
#pragma unroll
                    for (int e = 0; e < 4; ++e) { d += qs[w][8 * c + 2 * e] * __uint_as_float(kv[e] << 16) + qs[w][8 * c + 2 * e + 1] * __uint_as_float(kv[e] & 0xffff0000u); } }
                sc[i] = d * 0.08838834764831845f;
            }
            mx = fmaxf(mx, sc[i]);
        }
        const float sk = sink[h];
        mx = fmaxf(wave_max(mx), sk);
        float sum = 0.f;
#pragma unroll
        for (int i = 0; i < 5; ++i) { const int kk = lane + 64 * i; if (kk < nk) { const float p = __expf(sc[i] - mx); ps[w][kk] = p; sum += p; } }
        sum = wave_sum(sum) + __expf(sk - mx);
        const float inv = 1.f / sum;
        float o0 = 0.f, o1 = 0.f;
        const bf16_t* vp = QKV + (size_t)(b * SEQ + k0) * NQKV + C_VA + kvh * 128;
        for (int kk = 0; kk < nk; ++kk) { const float p = ps[w][kk]; o0 += p * bf2f(vp[(size_t)kk * NQKV + lane]); o1 += p * bf2f(vp[(size_t)kk * NQKV + lane + 64]); }
        bf16_t* o = OA + (size_t)t * 1024 + h * 128;
        o[lane] = f2bf(o0 * inv); o[lane + 64] = f2bf(o1 * inv);
    }
}

__global__ void __launch_bounds__(256) k_attn_b(const bf16_t* __restrict__ QKV, const float* __restrict__ rpb, bf16_t* __restrict__ OB) {
    __shared__ float qs[4][128];
    __shared__ float ps[4][128];
    const int lane = threadIdx.x & 63, w = threadIdx.x >> 6;
    for (int item = blockIdx.x * 4 + w; item < M * BH; item += gridDim.x * 4) {
        const int t = item >> 3, h = item & 7, b = t / SEQ, s = t % SEQ, qr = s / GW, qc = s % GW;
        const bf16_t* q = QKV + (size_t)t * NQKV + C_QB + h * 128;
        qs[w][lane] = bf2f(q[lane]); qs[w][lane + 64] = bf2f(q[lane + 64]);
        int rs = qr - 4; rs = rs < 0 ? 0 : (rs > GROWS - 8 ? GROWS - 8 : rs);
        int cs = qc - 8; cs = cs < 0 ? 0 : (cs > GW - 16 ? GW - 16 : cs);
        float sc[2]; float mx = -1e30f;
#pragma unroll
        for (int i = 0; i < 2; ++i) {
            const int kk = lane + 64 * i, kr = rs + (kk >> 4), kc = cs + (kk & 15);
            const bf16_t* kp = QKV + (size_t)(b * SEQ + kr * GW + kc) * NQKV + C_KB + h * 128;
            float d = 0.f;
            for (int c = 0; c < 16; ++c) { const u32x4 kv = *(const u32x4*)(kp + 8 * c);
#pragma unroll
                for (int e = 0; e < 4; ++e) { d += qs[w][8 * c + 2 * e] * __uint_as_float(kv[e] << 16) + qs[w][8 * c + 2 * e + 1] * __uint_as_float(kv[e] & 0xffff0000u); } }
            sc[i] = d * 0.08838834764831845f + rpb[(h * 15 + (kr - qr + 7)) * 31 + (kc - qc + 15)];
            mx = fmaxf(mx, sc[i]);
        }
        mx = wave_max(mx);
        float sum = 0.f;
#pragma unroll
        for (int i = 0; i < 2; ++i) { const float p = __expf(sc[i] - mx); ps[w][lane + 64 * i] = p; sum += p; }
        sum = wave_sum(sum);
        const float inv = 1.f / sum;
        float o0 = 0.f, o1 = 0.f;
        for (int kk = 0; kk < 128; ++kk) {
            const int kr = rs + (kk >> 4), kc = cs + (kk & 15);
            const bf16_t* vp = QKV + (size_t)(b * SEQ + kr * GW + kc) * NQKV + C_VB + h * 128;
            const float p = ps[w][kk]; o0 += p * bf2f(vp[lane]); o1 += p * bf2f(vp[lane + 64]);
        }
        bf16_t* o = OB + (size_t)t * 1024 + h * 128;
        o[lane] = f2bf(o0 * inv); o[lane + 64] = f2bf(o1 * inv);
    }
}

__global__ void k_conv_glu(const bf16_t* __restrict__ U, const float* __restrict__ cw, const float* __restrict__ cb, bf16_t* __restrict__ ACT) {
    const size_t n = (size_t)SEQ * DFF;
    for (size_t idx = (size_t)blockIdx.x * blockDim.x + threadIdx.x; idx < n; idx += (size_t)gridDim.x * blockDim.x) {
        const int s = (int)(idx / DFF), j = (int)(idx % DFF);
        float gt = cb[j], vl = cb[j + DFF];
#pragma unroll
        for (int t = 0; t < 3; ++t) {
            const int ss = s + t - 1;
            if (ss >= 0 && ss < SEQ) { gt += cw[t * NUP + j] * bf2f(U[(size_t)ss * NUP + j]); vl += cw[t * NUP + j + DFF] * bf2f(U[(size_t)ss * NUP + j + DFF]); }
        }
        ACT[(size_t)s * DFF + j] = f2bf(gt / (1.f + __expf(-gt)) * vl);
    }
}

}

namespace pg8 {
#define PG8_LAS __attribute__((address_space(3)))
typedef short bf16x8 __attribute__((ext_vector_type(8)));
constexpr int BM = 256, BK = 64, HALF = 128, HTB = HALF * BK * 2  , STAGE_BYTES = 8 * HTB, NXCD = 8, WGM = 8;

__host__ __device__ __forceinline__ int lds_byte(int r, int c) { const int st = (r >> 4) * 2 + (c >> 5), rr = r & 15, cc = c & 31, ob = rr * 64 + cc * 2; return st * 1024 + (ob ^ (((ob >> 9) & 1) << 5)); }
__host__ __device__ __forceinline__ void stage_rc(int b, int& R, int& C) { const int st = b / 1024, sb = b % 1024, swz = sb ^ (((sb >> 9) & 1) << 5); R = (st >> 1) * 16 + swz / 64; C = (st & 1) * 32 + (swz % 64) / 2; }

struct Unit { int pm, pn, sel; };
struct Gemm { const bf16_t* A; const bf16_t* Bt; const bf16_t* A2; const bf16_t* Bt2; int M, N, K; };

struct StaticOrder {
    int nM, nN, nwg, G, c, pair;
    __host__ __device__ void init(int M, int N, int G_, int c_, int pair_ = 0) { nM = M / BM; nN = N / BM; nwg = nM * nN; G = G_; c = c_; pair = pair_; }
    __host__ __device__ bool next(int i, Unit& u) const {
        const int ii = pair ? (i >> 1) : i; u.sel = pair ? (i & 1) : 0;
        const long L = (long)ii * G + c; if (L >= nwg) return false;
        int wgid = (int)L; { const int q = nwg / NXCD, r = nwg % NXCD, xcd = wgid % NXCD, off = wgid / NXCD; wgid = (xcd < r ? xcd * (q + 1) : r * (q + 1) + (xcd - r) * q) + off; }
        const int nig = WGM * nN, gid = wgid / nig, fm = gid * WGM, gsz = (nM - fm) < WGM ? (nM - fm) : WGM;
        u.pm = fm + ((wgid % nig) % gsz); u.pn = (wgid % nig) / gsz; return true;
    }
};

typedef float f32x2_t __attribute__((ext_vector_type(2))); typedef __bf16 bf16x2_t __attribute__((ext_vector_type(2)));
__device__ __forceinline__ unsigned cvt_pk_bf16(float lo, float hi) { f32x2_t v = {lo, hi}; bf16x2_t b = __builtin_convertvector(v, bf16x2_t); return __builtin_bit_cast(unsigned, b); }
__device__ __forceinline__ u32x4 pack8(const f32x4& a, const f32x4& b) { u32x4 w; w.x = cvt_pk_bf16(a[0], a[1]); w.y = cvt_pk_bf16(a[2], a[3]); w.z = cvt_pk_bf16(b[0], b[1]); w.w = cvt_pk_bf16(b[2], b[3]); return w; }
__device__ __forceinline__ void unpack8(const u32x4& w, f32x4& a, f32x4& b) {
    a[0] = __uint_as_float(w.x << 16); a[1] = __uint_as_float(w.x & 0xffff0000u); a[2] = __uint_as_float(w.y << 16); a[3] = __uint_as_float(w.y & 0xffff0000u);
    b[0] = __uint_as_float(w.z << 16); b[1] = __uint_as_float(w.z & 0xffff0000u); b[2] = __uint_as_float(w.w << 16); b[3] = __uint_as_float(w.w & 0xffff0000u); }
#define PG8_XBAR() do { asm volatile("s_waitcnt lgkmcnt(0)" ::: "memory"); __builtin_amdgcn_s_barrier(); asm volatile("" ::: "memory"); } while (0)


struct EpiProj {
    bf16_t* QKV; bf16_t* G; const float* norms; const float* rope;
    __device__ __forceinline__ void operator()(f32x4 (&acc)[2][2][4][2], const Unit& u, int wr, int wc, int fr, int fq, PG8_LAS unsigned char* xl) const {
        const int pn = u.pn, hd = wc >> 1, w1 = wc & 1;
        const int colt = 128 * hd + 32 * w1 + 8 * fq;
        const int row0 = u.pm * BM + wr * 64 + fr;
        if (pn >= 18) {
            bf16_t* base = G + (size_t)row0 * NGATE + (pn - 18) * 256 + colt;
#pragma unroll
            for (int ai = 0; ai < 2; ++ai)
#pragma unroll
                for (int m = 0; m < 4; ++m) { bf16_t* rowp = base + (size_t)(ai * 128 + m * 16) * NGATE;
#pragma unroll
                    for (int bj = 0; bj < 2; ++bj) { f32x4 v0 = acc[ai][bj][m][0], v1 = acc[ai][bj][m][1];
#pragma unroll
                        for (int e = 0; e < 4; ++e) { v0[e] = __builtin_amdgcn_rcpf(1.f + __builtin_amdgcn_exp2f(-1.4426950408889634f * v0[e])); v1[e] = __builtin_amdgcn_rcpf(1.f + __builtin_amdgcn_exp2f(-1.4426950408889634f * v1[e])); }
                        *(u32x4*)(rowp + 64 * bj) = pack8(v0, v1); } }
            return;
        }
        bf16_t* base = QKV + (size_t)row0 * NQKV + pn * 256 + colt;
        if (pn == 5 || pn >= 14) {
#pragma unroll
            for (int ai = 0; ai < 2; ++ai)
#pragma unroll
                for (int m = 0; m < 4; ++m) { bf16_t* rowp = base + (size_t)(ai * 128 + m * 16) * NQKV;
#pragma unroll
                    for (int bj = 0; bj < 2; ++bj) *(u32x4*)(rowp + 64 * bj) = pack8(acc[ai][bj][m][0], acc[ai][bj][m][1]); }
            return;
        }
        const bool do_rope = pn < 5;
        const float* g = norms + 128 * (pn < 4 ? 0 : pn == 4 ? 1 : pn < 10 ? 2 : 3);
        float ss[2][4];
#pragma unroll
        for (int ai = 0; ai < 2; ++ai)
#pragma unroll
            for (int m = 0; m < 4; ++m) { float s = 0.f;
#pragma unroll
                for (int bj = 0; bj < 2; ++bj)
#pragma unroll
                    for (int n = 0; n < 2; ++n) { const f32x4 v = acc[ai][bj][m][n]; s += (v[0] * v[0] + v[1] * v[1]) + (v[2] * v[2] + v[3] * v[3]); }
                s += __shfl_xor(s, 16); s += __shfl_xor(s, 32); ss[ai][m] = s; }
        PG8_LAS float* X = (PG8_LAS float*)xl;
        if (fq == 0) {
#pragma unroll
            for (int ai = 0; ai < 2; ++ai)
#pragma unroll
                for (int m = 0; m < 4; ++m) X[(ai * 128 + wr * 64 + m * 16 + fr) * 4 + wc] = ss[ai][m];
        }
        PG8_XBAR();
#pragma unroll
        for (int ai = 0; ai < 2; ++ai)
#pragma unroll
            for (int m = 0; m < 4; ++m) ss[ai][m] = __builtin_amdgcn_rsqf((ss[ai][m] + X[(ai * 128 + wr * 64 + m * 16 + fr) * 4 + (wc ^ 1)]) * (1.f / 128.f) + EPS);
        const float* gp = g + 32 * w1 + 8 * fq;
        const f32x4 g00 = *(const f32x4*)(gp), g01 = *(const f32x4*)(gp + 4), g10 = *(const f32x4*)(gp + 64), g11 = *(const f32x4*)(gp + 68);
#pragma unroll
        for (int ai = 0; ai < 2; ++ai)
#pragma unroll
            for (int m = 0; m < 4; ++m) {
                const float r = ss[ai][m];
                f32x4 a0 = acc[ai][0][m][0] * r * g00, a1 = acc[ai][0][m][1] * r * g01, b0 = acc[ai][1][m][0] * r * g10, b1 = acc[ai][1][m][1] * r * g11;
                if (do_rope) {
                    const int pos = (row0 + ai * 128 + m * 16) & (SEQ - 1);
                    const float* cp = rope + (size_t)pos * 64 + 32 * w1 + 8 * fq;
                    const f32x4 c0 = *(const f32x4*)(cp), c1 = *(const f32x4*)(cp + 4), s0 = *(const f32x4*)(cp + SEQ * 64), s1 = *(const f32x4*)(cp + SEQ * 64 + 4);
                    const f32x4 ta0 = a0 * c0 - b0 * s0, tb0 = b0 * c0 + a0 * s0, ta1 = a1 * c1 - b1 * s1, tb1 = b1 * c1 + a1 * s1;
                    a0 = ta0; b0 = tb0; a1 = ta1; b1 = tb1;
                }
                bf16_t* rowp = base + (size_t)(ai * 128 + m * 16) * NQKV;
                *(u32x4*)(rowp) = pack8(a0, a1); *(u32x4*)(rowp + 64) = pack8(b0, b1);
                if (m & 1) asm volatile("" ::: "memory");
            }
    }
};

struct EpiBranch {
    bf16_t* MG; const bf16_t* G;
    __device__ __forceinline__ void operator()(f32x4 (&acc)[2][2][4][2], const Unit& u, int wr, int wc, int fr, int fq, PG8_LAS unsigned char* xl) const {
        const int row0 = u.pm * BM + wr * 64 + fr, colt = u.pn * 256 + 32 * wc + 8 * fq;
#pragma unroll
        for (int ai = 0; ai < 2; ++ai)
#pragma unroll
            for (int m = 0; m < 4; ++m) { const size_t row = (size_t)(row0 + ai * 128 + m * 16);
#pragma unroll
                for (int bj = 0; bj < 2; ++bj) {
                    const u32x4 gw = *(const u32x4*)(G + row * NGATE + u.sel * 2048 + colt + 128 * bj);
                    f32x4 g0, g1; unpack8(gw, g0, g1);
                    f32x4 v0 = acc[ai][bj][m][0] * g0, v1 = acc[ai][bj][m][1] * g1;
                    bf16_t* op = MG + row * DM + colt + 128 * bj;
                    if (u.sel) { const u32x4 ow = *(const u32x4*)op; f32x4 o0, o1; unpack8(ow, o0, o1); v0 += o0; v1 += o1; }
                    *(u32x4*)op = pack8(v0, v1);
                } }
    }
};

struct EpiOut {
    const float* x; float* X1; bf16_t* X1B; float* SSQ;
    __device__ __forceinline__ void operator()(f32x4 (&acc)[2][2][4][2], const Unit& u, int wr, int wc, int fr, int fq, PG8_LAS unsigned char* xl) const {
        const int row0 = u.pm * BM + wr * 64 + fr, colt = u.pn * 256 + 32 * wc + 8 * fq;
        PG8_LAS float* X = (PG8_LAS float*)xl;
#pragma unroll
        for (int ai = 0; ai < 2; ++ai)
#pragma unroll
            for (int m = 0; m < 4; ++m) { const size_t row = (size_t)(row0 + ai * 128 + m * 16); float s = 0.f;
#pragma unroll
                for (int bj = 0; bj < 2; ++bj) {
                    const size_t off = row * DM + colt + 128 * bj;
                    const f32x4 v0 = *(const f32x4*)(x + off) + acc[ai][bj][m][0], v1 = *(const f32x4*)(x + off + 4) + acc[ai][bj][m][1];
                    *(f32x4*)(X1 + off) = v0; *(f32x4*)(X1 + off + 4) = v1;
                    *(u32x4*)(X1B + off) = pack8(v0, v1);
                    s += (v0[0] * v0[0] + v0[1] * v0[1]) + (v0[2] * v0[2] + v0[3] * v0[3]) + (v1[0] * v1[0] + v1[1] * v1[1]) + (v1[2] * v1[2] + v1[3] * v1[3]);
                }
                s += __shfl_xor(s, 16); s += __shfl_xor(s, 32);
                if (fq == 0) X[(ai * 128 + wr * 64 + m * 16 + fr) * 4 + wc] = s; }
        PG8_XBAR();
        if (wc == 0 && fq == 0) {
#pragma unroll
            for (int ai = 0; ai < 2; ++ai)
#pragma unroll
                for (int m = 0; m < 4; ++m) { const int r = ai * 128 + wr * 64 + m * 16 + fr; const f32x4 p = *(const PG8_LAS f32x4*)(X + r * 4);
                    SSQ[(size_t)(u.pm * BM + r) * 8 + u.pn] = (p[0] + p[1]) + (p[2] + p[3]); }
        }
    }
};

struct EpiUp {
    bf16_t* ACT; float* HALO; const float* SSQ; const float* cw; const float* cb;
    __device__ __forceinline__ void operator()(f32x4 (&acc)[2][2][4][2], const Unit& u, int wr, int wc, int fr, int fq, PG8_LAS unsigned char* xl) const {
        const int lane = fq * 16 + fr, wid = wr * 4 + wc;
        const int row0 = u.pm * BM + wr * 64 + fr;
        const int ucol = u.pn * 128 + wc * 32 + 8 * fq;
        PG8_LAS f32x4* E = (PG8_LAS f32x4*)xl;
        PG8_LAS float* CF = (PG8_LAS float*)(xl + 8192);
        {
            const float* src = (wid < 6 ? cw + (size_t)(wid >> 1) * NUP : cb) + (wid & 1) * DFF + u.pn * 128;
            const float c0 = src[lane], c1 = src[lane + 64];
            CF[wid * 128 + lane] = c0; CF[wid * 128 + lane + 64] = c1;
        }
#pragma unroll
        for (int ai = 0; ai < 2; ++ai)
#pragma unroll
            for (int m = 0; m < 4; ++m) { const float* sp = SSQ + (size_t)(row0 + ai * 128 + m * 16) * 8; const f32x4 a = *(const f32x4*)sp, b = *(const f32x4*)(sp + 4);
                const float r = __builtin_amdgcn_rsqf(((a[0] + a[1]) + (a[2] + a[3]) + (b[0] + b[1]) + (b[2] + b[3])) * (1.f / DM) + EPS);
#pragma unroll
                for (int bj = 0; bj < 2; ++bj)
#pragma unroll
                    for (int n = 0; n < 2; ++n) acc[ai][bj][m][n] *= r;
                if (m & 1) asm volatile("" ::: "memory"); }
        if (wr == 0 && fr < 2) {
#pragma unroll
            for (int bj = 0; bj < 2; ++bj)
#pragma unroll
                for (int n = 0; n < 2; ++n) *(f32x4*)(HALO + (size_t)(u.pm * 4 + fr) * NUP + bj * DFF + ucol + 4 * n) = acc[0][bj][0][n];
        }
        if (wr == 1 && fr >= 14) {
#pragma unroll
            for (int bj = 0; bj < 2; ++bj)
#pragma unroll
                for (int n = 0; n < 2; ++n) *(f32x4*)(HALO + (size_t)(u.pm * 4 + fr - 12) * NUP + bj * DFF + ucol + 4 * n) = acc[1][bj][3][n];
        }
        if (fr == 0) {
#pragma unroll
            for (int ai = 0; ai < 2; ++ai)
#pragma unroll
                for (int bj = 0; bj < 2; ++bj)
#pragma unroll
                    for (int n = 0; n < 2; ++n) E[((wid * 2 + ai) * 2 + 0) * 16 + 8 * bj + 4 * n + fq] = acc[ai][bj][0][n];
        }
        if (fr == 15) {
#pragma unroll
            for (int ai = 0; ai < 2; ++ai)
#pragma unroll
                for (int bj = 0; bj < 2; ++bj)
#pragma unroll
                    for (int n = 0; n < 2; ++n) E[((wid * 2 + ai) * 2 + 1) * 16 + 8 * bj + 4 * n + fq] = acc[ai][bj][3][n];
        }
        PG8_XBAR();
        __builtin_amdgcn_sched_barrier(0);
        const int srcR = ((lane & 48) | ((fr + 15) & 15)) * 4, srcL = ((lane & 48) | ((fr + 1) & 15)) * 4;
        const bool f0 = fr == 0, f15 = fr == 15;
        const PG8_LAS float* Ef = (const PG8_LAS float*)E;
        const PG8_LAS float* cfp = CF + 32 * wc + 8 * fq;
#pragma unroll
        for (int n = 0; n < 2; ++n) {
#pragma unroll
            for (int e = 0; e < 4; ++e) {
                float cf[8];
#pragma unroll
                for (int k = 0; k < 8; ++k) cf[k] = cfp[k * 128 + 4 * n + e];
#pragma unroll
                for (int ai = 0; ai < 2; ++ai) {
                    const bool pext = (wr == 0 && ai == 0), next_ext = (wr == 1 && ai == 1);
                    const int pidx = wr == 1 ? (((wid - 4) * 2 + ai) * 2 + 1) * 16 : (((wid + 4) * 2 + 0) * 2 + 1) * 16;
                    const int nidx = wr == 0 ? (((wid + 4) * 2 + ai) * 2 + 0) * 16 : (((wid - 4) * 2 + 1) * 2 + 0) * 16;
                    float o[2][4];
                    float Uv[2][4];
#pragma unroll
                    for (int bj = 0; bj < 2; ++bj)
#pragma unroll
                        for (int m = 0; m < 4; ++m) Uv[bj][m] = acc[ai][bj][m][n][e];
                    asm volatile("" : "+v"(Uv[0][0]), "+v"(Uv[0][1]), "+v"(Uv[0][2]), "+v"(Uv[0][3]), "+v"(Uv[1][0]), "+v"(Uv[1][1]), "+v"(Uv[1][2]), "+v"(Uv[1][3]));
#pragma unroll
                    for (int bj = 0; bj < 2; ++bj) {
                        const float pe = pext ? 0.f : Ef[(pidx + 8 * bj + 4 * n + fq) * 4 + e];
                        const float ne = next_ext ? 0.f : Ef[(nidx + 8 * bj + 4 * n + fq) * 4 + e];
                        float rR[4], rL[4];
#pragma unroll
                        for (int m = 0; m < 4; ++m) {
                            rR[m] = __int_as_float(__builtin_amdgcn_ds_bpermute(srcR, __float_as_int(Uv[bj][m]))); rL[m] = __int_as_float(__builtin_amdgcn_ds_bpermute(srcL, __float_as_int(Uv[bj][m]))); }
#pragma unroll
                        for (int m = 0; m < 4; ++m) {
                            const float pv = f0 ? (m == 0 ? pe : rR[m == 0 ? 0 : m - 1]) : rR[m];
                            const float nx = f15 ? (m == 3 ? ne : rL[m == 3 ? 3 : m + 1]) : rL[m];
                            o[bj][m] = fmaf(cf[bj], pv, fmaf(cf[2 + bj], Uv[bj][m], fmaf(cf[4 + bj], nx, cf[6 + bj])));
                        }
                    }
                    float rs[4];
#pragma unroll
                    for (int m = 0; m < 4; ++m) { const float gt = o[0][m]; rs[m] = gt * __builtin_amdgcn_rcpf(1.f + __builtin_amdgcn_exp2f(-1.4426950408889634f * gt)) * o[1][m]; }
                    asm volatile("" : "+v"(rs[0]), "+v"(rs[1]), "+v"(rs[2]), "+v"(rs[3]));
#pragma unroll
                    for (int m = 0; m < 4; ++m) acc[ai][0][m][n][e] = rs[m];
                    __builtin_amdgcn_sched_barrier(0);
                }
            }
        }
#pragma unroll
        for (int ai = 0; ai < 2; ++ai)
#pragma unroll
            for (int m = 0; m < 4; ++m) { *(u32x4*)(ACT + (size_t)(row0 + ai * 128 + m * 16) * DFF + ucol) = pack8(acc[ai][0][m][0], acc[ai][0][m][1]);
                if (m & 1) asm volatile("" ::: "memory"); }
    }
};

struct EpiDown {
    float* out;
    __device__ __forceinline__ void operator()(f32x4 (&acc)[2][2][4][2], const Unit& u, int wr, int wc, int fr, int fq, PG8_LAS unsigned char* xl) const {
        const int row0 = u.pm * BM + wr * 64 + fr, col0 = u.pn * 256 + 32 * wc + 4 * fq;
#pragma unroll
        for (int ai = 0; ai < 2; ++ai)
#pragma unroll
            for (int m = 0; m < 4; ++m) { float* rowp = out + (size_t)(row0 + ai * 128 + m * 16) * DM + col0;
#pragma unroll
                for (int bj = 0; bj < 2; ++bj)
#pragma unroll
                    for (int n = 0; n < 2; ++n) { f32x4* p = (f32x4*)(rowp + 128 * bj + 16 * n); *p = *p + acc[ai][bj][m][n]; } }
    }
};

template <class Epi, class Sched>
__device__ __forceinline__ void gemm_phase(PG8_LAS unsigned char* lds, PG8_LAS unsigned char* xl, const Gemm g, const Sched& S, const Epi& E) {
    const int tid = threadIdx.x, wid = __builtin_amdgcn_readfirstlane(tid >> 6), lane = tid & 63, wr = wid >> 2, wc = wid & 3, fr = lane & 15, fq = lane >> 4;
    const int K = g.K, nt = K / BK;
    unsigned voffA[2];
#pragma unroll
    for (int i = 0; i < 2; ++i) { int R, C; stage_rc(tid * 16 + i * 8192, R, C); voffA[i] = (unsigned)(R * K + C) * 2u; }
    const size_t kstep = (size_t)(BK * 2);
    const size_t hstep = (size_t)HALF * K * 2;
    const size_t tstep = 2 * hstep;
    const unsigned ldsw = (unsigned)wid * 1024u;
    const int aoff = lds_byte(wr * 64 + fr, fq * 8), boff = lds_byte(wc * 32 + fr, fq * 8);
#define PG8_SA(b, h) (((b) * 2 + (h)) * HTB)
#define PG8_SB(b, h) ((4 + (b) * 2 + (h)) * HTB)
#define PG8_STAGE(bufoff, gbase) do { _Pragma("unroll") for (int _i = 0; _i < 2; ++_i) \
        __builtin_amdgcn_global_load_lds((const unsigned*)((const char*)(gbase) + voffA[_i]), (PG8_LAS unsigned*)(lds + (bufoff) + ldsw + _i * 8192), 16, 0, 0); } while (0)
#define PG8_LDA(dst, b, h) do { _Pragma("unroll") for (int m = 0; m < 4; ++m) _Pragma("unroll") for (int k = 0; k < 2; ++k) dst[m][k] = *(const PG8_LAS bf16x8*)(lds + PG8_SA(b, h) + aoff + m * 2048 + k * 1024); } while (0)
#define PG8_LDB(dst, b, h) do { _Pragma("unroll") for (int n = 0; n < 2; ++n) _Pragma("unroll") for (int k = 0; k < 2; ++k) dst[n][k] = *(const PG8_LAS bf16x8*)(lds + PG8_SB(b, h) + boff + n * 2048 + k * 1024); } while (0)
#define PG8_MMA(ai, bj, At, Bt) do { __builtin_amdgcn_s_setprio(1); _Pragma("unroll") for (int m = 0; m < 4; ++m) _Pragma("unroll") for (int n = 0; n < 2; ++n) _Pragma("unroll") for (int k = 0; k < 2; ++k) \
        acc[ai][bj][m][n] = __builtin_amdgcn_mfma_f32_16x16x32_bf16(Bt[n][k], At[m][k], acc[ai][bj][m][n], 0, 0, 0); __builtin_amdgcn_s_setprio(0); } while (0)
#define PG8_WAIT_V(n) asm volatile("s_waitcnt vmcnt(" #n ")" ::: "memory")
#define PG8_WAIT_L(n) asm volatile("s_waitcnt lgkmcnt(" #n ")" ::: "memory")
#define PG8_BAR __builtin_amdgcn_s_barrier()
#define PG8_SCHED __builtin_amdgcn_sched_barrier(0)
#define PG8_UA(u) ((const char*)((u).sel ? g.A2 : g.A) + (size_t)(u).pm * tstep)
#define PG8_UB(u) ((const char*)((u).sel ? g.Bt2 : g.Bt) + (size_t)(u).pn * tstep)
    Unit cur, nxt; int ui = 0;
    if (!S.next(0, cur)) return;
    f32x4 acc[2][2][4][2];
#pragma unroll
    for (int a = 0; a < 2; ++a)
#pragma unroll
        for (int b = 0; b < 2; ++b)
#pragma unroll
            for (int m = 0; m < 4; ++m)
#pragma unroll
                for (int n = 0; n < 2; ++n) acc[a][b][m][n] = (f32x4){0.f, 0.f, 0.f, 0.f};
    bf16x8 At[4][2], B0[2][2], B1[2][2];
    const char* cA = PG8_UA(cur); const char* cB = PG8_UB(cur);
    PG8_STAGE(PG8_SB(0, 0), cB); PG8_STAGE(PG8_SB(0, 1), cB + hstep); PG8_STAGE(PG8_SA(0, 0), cA); PG8_STAGE(PG8_SA(0, 1), cA + hstep);
    if (wr == 1) PG8_BAR;
    PG8_WAIT_V(2); PG8_BAR;
    PG8_STAGE(PG8_SB(1, 0), cB + kstep); PG8_STAGE(PG8_SA(1, 0), cA + kstep); PG8_STAGE(PG8_SB(1, 1), cB + hstep + kstep);
    PG8_WAIT_V(6); PG8_BAR;
    for (;;) {
        const bool has_next = S.next(ui + 1, nxt);
        const char* nA = has_next ? PG8_UA(nxt) : cA; const char* nB = has_next ? PG8_UB(nxt) : cB;
        for (int t = 0; t < nt; t += 2) {
            const bool last = (t == nt - 2);
            const char* a1 = cA + (size_t)(t + 1) * kstep;
            const char* a2 = last ? nA : cA + (size_t)(t + 2) * kstep; const char* b2 = last ? nB : cB + (size_t)(t + 2) * kstep;
            const char* a3 = a2 + kstep; const char* b3 = b2 + kstep;
            PG8_LDB(B0, 0, 0); PG8_LDB(B1, 0, 1); PG8_SCHED; PG8_LDA(At, 0, 0); PG8_STAGE(PG8_SA(1, 1), a1 + hstep);
            PG8_WAIT_V(8); PG8_WAIT_L(0); PG8_BAR; PG8_MMA(0, 0, At, B0); PG8_MMA(0, 1, At, B1); PG8_BAR; PG8_SCHED;
            PG8_LDA(At, 0, 1); PG8_STAGE(PG8_SB(0, 0), b2); PG8_STAGE(PG8_SB(0, 1), b2 + hstep); PG8_STAGE(PG8_SA(0, 0), a2);
            PG8_WAIT_V(8); PG8_WAIT_L(0); PG8_BAR; PG8_MMA(1, 0, At, B0); PG8_MMA(1, 1, At, B1); PG8_BAR; PG8_SCHED;
            PG8_LDB(B0, 1, 0); PG8_LDB(B1, 1, 1); PG8_SCHED; PG8_LDA(At, 1, 0); PG8_STAGE(PG8_SA(0, 1), a2 + hstep);
            PG8_WAIT_V(8); PG8_WAIT_L(0); PG8_BAR; PG8_MMA(0, 0, At, B0); PG8_MMA(0, 1, At, B1); PG8_BAR; PG8_SCHED;
            PG8_LDA(At, 1, 1); PG8_STAGE(PG8_SB(1, 0), b3); PG8_STAGE(PG8_SB(1, 1), b3 + hstep); PG8_STAGE(PG8_SA(1, 0), a3);
            PG8_WAIT_V(8); PG8_WAIT_L(0); PG8_BAR; PG8_MMA(1, 0, At, B0); PG8_MMA(1, 1, At, B1); PG8_BAR; PG8_SCHED;
        }
        if (wr == 0) PG8_BAR;
        E(acc, cur, wr, wc, fr, fq, xl);
        if (!has_next) break;
#pragma unroll
        for (int a = 0; a < 2; ++a)
#pragma unroll
            for (int b = 0; b < 2; ++b)
#pragma unroll
                for (int m = 0; m < 4; ++m)
#pragma unroll
                    for (int n = 0; n < 2; ++n) acc[a][b][m][n] = (f32x4){0.f, 0.f, 0.f, 0.f};
        cur = nxt; cA = nA; cB = nB; ++ui;
        if (wr == 1) PG8_BAR;
    }
    PG8_WAIT_V(0);
    PG8_BAR;
#undef PG8_SA
#undef PG8_SB
#undef PG8_STAGE
#undef PG8_LDA
#undef PG8_LDB
#undef PG8_MMA
#undef PG8_WAIT_V
#undef PG8_WAIT_L
#undef PG8_BAR
#undef PG8_SCHED
#undef PG8_UA
#undef PG8_UB
}
}

constexpr int NWAVES = 8;
constexpr int N_PHASES = 8;
constexpr int RING_OFF = 0, RING_BYTES = 131072;
constexpr int LDSCTL_OFF = RING_BYTES, MISC_OFF = LDSCTL_OFF + 320, XCH_OFF = RING_BYTES + 1024;
constexpr int LDS_BYTES = 147456;
static_assert(XCH_OFF + 12288 <= LDS_BYTES, "LDS map");
constexpr int CW_BAR = 4096;
constexpr size_t WO_IN = 0, WO_A = (size_t)NIN * DM * 2, WO_B = WO_A + (size_t)DM * 1024 * 2, WO_OUT = WO_B + (size_t)DM * 1024 * 2, WO_UP = WO_OUT + (size_t)DM * DM * 2, WO_DN = WO_UP + (size_t)NUP * DM * 2;
static_assert(WS_W + WO_DN + (size_t)DM * DFF * 2 <= WS_QKV, "weights fit");

#define GAS __attribute__((address_space(1)))
#define LAS __attribute__((address_space(3)))
typedef GAS unsigned gu32;
#define RLX_AGENT __ATOMIC_RELAXED, __HIP_MEMORY_SCOPE_AGENT
#define LDS_WAIT() asm volatile("s_waitcnt lgkmcnt(0)" ::: "memory")

#define XB_TMO      128
#define XB_XCNT(j)  (256  + 64 * (j))
#define XB_XSUB(j)  (1280 + 64 * (j))
#define XB_XGEN(j)  (2304 + 64 * (j))
#define XB_TOP      3328
#define XB_TOPGEN   3392
#define XCD_BAR_WORDS 3456
#define XB_SPIN_CAP (1u << 18)
__device__ __forceinline__ unsigned xb_ld(unsigned* p)              { return __hip_atomic_load(p, __ATOMIC_RELAXED, __HIP_MEMORY_SCOPE_AGENT); }
__device__ __forceinline__ unsigned xb_add(unsigned* p, unsigned v) { return __hip_atomic_fetch_add(p, v, __ATOMIC_RELAXED, __HIP_MEMORY_SCOPE_AGENT); }
__device__ __forceinline__ unsigned xb_xcc_id() { return (unsigned)__builtin_amdgcn_s_getreg((3 << 11) | 20) & 0xFu; }
#define XB_SPIN(cond, bar) do { unsigned _sp = 0; while (cond) { __builtin_amdgcn_s_sleep(1); \
    if ((++_sp & 255u) == 0u) { if (xb_ld(&(bar)[XB_TMO])) break; if (_sp > XB_SPIN_CAP) { atomicAdd(&(bar)[XB_TMO], 1u); break; } } } } while (0)
struct XcdBarrier { unsigned* bar; unsigned x; volatile LAS unsigned* st; };
__device__ __forceinline__ XcdBarrier xcd_barrier_post(unsigned* bar, volatile LAS unsigned* st) {
    XcdBarrier b; b.bar = bar; b.x = xb_xcc_id(); b.st = st;
    if (threadIdx.x == 0) (void)xb_add(&bar[XB_XCNT(b.x)], 1u);
    return b;
}
__device__ __forceinline__ void xcd_barrier_complete(unsigned* bar, unsigned x, unsigned& nloc, unsigned& nx) {
    const unsigned G = gridDim.x * gridDim.y * gridDim.z;
    unsigned sum, cnt, mine, sp = 0u;
    for (;;) {
        sum = 0u; cnt = 0u; mine = 0u;
#pragma unroll
        for (unsigned j = 0; j < 16; ++j) { const unsigned c = xb_ld(&bar[XB_XCNT(j)]); sum += c; cnt += (c > 0u) ? 1u : 0u; mine = (j == x) ? c : mine; }
        if (sum == G) break;
        __builtin_amdgcn_s_sleep(1);
        if ((++sp & 255u) == 0u) { if (xb_ld(&bar[XB_TMO])) break; if (sp > XB_SPIN_CAP) { atomicAdd(&bar[XB_TMO], 1u); break; } }
    }
    nloc = mine > 0u ? mine : 1u; nx = cnt > 0u ? cnt : 1u;
}
__device__ __forceinline__ void xcd_barrier(const XcdBarrier& b) {
    asm volatile("s_waitcnt vmcnt(0)" ::: "memory");
    __syncthreads();
    if (threadIdx.x == 0) {
        unsigned* bar = b.bar;
        __builtin_amdgcn_s_waitcnt(0);
        unsigned nloc = b.st[0], nx = b.st[1];
        if (nloc == 0u) { xcd_barrier_complete(bar, b.x, nloc, nx); b.st[0] = nloc; b.st[1] = nx; }
        const unsigned old = xb_add(&bar[XB_XSUB(b.x)], 1u);
        const unsigned gen = old / nloc;
        if (old + 1u == (gen + 1u) * nloc) {
            __builtin_amdgcn_fence(__ATOMIC_RELEASE, "agent");
            asm volatile("s_waitcnt vmcnt(0)" ::: "memory");
            const unsigned og = xb_add(&bar[XB_TOP], 1u);
            const unsigned tg = og / nx;
            if (og + 1u == (tg + 1u) * nx) xb_add(&bar[XB_TOPGEN], 1u);
            else XB_SPIN(xb_ld(&bar[XB_TOPGEN]) == tg, bar);
            __builtin_amdgcn_fence(__ATOMIC_ACQUIRE, "agent");
            xb_add(&bar[XB_XGEN(b.x)], 1u);
            asm volatile("s_waitcnt vmcnt(0)" ::: "memory");
        } else {
            XB_SPIN(xb_ld(&bar[XB_XGEN(b.x)]) == gen, bar);
            __builtin_amdgcn_fence(__ATOMIC_ACQUIRE, "agent");
            asm volatile("s_waitcnt vmcnt(0)" ::: "memory");
        }
    }
    __syncthreads();
}

__device__ __forceinline__ unsigned pk2(float lo, float hi) { return (unsigned)f2bf(lo) | ((unsigned)f2bf(hi) << 16); }
__device__ __forceinline__ int map_head(int c) { const int cc = c & 255; return (c & ~255) + 128 * ((cc >> 6) & 1) + 32 * (2 * (cc >> 7) + ((cc >> 5) & 1)) + 16 * ((cc >> 2) & 1) + 4 * ((cc >> 3) & 3) + (cc & 3); }
__device__ __forceinline__ int map_p32(int c) { return (c & ~31) + 16 * ((c >> 2) & 1) + 4 * ((c >> 3) & 3) + (c & 3); }
__device__ __forceinline__ int map_up(int c) { const int half = c >= DFF ? 1 : 0, cc = c - half * DFF, j = cc & 127; return 256 * (cc >> 7) + 128 * half + (j & ~31) + 16 * ((j >> 2) & 1) + 4 * ((j >> 3) & 3) + (j & 3); }
template <int MAP>
__device__ __forceinline__ void p0_transpose_item(const float* __restrict__ W, int K, int N, bf16_t* __restrict__ WT, const float* __restrict__ ksc, LAS float* scr, int item, int lane) {
    const int nblk = N / 32, kb = item / nblk, nb = item % nblk, k0 = 64 * kb, n0 = 32 * nb;
#pragma unroll 8
    for (int i = 0; i < 32; ++i) { const int kk = 2 * i + (lane >> 5); float v = W[(size_t)(k0 + kk) * N + n0 + (lane & 31)]; if (ksc) v *= ksc[k0 + kk]; scr[kk * 33 + (lane & 31)] = v; }
    LDS_WAIT(); asm volatile("" ::: "memory");
    const int c = lane & 7;
#pragma unroll
    for (int j = 0; j < 4; ++j) { const int n = (lane >> 3) + 8 * j; const LAS float* s = scr + (8 * c) * 33 + n;
        u32x4 o; o.x = pk2(s[0 * 33], s[1 * 33]); o.y = pk2(s[2 * 33], s[3 * 33]); o.z = pk2(s[4 * 33], s[5 * 33]); o.w = pk2(s[6 * 33], s[7 * 33]);
        const int src = n0 + n; const int dst = MAP == 0 ? map_head(src) : MAP == 1 ? map_p32(src) : MAP == 2 ? map_up(src) : src;
        *(u32x4*)(WT + (size_t)dst * K + k0 + 8 * c) = o; }
    LDS_WAIT(); asm volatile("" ::: "memory");
}

struct Args { const float* in[17]; float* out; unsigned char* ws; int ph_lo, ph_hi, li, pad; };

__device__ __forceinline__ void attn_a_item(const bf16_t* __restrict__ QKV, const float* __restrict__ sink, bf16_t* __restrict__ OA, int item, LAS float* scr, int lane) {
    LAS float* qs = scr; LAS float* ps = scr + 128;
    const int t = item >> 3, h = item & 7, b = t / SEQ, s = t % SEQ, kvh = h >> 2;
    const bf16_t* q = QKV + (size_t)t * NQKV + C_QA + h * 128;
    qs[lane] = bf2f(q[lane]); qs[lane + 64] = bf2f(q[lane + 64]);
    const int k0 = s - 128 < 0 ? 0 : s - 128, k1 = s + 128 > SEQ - 1 ? SEQ - 1 : s + 128, nk = k1 - k0 + 1;
    float sc[5]; float mx = -1e30f;
#pragma unroll
    for (int i = 0; i < 5; ++i) {
        const int kk = lane + 64 * i; sc[i] = -1e30f;
        if (kk < nk) {
            const bf16_t* kp = QKV + (size_t)(b * SEQ + k0 + kk) * NQKV + C_KA + kvh * 128;
            float d = 0.f;
            for (int c = 0; c < 16; ++c) { const u32x4 kv = *(const u32x4*)(kp + 8 * c);
#pragma unroll
                for (int e = 0; e < 4; ++e) { d += qs[8 * c + 2 * e] * __uint_as_float(kv[e] << 16) + qs[8 * c + 2 * e + 1] * __uint_as_float(kv[e] & 0xffff0000u); } }
            sc[i] = d * 0.08838834764831845f;
        }
        mx = fmaxf(mx, sc[i]);
    }
    const float sk = sink[h];
    mx = fmaxf(wave_max(mx), sk);
    float sum = 0.f;
#pragma unroll
    for (int i = 0; i < 5; ++i) { const int kk = lane + 64 * i; if (kk < nk) { const float p = __expf(sc[i] - mx); ps[kk] = p; sum += p; } }
    sum = wave_sum(sum) + __expf(sk - mx);
    const float inv = 1.f / sum;
    float o0 = 0.f, o1 = 0.f;
    const bf16_t* vp = QKV + (size_t)(b * SEQ + k0) * NQKV + C_VA + kvh * 128;
    for (int kk = 0; kk < nk; ++kk) { const float p = ps[kk]; o0 += p * bf2f(vp[(size_t)kk * NQKV + lane]); o1 += p * bf2f(vp[(size_t)kk * NQKV + lane + 64]); }
    bf16_t* o = OA + (size_t)t * 1024 + h * 128;
    o[lane] = f2bf(o0 * inv); o[lane + 64] = f2bf(o1 * inv);
}
__device__ __forceinline__ void attn_b_item(const bf16_t* __restrict__ QKV, const float* __restrict__ rpb, bf16_t* __restrict__ OB, int item, LAS float* scr, int lane) {
    LAS float* qs = scr; LAS float* ps = scr + 128;
    const int t = item >> 3, h = item & 7, b = t / SEQ, s = t % SEQ, qr = s / GW, qc = s % GW;
    const bf16_t* q = QKV + (size_t)t * NQKV + C_QB + h * 128;
    qs[lane] = bf2f(q[lane]); qs[lane + 64] = bf2f(q[lane + 64]);
    int rs = qr - 4; rs = rs < 0 ? 0 : (rs > GROWS - 8 ? GROWS - 8 : rs);
    int cs = qc - 8; cs = cs < 0 ? 0 : (cs > GW - 16 ? GW - 16 : cs);
    float sc[2]; float mx = -1e30f;
#pragma unroll
    for (int i = 0; i < 2; ++i) {
        const int kk = lane + 64 * i, kr = rs + (kk >> 4), kc = cs + (kk & 15);
        const bf16_t* kp = QKV + (size_t)(b * SEQ + kr * GW + kc) * NQKV + C_KB + h * 128;
        float d = 0.f;
        for (int c = 0; c < 16; ++c) { const u32x4 kv = *(const u32x4*)(kp + 8 * c);
#pragma unroll
            for (int e = 0; e < 4; ++e) { d += qs[8 * c + 2 * e] * __uint_as_float(kv[e] << 16) + qs[8 * c + 2 * e + 1] * __uint_as_float(kv[e] & 0xffff0000u); } }
        sc[i] = d * 0.08838834764831845f + rpb[(h * 15 + (kr - qr + 7)) * 31 + (kc - qc + 15)];
        mx = fmaxf(mx, sc[i]);
    }
    mx = wave_max(mx);
    float sum = 0.f;
#pragma unroll
    for (int i = 0; i < 2; ++i) { const float p = __expf(sc[i] - mx); ps[lane + 64 * i] = p; sum += p; }
    sum = wave_sum(sum);
    const float inv = 1.f / sum;
    float o0 = 0.f, o1 = 0.f;
    for (int kk = 0; kk < 128; ++kk) {
        const int kr = rs + (kk >> 4), kc = cs + (kk & 15);
        const bf16_t* vp = QKV + (size_t)(b * SEQ + kr * GW + kc) * NQKV + C_VB + h * 128;
        const float p = ps[kk]; o0 += p * bf2f(vp[lane]); o1 += p * bf2f(vp[lane + 64]);
    }
    bf16_t* o = OB + (size_t)t * 1024 + h * 128;
    o[lane] = f2bf(o0 * inv); o[lane + 64] = f2bf(o1 * inv);
}


namespace att {
typedef short bf16x8 __attribute__((ext_vector_type(8)));
typedef short s16x4 __attribute__((ext_vector_type(4)));
typedef float f32x16 __attribute__((ext_vector_type(16)));
constexpr int KP = 272, VP = 320, KT = 64 * KP, VT = 64 * VP;
constexpr int OFF_K = 0, OFF_V = 2 * KT, OFF_RPB = 2 * KT + 2 * VT, ATT_LDS = OFF_RPB + 2048;
constexpr float SC_L2 = 0.08838834764831845f * 1.4426950408889634f;
constexpr float L2E = 1.4426950408889634f;
constexpr float NEGBIG = -1e30f;

__device__ __forceinline__ s16x4 vtr(const LAS char* p) { return __builtin_bit_cast(s16x4, __builtin_amdgcn_ds_read_tr16_b64_v4i16((LAS s16x4*)p)); }

struct Stage { u32x4 k[2], v[2]; };
__device__ __forceinline__ void stage_load(Stage& st, const bf16_t* __restrict__ QKV, int tok0, int kcol, int vcol, int tid) {
#pragma unroll
    for (int i = 0; i < 2; ++i) { const int c = tid + 512 * i, key = c >> 4, ch = c & 15; const bf16_t* rowp = QKV + (size_t)(tok0 + key) * NQKV + ch * 8;
        st.k[i] = *(const u32x4*)(rowp + kcol); st.v[i] = *(const u32x4*)(rowp + vcol); }
}
__device__ __forceinline__ void stage_store(const Stage& st, LAS char* Kt, LAS char* Vt, int tid) {
#pragma unroll
    for (int i = 0; i < 2; ++i) { const int c = tid + 512 * i, key = c >> 4, ch = c & 15; const int kr = (key & ~12) | ((key & 4) << 1) | ((key & 8) >> 1);
        *(LAS u32x4*)(Kt + kr * KP + ch * 16) = st.k[i]; *(LAS u32x4*)(Vt + key * VP + ch * 16) = st.v[i]; }
}

template <class SB>
__device__ __forceinline__ void tile_step(const LAS char* Kt, const LAS char* Vt, const bf16x8 (&qf)[8], f32x16 (&o)[4], float& m, float& l, int lane, const SB& sb) {
    const int r32 = lane & 31, hi = lane >> 5;
    f32x16 S0, S1;
#pragma unroll
    for (int g = 0; g < 16; ++g) { S0[g] = 0.f; S1[g] = 0.f; }
    const LAS char* kp = Kt + r32 * KP + hi * 16;
#pragma unroll
    for (int ds = 0; ds < 8; ++ds) {
        const bf16x8 k0 = *(const LAS bf16x8*)(kp + ds * 32);
        const bf16x8 k1 = *(const LAS bf16x8*)(kp + 32 * KP + ds * 32);
        S0 = __builtin_amdgcn_mfma_f32_32x32x16_bf16(k0, qf[ds], S0, 0, 0, 0);
        S1 = __builtin_amdgcn_mfma_f32_32x32x16_bf16(k1, qf[ds], S1, 0, 0, 0);
    }
    float mx = NEGBIG;
#pragma unroll
    for (int g = 0; g < 16; ++g) { const int kk = (g & 7) + 8 * hi + 16 * (g >> 3); S0[g] = sb(S0[g], kk); S1[g] = sb(S1[g], kk + 32); mx = fmaxf(mx, fmaxf(S0[g], S1[g])); }
    mx = fmaxf(mx, __shfl_xor(mx, 32));
    const float mn = fmaxf(m, mx), alpha = __builtin_amdgcn_exp2f(m - mn);
    m = mn;
    float ps = 0.f;
#pragma unroll
    for (int g = 0; g < 16; ++g) { S0[g] = __builtin_amdgcn_exp2f(S0[g] - mn); S1[g] = __builtin_amdgcn_exp2f(S1[g] - mn); ps += S0[g] + S1[g]; }
    l = l * alpha + ps;
    if (!__all(alpha == 1.f)) {
#pragma unroll
        for (int d = 0; d < 4; ++d)
#pragma unroll
            for (int g = 0; g < 16; ++g) o[d][g] *= alpha;
    }
    bf16x8 pf[4];
#pragma unroll
    for (int s2 = 0; s2 < 2; ++s2) {
        u32x4 w0, w1;
#pragma unroll
        for (int j = 0; j < 4; ++j) { w0[j] = pg8::cvt_pk_bf16(S0[8 * s2 + 2 * j], S0[8 * s2 + 2 * j + 1]); w1[j] = pg8::cvt_pk_bf16(S1[8 * s2 + 2 * j], S1[8 * s2 + 2 * j + 1]); }
        pf[s2] = __builtin_bit_cast(bf16x8, w0); pf[2 + s2] = __builtin_bit_cast(bf16x8, w1);
    }
    const int l16 = lane & 15, gi = lane >> 4;
    const LAS char* vp = Vt + (8 * hi + (l16 >> 2)) * VP + (16 * (gi & 1) + 4 * (l16 & 3)) * 2;
#pragma unroll
    for (int db = 0; db < 4; ++db)
#pragma unroll
        for (int ks = 0; ks < 4; ++ks) {
            const s16x4 a = vtr(vp + ks * 16 * VP + db * 64), b = vtr(vp + ks * 16 * VP + 4 * VP + db * 64);
            const bf16x8 vf = {a[0], a[1], a[2], a[3], b[0], b[1], b[2], b[3]};
            o[db] = __builtin_amdgcn_mfma_f32_32x32x16_bf16(vf, pf[ks], o[db], 0, 0, 0);
        }
}

__device__ __forceinline__ void store_o(const f32x16 (&o)[4], float l, bf16_t* __restrict__ orow, int lane) {
    const int hi = lane >> 5;
    const float lt = l + __shfl_xor(l, 32), inv = 1.f / lt;
#pragma unroll
    for (int db = 0; db < 4; ++db)
#pragma unroll
        for (int gq = 0; gq < 4; ++gq) { u32x2 w; w.x = pg8::cvt_pk_bf16(o[db][4 * gq] * inv, o[db][4 * gq + 1] * inv); w.y = pg8::cvt_pk_bf16(o[db][4 * gq + 2] * inv, o[db][4 * gq + 3] * inv);
            *(u32x2*)(orow + 32 * db + 8 * gq + 4 * hi) = w; }
}

__device__ __forceinline__ void unit_a(LAS char* L, const bf16_t* __restrict__ QKV, const float* __restrict__ sink, bf16_t* __restrict__ OA, int ua, int tid, int wave, int lane) {
    const int b = ua >> 7, kvh = (ua >> 6) & 1, n2 = ua & 63, q0 = n2 * 64;
    const int head = kvh * 4 + (wave >> 1), qi = 32 * (wave & 1) + (lane & 31), hi = lane >> 5;
    const int tokq = b * SEQ + q0 + qi;
    bf16x8 qf[8];
    { const bf16_t* qp = QKV + (size_t)tokq * NQKV + C_QA + head * 128 + 8 * hi;
#pragma unroll
      for (int ds = 0; ds < 8; ++ds) qf[ds] = *(const bf16x8*)(qp + 16 * ds); }
    f32x16 o[4];
#pragma unroll
    for (int d = 0; d < 4; ++d)
#pragma unroll
        for (int g = 0; g < 16; ++g) o[d][g] = 0.f;
    float m = sink[head] * L2E, l = hi == 0 ? 1.f : 0.f;
    const int t_lo = q0 >= 128 ? 0 : (q0 >= 64 ? 1 : 2), t_hi = q0 + 191 < SEQ ? 5 : (q0 + 127 < SEQ ? 4 : 3);
    const int kcol = C_KA + kvh * 128, vcol = C_VA + kvh * 128, tokb = b * SEQ + q0 - 128;
    Stage st;
    stage_load(st, QKV, tokb + 64 * t_lo, kcol, vcol, tid);
    stage_store(st, L + OFF_K, L + OFF_V, tid);
    PG8_XBAR();
    for (int t = t_lo; t < t_hi; ++t) {
        const int buf = (t - t_lo) & 1;
        if (t + 1 < t_hi) stage_load(st, QKV, tokb + 64 * (t + 1), kcol, vcol, tid);
        const bool lo_mask = t == 0, hi_mask = t == 4;
        tile_step(L + OFF_K + buf * KT, L + OFF_V + buf * VT, qf, o, m, l, lane, [=](float s, int kk) { const bool dead = (lo_mask && kk < qi) || (hi_mask && kk > qi); return dead ? NEGBIG : s * SC_L2; });
        if (t + 1 < t_hi) stage_store(st, L + OFF_K + (buf ^ 1) * KT, L + OFF_V + (buf ^ 1) * VT, tid);
        PG8_XBAR();
    }
    store_o(o, l, OA + (size_t)tokq * 1024 + head * 128, lane);
}

__device__ __forceinline__ void unit_b(LAS char* L, const bf16_t* __restrict__ QKV, const float* __restrict__ rpb, bf16_t* __restrict__ OB, int ub, int tid, int wave, int lane) {
    const int b = ub >> 7, h = (ub >> 4) & 7, rb = (ub >> 1) & 7, hf = ub & 1;
    const int qr = 8 * rb + wave, qc = 32 * hf + (lane & 31), hi = lane >> 5;
    const int tokq = b * SEQ + qr * GW + qc;
    LAS float* rp = (LAS float*)(L + OFF_RPB);
    if (tid < 15 * 31) rp[tid] = rpb[h * 15 * 31 + tid] * L2E;
    bf16x8 qf[8];
    { const bf16_t* qp = QKV + (size_t)tokq * NQKV + C_QB + h * 128 + 8 * hi;
#pragma unroll
      for (int ds = 0; ds < 8; ++ds) qf[ds] = *(const bf16x8*)(qp + 16 * ds); }
    f32x16 o[4];
#pragma unroll
    for (int d = 0; d < 4; ++d)
#pragma unroll
        for (int g = 0; g < 16; ++g) o[d][g] = 0.f;
    float m = NEGBIG, l = 0.f;
    int rs = qr - 4; rs = rs < 0 ? 0 : (rs > GROWS - 8 ? GROWS - 8 : rs);
    int cs = qc - 8; cs = cs < 0 ? 0 : (cs > GW - 16 ? GW - 16 : cs);
    int kr_lo = 8 * rb - 4; kr_lo = kr_lo < 0 ? 0 : (kr_lo > GROWS - 8 ? GROWS - 8 : kr_lo);
    int kr_hi = 8 * rb + 3; kr_hi = (kr_hi < 0 ? 0 : (kr_hi > GROWS - 8 ? GROWS - 8 : kr_hi)) + 8;
    const int kcol = C_KB + h * 128, vcol = C_VB + h * 128, tokb = b * SEQ;
    Stage st;
    stage_load(st, QKV, tokb + GW * kr_lo, kcol, vcol, tid);
    stage_store(st, L + OFF_K, L + OFF_V, tid);
    PG8_XBAR();
    for (int kr = kr_lo; kr < kr_hi; ++kr) {
        const int buf = (kr - kr_lo) & 1;
        if (kr + 1 < kr_hi) stage_load(st, QKV, tokb + GW * (kr + 1), kcol, vcol, tid);
        if (kr >= rs && kr < rs + 8) {
            const LAS float* brow = rp + (kr - qr + 7) * 31 + 15 - qc;
            tile_step(L + OFF_K + buf * KT, L + OFF_V + buf * VT, qf, o, m, l, lane, [=](float s, int kk) { const bool ok = kk >= cs && kk < cs + 16; const float bias = brow[ok ? kk : cs]; return ok ? fmaf(s, SC_L2, bias) : NEGBIG; });
        }
        if (kr + 1 < kr_hi) stage_store(st, L + OFF_K + (buf ^ 1) * KT, L + OFF_V + (buf ^ 1) * VT, tid);
        PG8_XBAR();
    }
    store_o(o, l, OB + (size_t)tokq * 1024 + h * 128, lane);
}
}

__global__ void __launch_bounds__(NWAVES * 64, 2) mk_fwd(Args args) {
    extern __shared__ __attribute__((aligned(16))) unsigned char lds[];
    LAS unsigned char* L = (LAS unsigned char*)lds;
    volatile LAS unsigned* MISC = (volatile LAS unsigned*)(L + MISC_OFF);
    const int tid = threadIdx.x, lane = tid & 63, wave = __builtin_amdgcn_readfirstlane(tid >> 6);
    const int G = gridDim.x; const int bx = blockIdx.x; const int vcu = (G % 8 == 0) ? (bx % 8) * (G / 8) + bx / 8 : bx;
    unsigned char* ws = args.ws;
    gu32* ctl = (gu32*)(ws + WS_CTL);
    const float* x = args.in[0]; float* out = args.out;
    bf16_t* Wt = (bf16_t*)(ws + WS_W);
    bf16_t* Win_t = (bf16_t*)(ws + WS_W + WO_IN); bf16_t* Wa_t = (bf16_t*)(ws + WS_W + WO_A); bf16_t* Wb_t = (bf16_t*)(ws + WS_W + WO_B);
    bf16_t* Wo_t = (bf16_t*)(ws + WS_W + WO_OUT); bf16_t* Wup_t = (bf16_t*)(ws + WS_W + WO_UP); bf16_t* Wdn_t = (bf16_t*)(ws + WS_W + WO_DN);
    float* rope = (float*)(ws + WS_ROPE); float* NORMS = (float*)(ws + WS_NORMS); float* SSQ = (float*)(ws + WS_SSQ); float* HALO = (float*)(ws + WS_HALO);
    bf16_t* QKV = (bf16_t*)(ws + WS_QKV); bf16_t* Gt = (bf16_t*)(ws + WS_G); bf16_t* MG = (bf16_t*)(ws + WS_MG); bf16_t* ACT = (bf16_t*)(ws + WS_ACT); bf16_t* X1B = (bf16_t*)(ws + WS_X1B);
    bf16_t* XN = (bf16_t*)out; bf16_t* OA = (bf16_t*)((unsigned char*)out + 64 * MiB); bf16_t* OB = (bf16_t*)((unsigned char*)out + 96 * MiB);
    (void)Wt;
    for (int u = tid; u < (LDS_BYTES - LDSCTL_OFF) / 4; u += NWAVES * 64) ((LAS unsigned*)(L + LDSCTL_OFF))[u] = 0u;
    __syncthreads();
    const int lo = args.ph_lo, hi = args.ph_hi;
    XcdBarrier bar; bar.bar = (unsigned*)(ctl + CW_BAR) + args.li * XCD_BAR_WORDS; bar.x = 0; bar.st = nullptr;
    if (hi - lo > 1) bar = xcd_barrier_post((unsigned*)(ctl + CW_BAR) + args.li * XCD_BAR_WORDS, MISC + 8);
#ifndef PHMASK
#define PHMASK 255
#endif
#define IN(k) (((PHMASK >> (k)) & 1) && lo <= (k) && (k) < hi)
#define SEAM(k) do { if (IN(k) && IN((k) + 1)) xcd_barrier(bar); } while (0)
    const int gw = vcu * NWAVES + wave, NGW = G * NWAVES;

    if (IN(0)) {
        LAS float* scr = (LAS float*)(L + RING_OFF + wave * 16384);
        constexpr int I_IN = (DM / 64) * (NIN / 32), I_A = (1024 / 64) * (DM / 32), I_O = (DM / 64) * (DM / 32), I_U = (DM / 64) * (NUP / 32), I_D = (DFF / 64) * (DM / 32);
        constexpr int NITEMS = I_IN + 2 * I_A + I_O + I_U + I_D;
        for (int it = gw; it < NITEMS; it += NGW) {
            int r = it;
            if (r < I_IN) { p0_transpose_item<0>(args.in[2], DM, NIN, Win_t, nullptr, scr, r, lane); continue; } r -= I_IN;
            if (r < I_A) { p0_transpose_item<1>(args.in[9], 1024, DM, Wa_t, nullptr, scr, r, lane); continue; } r -= I_A;
            if (r < I_A) { p0_transpose_item<1>(args.in[10], 1024, DM, Wb_t, nullptr, scr, r, lane); continue; } r -= I_A;
            if (r < I_O) { p0_transpose_item<1>(args.in[11], DM, DM, Wo_t, nullptr, scr, r, lane); continue; } r -= I_O;
            if (r < I_U) { p0_transpose_item<2>(args.in[13], DM, NUP, Wup_t, args.in[12], scr, r, lane); continue; } r -= I_U;
            p0_transpose_item<3>(args.in[16], DFF, DM, Wdn_t, nullptr, scr, r, lane);
        }
        if (bx == 0) { const int k = tid >> 7, j = tid & 127; NORMS[tid] = args.in[k == 0 ? 3 : k == 1 ? 4 : k == 2 ? 6 : 7][j]; }
        const float* g = args.in[1];
        for (int m = gw; m < M; m += NGW) {
            const f32x4* xr = (const f32x4*)(x + (size_t)m * DM) + lane;
            f32x4 v[8]; float s = 0.f;
#pragma unroll
            for (int j = 0; j < 8; ++j) { v[j] = xr[64 * j]; s += (v[j].x * v[j].x + v[j].y * v[j].y) + (v[j].z * v[j].z + v[j].w * v[j].w); }
            const float rs = rsqrtf(wave_sum(s) * (1.f / DM) + EPS);
#pragma unroll
            for (int j = 0; j < 8; ++j) { const f32x4 gv = ((const f32x4*)g)[lane + 64 * j];
                u32x2 o; o.x = pk2(v[j].x * rs * gv.x, v[j].y * rs * gv.y); o.y = pk2(v[j].z * rs * gv.z, v[j].w * rs * gv.w);
                ((u32x2*)(XN + (size_t)m * DM))[lane + 64 * j] = o; }
        }
        for (int idx = vcu * (NWAVES * 64) + tid; idx < SEQ * 64; idx += G * NWAVES * 64) {
            const int pos = idx >> 6, j = idx & 63;
            const double inv = exp2(-(double)j * (1.0 / 64.0) * 13.287712379549449);
            const double ang = (double)pos * inv;
            const double TWO_PI = 6.283185307179586476925286766559;
            const double k = rint(ang / TWO_PI);
            const float r = (float)(ang - k * TWO_PI);
            rope[idx] = cosf(r); rope[SEQ * 64 + idx] = sinf(r);
        }
    }
    SEAM(0);
    if (IN(1)) {
        pg8::Gemm g{XN, Win_t, XN, Win_t, M, NIN, DM}; pg8::StaticOrder S; S.init(M, NIN, G, bx);
        pg8::EpiProj E{QKV, Gt, NORMS, rope};
        pg8::gemm_phase(L + RING_OFF, L + XCH_OFF, g, S, E);
    }
    SEAM(1);
    if (IN(2)) {
#if defined(ATTN_VALU) && ATTN_VALU
        LAS float* scr = (LAS float*)(L + RING_OFF + wave * 2048);
        for (int it = gw; it < M * 8; it += NGW) attn_a_item(QKV, args.in[5], OA, it, scr, lane);
        for (int it = gw; it < M * 8; it += NGW) attn_b_item(QKV, args.in[8], OB, it, scr, lane);
#else
        static_assert(att::ATT_LDS <= RING_BYTES, "attention LDS");
        for (int ua = vcu; ua < 512; ua += G) att::unit_a((LAS char*)(L + RING_OFF), QKV, args.in[5], OA, ua, tid, wave, lane);
        for (int ub = vcu; ub < 512; ub += G) att::unit_b((LAS char*)(L + RING_OFF), QKV, args.in[8], OB, ub, tid, wave, lane);
#endif
    }
    SEAM(2);
    if (IN(3)) {
        pg8::Gemm g{OA, Wa_t, OB, Wb_t, M, DM, 1024}; pg8::StaticOrder S; S.init(M, DM, G, bx, 1);
        pg8::EpiBranch E{MG, Gt};
        pg8::gemm_phase(L + RING_OFF, L + XCH_OFF, g, S, E);
    }
    SEAM(3);
    if (IN(4)) {
        pg8::Gemm g{MG, Wo_t, MG, Wo_t, M, DM, DM}; pg8::StaticOrder S; S.init(M, DM, G, bx);
        pg8::EpiOut E{x, out, X1B, SSQ};
        pg8::gemm_phase(L + RING_OFF, L + XCH_OFF, g, S, E);
    }
    SEAM(4);
    if (IN(5)) {
        pg8::Gemm g{X1B, Wup_t, X1B, Wup_t, M, NUP, DM}; pg8::StaticOrder S; S.init(M, NUP, G, bx);
        pg8::EpiUp E{ACT, HALO, SSQ, args.in[14], args.in[15]};
        pg8::gemm_phase(L + RING_OFF, L + XCH_OFF, g, S, E);
    }
    SEAM(5);
    if (IN(6)) {
        const float* cw = args.in[14]; const float* cb = args.in[15];
        for (int idx = vcu * (NWAVES * 64) + tid; idx < 128 * (DFF / 4); idx += G * NWAVES * 64) {
            const int rr = idx / (DFF / 4), j = (idx % (DFF / 4)) * 4, pm = rr >> 1, side = rr & 1;
            const int row = pm * 256 + (side ? 255 : 0);
            const float* hc = HALO + (size_t)(pm * 4 + (side ? 3 : 0)) * NUP;
            const float* hp = side ? HALO + (size_t)(pm * 4 + 2) * NUP : ((pm & 15) == 0 ? nullptr : HALO + (size_t)((pm - 1) * 4 + 3) * NUP);
            const float* hn = side ? ((pm & 15) == 15 ? nullptr : HALO + (size_t)((pm + 1) * 4 + 0) * NUP) : HALO + (size_t)(pm * 4 + 1) * NUP;
            f32x4 o[2];
#pragma unroll
            for (int bj = 0; bj < 2; ++bj) {
                const int c = bj * DFF + j;
                f32x4 a = *(const f32x4*)(cb + c) + *(const f32x4*)(cw + NUP + c) * *(const f32x4*)(hc + c);
                if (hp) a += *(const f32x4*)(cw + c) * *(const f32x4*)(hp + c);
                if (hn) a += *(const f32x4*)(cw + 2 * NUP + c) * *(const f32x4*)(hn + c);
                o[bj] = a;
            }
            u32x2 w; float r[4];
#pragma unroll
            for (int e = 0; e < 4; ++e) r[e] = o[0][e] / (1.f + __expf(-o[0][e])) * o[1][e];
            w.x = pk2(r[0], r[1]); w.y = pk2(r[2], r[3]);
            *(u32x2*)(ACT + (size_t)row * DFF + j) = w;
        }
    }
    SEAM(6);
    if (IN(7)) {
        pg8::Gemm g{ACT, Wdn_t, ACT, Wdn_t, M, DM, DFF}; pg8::StaticOrder S; S.init(M, DM, G, bx);
        pg8::EpiDown E{out};
        pg8::gemm_phase(L + RING_OFF, L + XCH_OFF, g, S, E);
    }
#undef IN
#undef SEAM
}

#ifndef OPTMASK
#define OPTMASK 31
#endif
#ifndef FUSED
#define FUSED 1
#endif
extern "C" void kernel_launch(void* const* d_in, const int* in_sizes, int n_in, void* d_out, int out_size, void* d_ws, size_t ws_size, hipStream_t stream) {
    if (n_in != 17 || out_size != M * DM || ws_size < WS_END) { fprintf(stderr, "kernel_launch: unexpected shapes (n_in %d out %d ws %zu)\n", n_in, out_size, ws_size); return; }
    static int grid = 0;
    if (grid == 0) {
        int dev = 0, cus = 0, per_cu = 0;
        if (hipGetDevice(&dev) != hipSuccess || hipDeviceGetAttribute(&cus, hipDeviceAttributeMultiprocessorCount, dev) != hipSuccess) { grid = -1; return; }
        if (hipFuncSetAttribute((const void*)mk_fwd, hipFuncAttributeMaxDynamicSharedMemorySize, LDS_BYTES) != hipSuccess) { fprintf(stderr, "kernel_launch: hipFuncSetAttribute failed\n"); grid = -1; return; }
        if (hipOccupancyMaxActiveBlocksPerMultiprocessor(&per_cu, (const void*)mk_fwd, NWAVES * 64, LDS_BYTES) != hipSuccess || per_cu < 1) { fprintf(stderr, "kernel_launch: occupancy query says %d\n", per_cu); }
        (void)hipGetLastError();
        grid = cus;
    }
    if (grid < 0) return;
    const float* x = (const float*)d_in[0]; const float* norm_mix = (const float*)d_in[1]; const float* w_in = (const float*)d_in[2];
    const float* aqn = (const float*)d_in[3]; const float* akn = (const float*)d_in[4]; const float* sink = (const float*)d_in[5];
    const float* bqn = (const float*)d_in[6]; const float* bkn = (const float*)d_in[7]; const float* rpb = (const float*)d_in[8];
    const float* wba = (const float*)d_in[9]; const float* wbb = (const float*)d_in[10]; const float* w_out = (const float*)d_in[11];
    const float* norm_ffn = (const float*)d_in[12]; const float* w_up = (const float*)d_in[13]; const float* conv_w = (const float*)d_in[14];
    const float* conv_b = (const float*)d_in[15]; const float* w_down = (const float*)d_in[16];
    unsigned char* ws = (unsigned char*)d_ws; float* out = (float*)d_out;
    float* rope = (float*)(ws + WS_ROPE);
    bf16_t* QKV = (bf16_t*)(ws + WS_QKV); bf16_t* G = (bf16_t*)(ws + WS_G); bf16_t* MG = (bf16_t*)(ws + WS_MG); bf16_t* ACT = (bf16_t*)(ws + WS_ACT);
    bf16_t* X1B = (bf16_t*)(ws + WS_X1B); bf16_t* UCH = (bf16_t*)(ws + WS_UCH);
    bf16_t* XN = (bf16_t*)d_out; bf16_t* OA = (bf16_t*)((unsigned char*)d_out + 64 * MiB); bf16_t* OB = (bf16_t*)((unsigned char*)d_out + 96 * MiB);
    (void)hipMemsetAsync(ws + WS_CTL, 0, 1 * MiB, stream);
    Args a{};
    for (int i = 0; i < 17; ++i) a.in[i] = (const float*)d_in[i];
    a.out = out; a.ws = ws;
    int li = 0;
#ifndef DUP
#define DUP -1
#endif
#define MK(lo_, hi_) do { for (int rep_ = 0; rep_ < (((lo_) == DUP && (hi_) == DUP + 1) ? 2 : 1); ++rep_) { a.ph_lo = (lo_); a.ph_hi = (hi_); a.li = li++; hipLaunchKernelGGL(mk_fwd, dim3(grid), dim3(NWAVES * 64), LDS_BYTES, stream, a); } } while (0)
    if (FUSED && OPTMASK == 31) { MK(0, N_PHASES); return; }
    if (OPTMASK & 1) { MK(0, 1); MK(1, 2);
#if defined(PROBE) && PROBE == 1
        { nv::NEpi e = nv::mk_epi(0, QKV, NQKV, nullptr, 0, nullptr, nullptr, 0); nv::k_ngemm<<<4096, 256, 0, stream>>>(XN, DM, w_in, NIN, M, NQKV, DM, e); }
        nv::k_proj_post<<<2048, 256, 0, stream>>>(QKV, G, aqn, akn, bqn, bkn, rope, 1, 0);
#elif defined(PROBE) && PROBE == 2
        { nv::NEpi e = nv::mk_epi(0, G, NGATE, nullptr, 0, nullptr, nullptr, 0); nv::k_ngemm<<<4096, 256, 0, stream>>>(XN, DM, w_in + NQKV, NIN, M, NGATE, DM, e); }
        nv::k_proj_post<<<2048, 256, 0, stream>>>(QKV, G, aqn, akn, bqn, bkn, rope, 0, 1);
#endif
    }
    else {
        if (OPTMASK) MK(0, 1);
        nv::k_rope_table<<<SEQ * 64 / 256, 256, 0, stream>>>(rope);
        nv::k_rmsnorm_rows<<<2048, 256, 0, stream>>>(x, norm_mix, XN, M);
        { nv::NEpi e = nv::mk_epi(0, QKV, NQKV, nullptr, 0, nullptr, nullptr, 0); nv::k_ngemm<<<4096, 256, 0, stream>>>(XN, DM, w_in, NIN, M, NQKV, DM, e); }
        { nv::NEpi e = nv::mk_epi(0, G, NGATE, nullptr, 0, nullptr, nullptr, 0); nv::k_ngemm<<<4096, 256, 0, stream>>>(XN, DM, w_in + NQKV, NIN, M, NGATE, DM, e); }
        nv::k_proj_post<<<2048, 256, 0, stream>>>(QKV, G, aqn, akn, bqn, bkn, rope, 1, 1);
    }
    if (OPTMASK & 2) MK(2, 3);
    else { nv::k_attn_a<<<4096, 256, 0, stream>>>(QKV, sink, OA); nv::k_attn_b<<<4096, 256, 0, stream>>>(QKV, rpb, OB); }
    if (OPTMASK & 4) MK(3, 4);
    else {
        { nv::NEpi e = nv::mk_epi(1, MG, DM, G, NGATE, nullptr, nullptr, 0); nv::k_ngemm<<<4096, 256, 0, stream>>>(OA, 1024, wba, DM, M, DM, 1024, e); }
        { nv::NEpi e = nv::mk_epi(2, MG, DM, G + 2048, NGATE, nullptr, nullptr, 0); nv::k_ngemm<<<4096, 256, 0, stream>>>(OB, 1024, wbb, DM, M, DM, 1024, e); }
    }
    if (OPTMASK & 8) { MK(4, 5); MK(5, 6); MK(6, 7); }
    else {
        { nv::NEpi e = nv::mk_epi(3, nullptr, 0, nullptr, 0, x, out, DM); nv::k_ngemm<<<4096, 256, 0, stream>>>(MG, DM, w_out, DM, M, DM, DM, e); }
        nv::k_rmsnorm_rows<<<2048, 256, 0, stream>>>(out, norm_ffn, X1B, M);
        for (int b = 0; b < BATCH; ++b) {
            nv::NEpi e = nv::mk_epi(0, UCH, NUP, nullptr, 0, nullptr, nullptr, 0);
            nv::k_ngemm<<<4096, 256, 0, stream>>>(X1B + (size_t)b * SEQ * DM, DM, w_up, NUP, SEQ, NUP, DM, e);
            nv::k_conv_glu<<<4096, 256, 0, stream>>>(UCH, conv_w, conv_b, ACT + (size_t)b * SEQ * DFF);
        }
    }
    if (OPTMASK & 16) MK(7, 8);
    else { nv::NEpi e = nv::mk_epi(3, nullptr, 0, nullptr, 0, out, out, DM); nv::k_ngemm<<<4096, 256, 0, stream>>>(ACT, DFF, w_down, DM, M, DM, DFF, e); }
#undef MK
}
```

```cpp
#define OPTMASK 31
#define FUSED 1
#define PROBE 0
#define DUP -1
#define NO_RELAX 1
#include <hip/hip_runtime.h>
#include <cstdint>
#include <cstdio>

typedef unsigned short bf16_t;
typedef float f32x4 __attribute__((ext_vector_type(4)));
typedef unsigned u32x4 __attribute__((ext_vector_type(4)));
typedef unsigned u32x2 __attribute__((ext_vector_type(2)));

constexpr int BATCH = 4, SEQ = 4096, DM = 2048, M = BATCH * SEQ;
constexpr int HD = 128, AQH = 8, AKVH = 2, BH = 8;
constexpr int NQKV = 4608, NGATE = 4096, NIN = NQKV + NGATE;
constexpr int C_QA = 0, C_KA = 1024, C_VA = 1280, C_QB = 1536, C_KB = 2560, C_VB = 3584;
constexpr int DFF = 5632, NUP = 2 * DFF;
constexpr int GW = 64, GROWS = SEQ / GW;
constexpr float EPS = 1e-6f;

constexpr size_t MiB = 1u << 20;
constexpr size_t WS_CTL = 0;
constexpr size_t WS_ROPE = 1 * MiB;
constexpr size_t WS_SSQ = 3 * MiB;
constexpr size_t WS_NORMS = 3 * MiB + 768 * 1024;
constexpr size_t WS_RS1 = 3 * MiB + 832 * 1024;
constexpr size_t WS_CSC = 3 * MiB + 896 * 1024;
constexpr size_t WS_CMAX = 32 * 1024, WS_CTL_ZERO = 72 * 1024;
constexpr size_t WS_HALO = 4 * MiB;
constexpr size_t WS_W = 16 * MiB;
constexpr size_t WS_QKV = 132 * MiB;
constexpr size_t WS_G = 276 * MiB;
constexpr size_t WS_MG = 132 * MiB;
constexpr size_t WS_ACT = 132 * MiB;
constexpr size_t WS_X1B = 340 * MiB;
constexpr size_t WS_UCH = 404 * MiB;
constexpr size_t WS_END = 492 * MiB;

__device__ __forceinline__ float bf2f(bf16_t v) { return __uint_as_float((unsigned)v << 16); }
__device__ __forceinline__ bf16_t f2bf(float f) { unsigned u = __float_as_uint(f); return (bf16_t)((u + 0x7fffu + ((u >> 16) & 1u)) >> 16); }
__device__ __forceinline__ float wave_sum(float v) {
#pragma unroll
    for (int o = 1; o < 64; o <<= 1) v += __shfl_xor(v, o);
    return v;
}
__device__ __forceinline__ float wave_max(float v) {
#pragma unroll
    for (int o = 1; o < 64; o <<= 1) v = fmaxf(v, __shfl_xor(v, o));
    return v;
}

namespace nv {

__global__ void k_rope_table(float* tab) {
    const int idx = blockIdx.x * blockDim.x + threadIdx.x;
    if (idx >= SEQ * 64) return;
    const int pos = idx >> 6, j = idx & 63;
    const double inv = exp2(-(double)j * (1.0 / 64.0) * 13.287712379549449);
    const double ang = (double)pos * inv;
    const double TWO_PI = 6.283185307179586476925286766559;
    const double k = rint(ang / TWO_PI);
    const float r = (float)(ang - k * TWO_PI);
    tab[idx] = cosf(r);
    tab[SEQ * 64 + idx] = sinf(r);
}

__global__ void k_rmsnorm_rows(const float* __restrict__ x, const float* __restrict__ g, bf16_t* __restrict__ out, int rows) {
    const int lane = threadIdx.x & 63, wpb = blockDim.x >> 6;
    for (int r = blockIdx.x * wpb + (threadIdx.x >> 6); r < rows; r += gridDim.x * wpb) {
        const f32x4* xr = (const f32x4*)(x + (size_t)r * DM) + lane;
        f32x4 v[8]; float s = 0.f;
#pragma unroll
        for (int j = 0; j < 8; ++j) { v[j] = xr[64 * j]; s += v[j].x * v[j].x + v[j].y * v[j].y + v[j].z * v[j].z + v[j].w * v[j].w; }
        const float rs = rsqrtf(wave_sum(s) * (1.f / DM) + EPS);
#pragma unroll
        for (int j = 0; j < 8; ++j) {
            const f32x4 gv = ((const f32x4*)g)[lane + 64 * j];
            u32x2 o; o.x = (unsigned)f2bf(v[j].x * rs * gv.x) | ((unsigned)f2bf(v[j].y * rs * gv.y) << 16);
            o.y = (unsigned)f2bf(v[j].z * rs * gv.z) | ((unsigned)f2bf(v[j].w * rs * gv.w) << 16);
            ((u32x2*)(out + (size_t)r * DM))[lane + 64 * j] = o;
        }
    }
}

struct NEpi { bf16_t* Cb; const bf16_t* gate; const float* resid; float* Cf; int mode, ldc, ldg, ldf; };
static inline NEpi mk_epi(int mode, bf16_t* Cb, int ldc, const bf16_t* gate, int ldg, const float* resid, float* Cf, int ldf) { NEpi e{}; e.Cb = Cb; e.gate = gate; e.resid = resid; e.Cf = Cf; e.mode = mode; e.ldc = ldc; e.ldg = ldg; e.ldf = ldf; return e; }
__global__ void __launch_bounds__(256) k_ngemm(const bf16_t* __restrict__ A, int lda, const float* __restrict__ W, int ldw, int Mr, int N, int K, NEpi E) {
    __shared__ float As[16][68];
    __shared__ float Bs[16][68];
    const int tid = threadIdx.x, tx = tid & 15, ty = tid >> 4;
    const int ntn = N / 64, ntm = Mr / 64;
    for (int tile = blockIdx.x; tile < ntn * ntm; tile += gridDim.x) {
        const int tm = tile / ntn, tn = tile % ntn;
        float acc[4][4];
#pragma unroll
        for (int i = 0; i < 4; ++i)
#pragma unroll
            for (int j = 0; j < 4; ++j) acc[i][j] = 0.f;
        const int ar = tid >> 2, ak = (tid & 3) * 4;
        const int bk = tid >> 4, bn = (tid & 15) * 4;
        const bf16_t* Ap = A + (size_t)(tm * 64 + ar) * lda + ak;
        const float* Wp = W + (size_t)bk * ldw + tn * 64 + bn;
        for (int k0 = 0; k0 < K; k0 += 16) {
            const u32x2 av = *(const u32x2*)(Ap + k0);
            const f32x4 wv = *(const f32x4*)(Wp + (size_t)k0 * ldw);
            __syncthreads();
            As[ak + 0][ar] = __uint_as_float(av.x << 16); As[ak + 1][ar] = __uint_as_float(av.x & 0xffff0000u);
            As[ak + 2][ar] = __uint_as_float(av.y << 16); As[ak + 3][ar] = __uint_as_float(av.y & 0xffff0000u);
            *(f32x4*)&Bs[bk][bn] = wv;
            __syncthreads();
#pragma unroll
            for (int k = 0; k < 16; ++k) {
                const f32x4 a = *(const f32x4*)&As[k][ty * 4];
                const f32x4 b = *(const f32x4*)&Bs[k][tx * 4];
#pragma unroll
                for (int i = 0; i < 4; ++i)
#pragma unroll
                    for (int j = 0; j < 4; ++j) acc[i][j] = fmaf(a[i], b[j], acc[i][j]);
            }
        }
#pragma unroll
        for (int i = 0; i < 4; ++i) {
            const int row = tm * 64 + ty * 4 + i, col = tn * 64 + tx * 4;
#pragma unroll
            for (int j = 0; j < 4; ++j) {
                float v = acc[i][j];
                if (E.mode == 0) E.Cb[(size_t)row * E.ldc + col + j] = f2bf(v);
                else if (E.mode == 1) E.Cb[(size_t)row * E.ldc + col + j] = f2bf(v * bf2f(E.gate[(size_t)row * E.ldg + col + j]));
                else if (E.mode == 2) { bf16_t* p = E.Cb + (size_t)row * E.ldc + col + j; *p = f2bf(bf2f(*p) + v * bf2f(E.gate[(size_t)row * E.ldg + col + j])); }
                else E.Cf[(size_t)row * E.ldf + col + j] = E.resid[(size_t)row * E.ldf + col + j] + v;
            }
        }
    }
}

__global__ void k_proj_post(bf16_t* __restrict__ QKV, bf16_t* __restrict__ G, const float* __restrict__ aqn, const float* __restrict__ akn,
                            const float* __restrict__ bqn, const float* __restrict__ bkn, const float* __restrict__ rope, int do_qkv, int do_g) {
    const int lane = threadIdx.x & 63, wpb = blockDim.x >> 6;
    for (int r = blockIdx.x * wpb + (threadIdx.x >> 6); r < M; r += gridDim.x * wpb) {
        const int pos = r % SEQ;
        bf16_t* q = QKV + (size_t)r * NQKV;
        const float cs = rope[pos * 64 + lane], sn = rope[SEQ * 64 + pos * 64 + lane];
        for (int h = 0; h < (do_qkv ? 36 : 0); ++h) {
            if ((h >= 10 && h < 12) || h >= 28) continue;
            bf16_t* p = q + h * 128;
            const float x1 = bf2f(p[lane]), x2 = bf2f(p[lane + 64]);
            const float rs = rsqrtf(wave_sum(x1 * x1 + x2 * x2) * (1.f / 128.f) + EPS);
            const float* g = h < 8 ? aqn : h < 10 ? akn : h < 20 ? bqn : bkn;
            const float y1 = x1 * rs * g[lane], y2 = x2 * rs * g[lane + 64];
            if (h < 10) { p[lane] = f2bf(y1 * cs - y2 * sn); p[lane + 64] = f2bf(y2 * cs + y1 * sn); }
            else { p[lane] = f2bf(y1); p[lane + 64] = f2bf(y2); }
        }
        bf16_t* gp = G + (size_t)r * NGATE;
        for (int j = 0; j < (do_g ? NGATE / 64 : 0); ++j) { const float v = bf2f(gp[lane + 64 * j]); gp[lane + 64 * j] = f2bf(1.f / (1.f + __expf(-v))); }
    }
}

__global__ void __launch_bounds__(256) k_attn_a(const bf16_t* __restrict__ QKV, const float* __restrict__ sink, bf16_t* __restrict__ OA) {
    __shared__ float qs[4][128];
    __shared__ float ps[4][320];
    const int lane = threadIdx.x & 63, w = threadIdx.x >> 6;
    for (int item = blockIdx.x * 4 + w; item < M * AQH; item += gridDim.x * 4) {
        const int t = item >> 3, h = item & 7, b = t / SEQ, s = t % SEQ, kvh = h >> 2;
        const bf16_t* q = QKV + (size_t)t * NQKV + C_QA + h * 128;
        qs[w][lane] = bf2f(q[lane]); qs[w][lane + 64] = bf2f(q[lane + 64]);
        const int k0 = s - 128 < 0 ? 0 : s - 128, k1 = s + 128 > SEQ - 1 ? SEQ - 1 : s + 128, nk = k1 - k0 + 1;
        float sc[5]; float mx = -1e30f;
#pragma unroll
        for (int i = 0; i < 5; ++i) {
            const int kk = lane + 64 * i; sc[i] = -1e30f;
            if (kk < nk) {
                const bf16_t* kp = QKV + (size_t)(b * SEQ + k0 + kk) * NQKV + C_KA + kvh * 128;
                float d = 0.f;
                for (int c = 0; c < 16; ++c) { const u32x4 kv = *(const u32x4*)(kp + 8 * c);
#pragma unroll
                    for (int e = 0; e < 4; ++e) { d += qs[w][8 * c + 2 * e] * __uint_as_float(kv[e] << 16) + qs[w][8 * c + 2 * e + 1] * __uint_as_float(kv[e] & 0xffff0000u); } }
                sc[i] = d * 0.08838834764831845f;
            }
            mx = fmaxf(mx, sc[i]);
        }
        const float sk = sink[h];
        mx = fmaxf(wave_max(mx), sk);
        float sum = 0.f;
#pragma unroll
        for (int i = 0; i < 5; ++i) { const int kk = lane + 64 * i; if (kk < nk) { const float p = __expf(sc[i] - mx); ps[w][kk] = p; sum += p; } }
        sum = wave_sum(sum) + __expf(sk - mx);
        const float inv = 1.f / sum;
        float o0 = 0.f, o1 = 0.f;
        const bf16_t* vp = QKV + (size_t)(b * SEQ + k0) * NQKV + C_VA + kvh * 128;
        for (int kk = 0; kk < nk; ++kk) { const float p = ps[w][kk]; o0 += p * bf2f(vp[(size_t)kk * NQKV + lane]); o1 += p * bf2f(vp[(size_t)kk * NQKV + lane + 64]); }
        bf16_t* o = OA + (size_t)t * 1024 + h * 128;
        o[lane] = f2bf(o0 * inv); o[lane + 64] = f2bf(o1 * inv);
    }
}

__global__ void __launch_bounds__(256) k_attn_b(const bf16_t* __restrict__ QKV, const float* __restrict__ rpb, bf16_t* __restrict__ OB) {
    __shared__ float qs[4][128];
    __shared__ float ps[4][128];
    const int lane = threadIdx.x & 63, w = threadIdx.x >> 6;
    for (int item = blockIdx.x * 4 + w; item < M * BH; item += gridDim.x * 4) {
        const int t = item >> 3, h = item & 7, b = t / SEQ, s = t % SEQ, qr = s / GW, qc = s % GW;
        const bf16_t* q = QKV + (size_t)t * NQKV + C_QB + h * 128;
        qs[w][lane] = bf2f(q[lane]); qs[w][lane + 64] = bf2f(q[lane + 64]);
        int rs = qr - 4; rs = rs < 0 ? 0 : (rs > GROWS - 8 ? GROWS - 8 : rs);
        int cs = qc - 8; cs = cs < 0 ? 0 : (cs > GW - 16 ? GW - 16 : cs);
        float sc[2]; float mx = -1e30f;
#pragma unroll
        for (int i = 0; i < 2; ++i) {
            const int kk = lane + 64 * i, kr = rs + (kk >> 4), kc = cs + (kk & 15);
            const bf16_t* kp = QKV + (size_t)(b * SEQ + kr * GW + kc) * NQKV + C_KB + h * 128;
            float d = 0.f;
            for (int c = 0; c < 16; ++c) { const u32x4 kv = *(const u32x4*)(kp + 8 * c);
#pragma unroll
                for (int e = 0; e < 4; ++e) { d += qs[w][8 * c + 2 * e] * __uint_as_float(kv[e] << 16) + qs[w][8 * c + 2 * e + 1] * __uint_as_float(kv[e] & 0xffff0000u); } }
            sc[i] = d * 0.08838834764831845f + rpb[(h * 15 + (kr - qr + 7)) * 31 + (kc - qc + 15)];
            mx = fmaxf(mx, sc[i]);
        }
        mx = wave_max(mx);
        float sum = 0.f;
#pragma unroll
        for (int i = 0; i < 2; ++i) { const float p = __expf(sc[i] - mx); ps[w][lane + 64 * i] = p; sum += p; }
        sum = wave_sum(sum);
        const float inv = 1.f / sum;
        float o0 = 0.f, o1 = 0.f;
        for (int kk = 0; kk < 128; ++kk) {
            const int kr = rs + (kk >> 4), kc = cs + (kk & 15);
            const bf16_t* vp = QKV + (size_t)(b * SEQ + kr * GW + kc) * NQKV + C_VB + h * 128;
            const float p = ps[w][kk]; o0 += p * bf2f(vp[lane]); o1 += p * bf2f(vp[lane + 64]);
        }
        bf16_t* o = OB + (size_t)t * 1024 + h * 128;
        o[lane] = f2bf(o0 * inv); o[lane + 64] = f2bf(o1 * inv);
    }
}

__global__ void k_conv_glu(const bf16_t* __restrict__ U, const float* __restrict__ cw, const float* __restrict__ cb, bf16_t* __restrict__ ACT) {
    const size_t n = (size_t)SEQ * DFF;
    for (size_t idx = (size_t)blockIdx.x * blockDim.x + threadIdx.x; idx < n; idx += (size_t)gridDim.x * blockDim.x) {
        const int s = (int)(idx / DFF), j = (int)(idx % DFF);
        float gt = cb[j], vl = cb[j + DFF];
#pragma unroll
        for (int t = 0; t < 3; ++t) {
            const int ss = s + t - 1;
            if (ss >= 0 && ss < SEQ) { gt += cw[t * NUP + j] * bf2f(U[(size_t)ss * NUP + j]); vl += cw[t * NUP + j + DFF] * bf2f(U[(size_t)ss * NUP + j + DFF]); }
        }
        ACT[(size_t)s * DFF + j] = f2bf(gt / (1.f + __expf(-gt)) * vl);
    }
}

}

namespace pg8 {
#define PG8_LAS __attribute__((address_space(3)))
typedef short bf16x8 __attribute__((ext_vector_type(8)));
constexpr int BM = 256, BK = 64, HALF = 128, HTB = HALF * BK * 2  , STAGE_BYTES = 8 * HTB, NXCD = 8, WGM = 8;

__host__ __device__ __forceinline__ int lds_byte(int r, int c) { const int st = (r >> 4) * 2 + (c >> 5), rr = r & 15, cc = c & 31, ob = rr * 64 + cc * 2; return st * 1024 + (ob ^ (((ob >> 9) & 1) << 5)); }
__host__ __device__ __forceinline__ void stage_rc(int b, int& R, int& C) { const int st = b / 1024, sb = b % 1024, swz = sb ^ (((sb >> 9) & 1) << 5); R = (st >> 1) * 16 + swz / 64; C = (st & 1) * 32 + (swz % 64) / 2; }

struct Unit { int pm, pn, sel, idx; };
struct Gemm { const bf16_t* A; const bf16_t* Bt; const bf16_t* A2; const bf16_t* Bt2; int M, N, K; unsigned* dbg; };

template <int NM, int NN, int PAIR = 0>
struct StaticOrderT {
    int G, c, shift;
    __host__ __device__ void init(int G_, int c_, int rot_ = 0) { G = G_; c = c_; constexpr int q = (NM * NN) / NXCD; shift = ((NM * NN) % NXCD == 0 && rot_) ? (32 * rot_) % q : 0; }
    __host__ __device__ bool next(int i, Unit& u) const {
        constexpr int nwg = NM * NN;
        const int ii = PAIR ? (i >> 1) : i; u.sel = PAIR ? (i & 1) : 0; u.idx = i;
        const long L = (long)ii * G + c; if (L >= nwg) return false;
        int wgid = (int)L; { constexpr int q = nwg / NXCD, r = nwg % NXCD; const int xcd = wgid % NXCD; int off = wgid / NXCD;
            if (shift) { off += shift; off -= (off >= q) ? q : 0; }
            wgid = (xcd < r ? xcd * (q + 1) : r * (q + 1) + (xcd - r) * q) + off; }
        constexpr int nig = WGM * NN; const int gid = wgid / nig, fm = gid * WGM, gsz = (NM - fm) < WGM ? (NM - fm) : WGM;
        u.pm = fm + ((wgid % nig) % gsz); u.pn = (wgid % nig) / gsz; return true;
    }
};

typedef float f32x2_t __attribute__((ext_vector_type(2))); typedef int i32x4_t __attribute__((ext_vector_type(4))); typedef __bf16 bf16x2_t __attribute__((ext_vector_type(2)));
__device__ __forceinline__ unsigned cvt_pk_bf16(float lo, float hi) { f32x2_t v = {lo, hi}; bf16x2_t b = __builtin_convertvector(v, bf16x2_t); return __builtin_bit_cast(unsigned, b); }
__device__ __forceinline__ u32x4 pack8(const f32x4& a, const f32x4& b) { u32x4 w; w.x = cvt_pk_bf16(a[0], a[1]); w.y = cvt_pk_bf16(a[2], a[3]); w.z = cvt_pk_bf16(b[0], b[1]); w.w = cvt_pk_bf16(b[2], b[3]); return w; }
__device__ __forceinline__ void unpack8(const u32x4& w, f32x4& a, f32x4& b) {
    a[0] = __uint_as_float(w.x << 16); a[1] = __uint_as_float(w.x & 0xffff0000u); a[2] = __uint_as_float(w.y << 16); a[3] = __uint_as_float(w.y & 0xffff0000u);
    b[0] = __uint_as_float(w.z << 16); b[1] = __uint_as_float(w.z & 0xffff0000u); b[2] = __uint_as_float(w.w << 16); b[3] = __uint_as_float(w.w & 0xffff0000u); }
#define PG8_XBAR() do { asm volatile("s_waitcnt lgkmcnt(0)" ::: "memory"); __builtin_amdgcn_s_barrier(); asm volatile("" ::: "memory"); } while (0)


struct EpiProj {
    static constexpr int VM_MIN = 14;
    bf16_t* QKV; bf16_t* G; const float* norms; const float* rope; const float* rs1; const float* csc; int pm0;
    __device__ __forceinline__ void operator()(f32x4 (&acc)[2][2][4][2], const Unit& u, int wr, int wc, int fr, int fq, PG8_LAS unsigned char* xl) const {
        const int pn = u.pn, hd = wc >> 1, w1 = wc & 1;
        const int colt = 128 * hd + 32 * w1 + 8 * fq;
        const int row0 = u.pm * BM + wr * 64 + fr;
        {
            const bool tab = (u.pm == pm0) && (u.idx < 9);
            const PG8_LAS float* RST = (const PG8_LAS float*)(xl + 4096); const PG8_LAS float* CST = (const PG8_LAS float*)(xl + 7168) + u.idx * 256;
            f32x4 cs[2][2];
#pragma unroll
            for (int bj = 0; bj < 2; ++bj)
#pragma unroll
                for (int n = 0; n < 2; ++n) { cs[bj][n] = tab ? *(const PG8_LAS f32x4*)(CST + 128 * bj + 32 * wc + 16 * n + 4 * fq) : *(const f32x4*)(csc + pn * 256 + 128 * bj + 32 * wc + 16 * n + 4 * fq);
                    if (pn >= 18) cs[bj][n] *= -1.4426950408889634f; }
#pragma unroll
            for (int ai = 0; ai < 2; ++ai)
#pragma unroll
                for (int m = 0; m < 4; ++m) { const float rs = tab ? RST[ai * 128 + wr * 64 + m * 16 + fr] : rs1[row0 + ai * 128 + m * 16];
#pragma unroll
                    for (int bj = 0; bj < 2; ++bj)
#pragma unroll
                        for (int n = 0; n < 2; ++n) { const i32x4_t iv = __builtin_bit_cast(i32x4_t, acc[ai][bj][m][n]); acc[ai][bj][m][n] = __builtin_convertvector(iv, f32x4) * (cs[bj][n] * rs); } }
        }
        if (pn >= 18) {
            unsigned char* base = (unsigned char*)G + (size_t)row0 * NGATE + (pn - 18) * 256 + colt;
#pragma unroll
            for (int ai = 0; ai < 2; ++ai)
#pragma unroll
                for (int m = 0; m < 4; ++m) { unsigned char* rowp = base + (size_t)(ai * 128 + m * 16) * NGATE;
#pragma unroll
                    for (int bj = 0; bj < 2; ++bj) { u32x2 w;
#pragma unroll
                        for (int n = 0; n < 2; ++n) { unsigned pk = 0u;
#pragma unroll
                            for (int e = 0; e < 4; ++e) { const float sg = __builtin_amdgcn_rcpf(fmaf(__builtin_amdgcn_exp2f(acc[ai][bj][m][n][e]), 1.f / 255.f, 1.f / 255.f)); pk = __builtin_amdgcn_cvt_pk_u8_f32(sg, e, pk); }
                            w[n] = pk; }
                        *(u32x2*)(rowp + 64 * bj) = w; } }
            return;
        }
        bf16_t* base = QKV + (size_t)row0 * NQKV + pn * 256 + colt;
        if (pn == 5 || pn >= 14) {
#pragma unroll
            for (int ai = 0; ai < 2; ++ai)
#pragma unroll
                for (int m = 0; m < 4; ++m) { bf16_t* rowp = base + (size_t)(ai * 128 + m * 16) * NQKV;
#pragma unroll
                    for (int bj = 0; bj < 2; ++bj) *(u32x4*)(rowp + 64 * bj) = pack8(acc[ai][bj][m][0], acc[ai][bj][m][1]); }
            return;
        }
        const bool do_rope = pn < 5;
        const float* g = norms + 128 * (pn < 4 ? 0 : pn == 4 ? 1 : pn < 10 ? 2 : 3);
        float ss[2][4];
#pragma unroll
        for (int ai = 0; ai < 2; ++ai)
#pragma unroll
            for (int m = 0; m < 4; ++m) { float s; f32x2_t s2 = {0.f, 0.f};
#pragma unroll
                for (int bj = 0; bj < 2; ++bj)
#pragma unroll
                    for (int n = 0; n < 2; ++n) { const f32x4 v = acc[ai][bj][m][n]; const f32x2_t lo = {v[0], v[1]}, hi = {v[2], v[3]}; s2 = __builtin_elementwise_fma(lo, lo, s2); s2 = __builtin_elementwise_fma(hi, hi, s2); }
                s = s2[0] + s2[1];
                s += __shfl_xor(s, 16); s += __shfl_xor(s, 32); ss[ai][m] = s; }
        PG8_LAS float* X = (PG8_LAS float*)xl;
        if (fq == 0) {
#pragma unroll
            for (int ai = 0; ai < 2; ++ai)
#pragma unroll
                for (int m = 0; m < 4; ++m) X[(ai * 128 + wr * 64 + m * 16 + fr) * 4 + wc] = ss[ai][m];
        }
        PG8_XBAR();
#pragma unroll
        for (int ai = 0; ai < 2; ++ai)
#pragma unroll
            for (int m = 0; m < 4; ++m) ss[ai][m] = __builtin_amdgcn_rsqf((ss[ai][m] + X[(ai * 128 + wr * 64 + m * 16 + fr) * 4 + (wc ^ 1)]) * (1.f / 128.f) + EPS);
        const float qsc = (pn < 4 || (pn >= 6 && pn < 10)) ? 0.08838834764831845f * 1.4426950408889634f : 1.f;
        const PG8_LAS float* gp = (const PG8_LAS float*)(xl + 5120) + (g - norms) + 32 * w1 + 8 * fq;
        const f32x4 g00 = *(const PG8_LAS f32x4*)(gp), g01 = *(const PG8_LAS f32x4*)(gp + 4), g10 = *(const PG8_LAS f32x4*)(gp + 64), g11 = *(const PG8_LAS f32x4*)(gp + 68);
#pragma unroll
        for (int ai = 0; ai < 2; ++ai)
#pragma unroll
            for (int m = 0; m < 4; ++m) {
                const float r = ss[ai][m] * qsc;
                f32x4 a0 = acc[ai][0][m][0] * r * g00, a1 = acc[ai][0][m][1] * r * g01, b0 = acc[ai][1][m][0] * r * g10, b1 = acc[ai][1][m][1] * r * g11;
                if (do_rope) {
                    const int pos = (row0 + ai * 128 + m * 16) & (SEQ - 1);
                    const float* cp = rope + (size_t)pos * 64 + 32 * w1 + 8 * fq;
                    const f32x4 c0 = *(const f32x4*)(cp), c1 = *(const f32x4*)(cp + 4), s0 = *(const f32x4*)(cp + SEQ * 64), s1 = *(const f32x4*)(cp + SEQ * 64 + 4);
                    const f32x4 ta0 = a0 * c0 - b0 * s0, tb0 = b0 * c0 + a0 * s0, ta1 = a1 * c1 - b1 * s1, tb1 = b1 * c1 + a1 * s1;
                    a0 = ta0; b0 = tb0; a1 = ta1; b1 = tb1;
                }
                bf16_t* rowp = base + (size_t)(ai * 128 + m * 16) * NQKV;
                *(u32x4*)(rowp) = pack8(a0, a1); *(u32x4*)(rowp + 64) = pack8(b0, b1);
                if (m & 1) asm volatile("" ::: "memory");
            }
    }
};

struct EpiBranch {
    static constexpr int VM_MIN = 28;
    bf16_t* MG; const bf16_t* G;
    __device__ __forceinline__ void operator()(f32x4 (&acc)[2][2][4][2], const Unit& u, int wr, int wc, int fr, int fq, PG8_LAS unsigned char* xl) const {
        const int row0 = u.pm * BM + wr * 64 + fr, colt = u.pn * 256 + 32 * wc + 8 * fq;
#pragma unroll
        for (int ai = 0; ai < 2; ++ai)
#pragma unroll
            for (int m = 0; m < 4; ++m) { const size_t row = (size_t)(row0 + ai * 128 + m * 16);
#pragma unroll
                for (int bj = 0; bj < 2; ++bj) {
                    const u32x2 gbw = *(const u32x2*)((const unsigned char*)G + row * NGATE + 2048 + colt + 128 * bj);
                    f32x4 b0, b1;
#pragma unroll
                    for (int e = 0; e < 4; ++e) { b0[e] = fmaxf((float)((gbw.x >> (8 * e)) & 255u), 255e-30f); b1[e] = fmaxf((float)((gbw.y >> (8 * e)) & 255u), 255e-30f); }
                    if (u.sel == 0) {
                        const u32x2 gaw = *(const u32x2*)((const unsigned char*)G + row * NGATE + colt + 128 * bj);
                        f32x4 a0, a1;
#pragma unroll
                        for (int e = 0; e < 4; ++e) { a0[e] = (float)((gaw.x >> (8 * e)) & 255u); a1[e] = (float)((gaw.y >> (8 * e)) & 255u); b0[e] = __builtin_amdgcn_rcpf(b0[e]); b1[e] = __builtin_amdgcn_rcpf(b1[e]); }
                        acc[ai][bj][m][0] *= a0 * b0; acc[ai][bj][m][1] *= a1 * b1;
                    } else {
                        *(u32x4*)(MG + row * DM + colt + 128 * bj) = pack8(acc[ai][bj][m][0] * (b0 * (1.f / 255.f)), acc[ai][bj][m][1] * (b1 * (1.f / 255.f)));
                    }
                }
                if (m & 1) asm volatile("" ::: "memory"); }
    }
};

struct EpiOut {
    static constexpr int VM_MIN = 40;
    const float* x; float* X1; bf16_t* X1B; float* SSQ;
    __device__ __forceinline__ void operator()(f32x4 (&acc)[2][2][4][2], const Unit& u, int wr, int wc, int fr, int fq, PG8_LAS unsigned char* xl) const {
        const int row0 = u.pm * BM + wr * 64 + fr, colt = u.pn * 256 + 32 * wc + 8 * fq;
        PG8_LAS float* X = (PG8_LAS float*)xl;
#pragma unroll
        for (int ai = 0; ai < 2; ++ai)
#pragma unroll
            for (int m = 0; m < 4; ++m) { const size_t row = (size_t)(row0 + ai * 128 + m * 16); float s = 0.f;
#pragma unroll
                for (int bj = 0; bj < 2; ++bj) {
                    const size_t off = row * DM + colt + 128 * bj;
                    const f32x4 v0 = *(const f32x4*)(x + off) + acc[ai][bj][m][0], v1 = *(const f32x4*)(x + off + 4) + acc[ai][bj][m][1];
                    *(u32x4*)(X1B + off) = pack8(v0, v1);
                    s += (v0[0] * v0[0] + v0[1] * v0[1]) + (v0[2] * v0[2] + v0[3] * v0[3]) + (v1[0] * v1[0] + v1[1] * v1[1]) + (v1[2] * v1[2] + v1[3] * v1[3]);
                }
                s += __shfl_xor(s, 16); s += __shfl_xor(s, 32);
                if (fq == 0) X[(ai * 128 + wr * 64 + m * 16 + fr) * 4 + wc] = s; }
        PG8_XBAR();
        if (wc == 0 && fq == 0) {
#pragma unroll
            for (int ai = 0; ai < 2; ++ai)
#pragma unroll
                for (int m = 0; m < 4; ++m) { const int r = ai * 128 + wr * 64 + m * 16 + fr; const f32x4 p = *(const PG8_LAS f32x4*)(X + r * 4);
                    SSQ[(size_t)(u.pm * BM + r) * 8 + u.pn] = (p[0] + p[1]) + (p[2] + p[3]); }
        }
    }
};

struct EpiUp {
    static constexpr int VM_MIN = 8;
    bf16_t* ACT; float* HALO; const float* SSQ; const float* cw; const float* cb; int pm0;
    __device__ __forceinline__ void operator()(f32x4 (&acc)[2][2][4][2], const Unit& u, int wr, int wc, int fr, int fq, PG8_LAS unsigned char* xl) const {
        const int lane = fq * 16 + fr, wid = wr * 4 + wc;
        const int rowb = u.pm * BM + wr * 64 + 4 * fr;
        const int ucol = u.pn * 128 + wc * 32 + 8 * fq;
        PG8_LAS f32x4* E = (PG8_LAS f32x4*)xl;
        PG8_LAS float* CF = (PG8_LAS float*)(xl + 8192);
        {
            const float* src = (wid < 6 ? cw + (size_t)(wid >> 1) * NUP : cb) + (wid & 1) * DFF + u.pn * 128;
            const float fs = (wid & 1) ? -0.6931471805599453f : -1.4426950408889634f;
            const float c0 = src[lane] * fs, c1 = src[lane + 64] * fs;
            CF[wid * 128 + lane] = c0; CF[wid * 128 + lane + 64] = c1;
        }
        const PG8_LAS float* RS = (const PG8_LAS float*)(xl + 12288);
        const bool rs_lds = (u.pm == pm0);
#pragma unroll
        for (int ai = 0; ai < 2; ++ai)
#pragma unroll
            for (int m = 0; m < 4; ++m) { float r;
                if (rs_lds) r = RS[ai * 128 + wr * 64 + 4 * fr + m];
                else { const float* sp = SSQ + (size_t)(rowb + ai * 128 + m) * 8; const f32x4 a = *(const f32x4*)sp, b = *(const f32x4*)(sp + 4);
                    r = __builtin_amdgcn_rsqf(((a[0] + a[1]) + (a[2] + a[3]) + (b[0] + b[1]) + (b[2] + b[3])) * (1.f / DM) + EPS); }
#pragma unroll
                for (int bj = 0; bj < 2; ++bj)
#pragma unroll
                    for (int n = 0; n < 2; ++n) acc[ai][bj][m][n] *= r;
                if (m & 1) asm volatile("" ::: "memory"); }
        if (wr == 0 && fr == 0) {
#pragma unroll
            for (int mm = 0; mm < 2; ++mm)
#pragma unroll
                for (int bj = 0; bj < 2; ++bj)
#pragma unroll
                    for (int n = 0; n < 2; ++n) *(f32x4*)(HALO + (size_t)(u.pm * 4 + mm) * NUP + bj * DFF + ucol + 4 * n) = acc[0][bj][mm][n];
        }
        if (wr == 1 && fr == 15) {
#pragma unroll
            for (int mm = 2; mm < 4; ++mm)
#pragma unroll
                for (int bj = 0; bj < 2; ++bj)
#pragma unroll
                    for (int n = 0; n < 2; ++n) *(f32x4*)(HALO + (size_t)(u.pm * 4 + mm) * NUP + bj * DFF + ucol + 4 * n) = acc[1][bj][mm][n];
        }
        if (fr == 0) {
#pragma unroll
            for (int ai = 0; ai < 2; ++ai)
#pragma unroll
                for (int bj = 0; bj < 2; ++bj)
#pragma unroll
                    for (int n = 0; n < 2; ++n) E[((wid * 2 + ai) * 2 + 0) * 16 + 8 * bj + 4 * n + fq] = acc[ai][bj][0][n];
        }
        if (fr == 15) {
#pragma unroll
            for (int ai = 0; ai < 2; ++ai)
#pragma unroll
                for (int bj = 0; bj < 2; ++bj)
#pragma unroll
                    for (int n = 0; n < 2; ++n) E[((wid * 2 + ai) * 2 + 1) * 16 + 8 * bj + 4 * n + fq] = acc[ai][bj][3][n];
        }
        PG8_XBAR();
        __builtin_amdgcn_sched_barrier(0);
        const PG8_LAS float* Ef = (const PG8_LAS float*)E;
        const PG8_LAS float* cfp = CF + 32 * wc + 8 * fq;
#pragma unroll
        for (int n = 0; n < 2; ++n) {
#pragma unroll
            for (int ep = 0; ep < 2; ++ep) {
                f32x2_t cf[8];
#pragma unroll
                for (int k = 0; k < 8; ++k) cf[k] = *(const PG8_LAS f32x2_t*)(cfp + k * 128 + 4 * n + 2 * ep);
#pragma unroll
                for (int ai = 0; ai < 2; ++ai) {
                    const bool pext = (wr == 0 && ai == 0), next_ext = (wr == 1 && ai == 1);
                    const int pidx = wr == 1 ? (((wid - 4) * 2 + ai) * 2 + 1) * 16 : (((wid + 4) * 2 + 0) * 2 + 1) * 16;
                    const int nidx = wr == 0 ? (((wid + 4) * 2 + ai) * 2 + 0) * 16 : (((wid - 4) * 2 + 1) * 2 + 0) * 16;
                    f32x2_t o[2][4], Uv[2][4];
#pragma unroll
                    for (int bj = 0; bj < 2; ++bj)
#pragma unroll
                        for (int m = 0; m < 4; ++m) { Uv[bj][m][0] = acc[ai][bj][m][n][2 * ep]; Uv[bj][m][1] = acc[ai][bj][m][n][2 * ep + 1]; }
                    asm volatile("" : "+v"(Uv[0][0]), "+v"(Uv[0][1]), "+v"(Uv[0][2]), "+v"(Uv[0][3]), "+v"(Uv[1][0]), "+v"(Uv[1][1]), "+v"(Uv[1][2]), "+v"(Uv[1][3]));
#pragma unroll
                    for (int bj = 0; bj < 2; ++bj) {
                        f32x2_t pe = {0.f, 0.f}, ne = {0.f, 0.f};
                        if (!pext) pe = *(const PG8_LAS f32x2_t*)(Ef + (pidx + 8 * bj + 4 * n + fq) * 4 + 2 * ep);
                        if (!next_ext) ne = *(const PG8_LAS f32x2_t*)(Ef + (nidx + 8 * bj + 4 * n + fq) * 4 + 2 * ep);
                        f32x2_t pA, nA;
#pragma unroll
                        for (int c = 0; c < 2; ++c) {
                            pA[c] = __int_as_float(__builtin_amdgcn_update_dpp(__float_as_int(pe[c]), __float_as_int(Uv[bj][3][c]), 0x111, 0xF, 0xF, false));
                            nA[c] = __int_as_float(__builtin_amdgcn_update_dpp(__float_as_int(ne[c]), __float_as_int(Uv[bj][0][c]), 0x101, 0xF, 0xF, false));
                        }
#pragma unroll
                        for (int m = 0; m < 4; ++m) {
                            const f32x2_t pv = m == 0 ? pA : Uv[bj][m == 0 ? 0 : m - 1];
                            const f32x2_t nx = m == 3 ? nA : Uv[bj][m == 3 ? 3 : m + 1];
                            o[bj][m] = __builtin_elementwise_fma(cf[bj], pv, __builtin_elementwise_fma(cf[2 + bj], Uv[bj][m], __builtin_elementwise_fma(cf[4 + bj], nx, cf[6 + bj])));
                        }
                    }
                    f32x2_t rs[4];
#pragma unroll
                    for (int m = 0; m < 4; ++m) { const f32x2_t t = o[0][m]; f32x2_t d; d[0] = __builtin_amdgcn_exp2f(t[0]); d[1] = __builtin_amdgcn_exp2f(t[1]); d = d + 1.f;
                        f32x2_t rc; rc[0] = __builtin_amdgcn_rcpf(d[0]); rc[1] = __builtin_amdgcn_rcpf(d[1]); rs[m] = (t * rc) * o[1][m]; }
                    asm volatile("" : "+v"(rs[0]), "+v"(rs[1]), "+v"(rs[2]), "+v"(rs[3]));
#pragma unroll
                    for (int m = 0; m < 4; ++m) { acc[ai][0][m][n][2 * ep] = rs[m][0]; acc[ai][0][m][n][2 * ep + 1] = rs[m][1]; }
                    __builtin_amdgcn_sched_barrier(0);
                }
            }
        }
#pragma unroll
        for (int ai = 0; ai < 2; ++ai)
#pragma unroll
            for (int m = 0; m < 4; ++m) { *(u32x4*)(ACT + (size_t)(rowb + ai * 128 + m) * DFF + ucol) = pack8(acc[ai][0][m][0], acc[ai][0][m][1]);
                if (m & 1) asm volatile("" ::: "memory"); }
    }
};

struct EpiDown {
    static constexpr int VM_MIN = 40;
    float* out; const bf16_t* X1B;
    __device__ __forceinline__ void operator()(f32x4 (&acc)[2][2][4][2], const Unit& u, int wr, int wc, int fr, int fq, PG8_LAS unsigned char* xl) const {
        const int row0 = u.pm * BM + wr * 64 + fr, colt = u.pn * 256 + 32 * wc + 8 * fq;
#pragma unroll
        for (int ai = 0; ai < 2; ++ai)
#pragma unroll
            for (int m = 0; m < 4; ++m) { const size_t rowoff = (size_t)(row0 + ai * 128 + m * 16) * DM + colt;
#pragma unroll
                for (int bj = 0; bj < 2; ++bj) { const u32x4 xw = *(const u32x4*)(X1B + rowoff + 128 * bj); f32x4 x0, x1; unpack8(xw, x0, x1);
                    float* op = out + rowoff + 128 * bj; *(f32x4*)op = x0 + acc[ai][bj][m][0]; *(f32x4*)(op + 4) = x1 + acc[ai][bj][m][1]; }
                if (m & 1) asm volatile("" ::: "memory"); }
    }
};

template <int EREP = 1, int KREP = 1, bool I8 = false, bool APERM = false, class Epi, class Sched>
__device__ __forceinline__ void gemm_phase(PG8_LAS unsigned char* lds, PG8_LAS unsigned char* xl, const Gemm g, const Sched& S, const Epi& E) {
    const int tid = threadIdx.x, wid = __builtin_amdgcn_readfirstlane(tid >> 6), lane = tid & 63, wr = wid >> 2, wc = wid & 3, fr = lane & 15, fq = lane >> 4;
    const int K = g.K, nt = K / BK;
    unsigned voffA[2], voffB[2];
#pragma unroll
    for (int i = 0; i < 2; ++i) { int R, C; stage_rc(tid * 16 + i * 8192, R, C); const int Ra = APERM ? ((R & 64) | ((R & 15) << 2) | ((R >> 4) & 3)) : R;
        voffA[i] = (unsigned)(Ra * K + C) * 2u; voffB[i] = (unsigned)(R * K + C) * 2u; }
    const size_t kstep = (size_t)(BK * 2);
    const size_t hstep = (size_t)HALF * K * 2;
    const size_t tstep = 2 * hstep;
    const unsigned ldsw = (unsigned)wid * 1024u;
    const int aoff = lds_byte(wr * 64 + fr, fq * 8), boff = lds_byte(wc * 32 + fr, fq * 8);
#define PG8_SA(b, h) (((b) * 2 + (h)) * HTB)
#define PG8_SB(b, h) ((4 + (b) * 2 + (h)) * HTB)
#define PG8_STAGE_V(bufoff, gbase, voff) do { _Pragma("unroll") for (int _i = 0; _i < 2; ++_i) \
        __builtin_amdgcn_global_load_lds((const unsigned*)((const char*)(gbase) + (voff)[_i]), (PG8_LAS unsigned*)(lds + (bufoff) + ldsw + _i * 8192), 16, 0, 0); } while (0)
#define PG8_STAGE(bufoff, gbase) PG8_STAGE_V(bufoff, gbase, ((bufoff) >= 4 * HTB ? voffB : voffA))
#define PG8_LDA(dst, b, h) do { _Pragma("unroll") for (int m = 0; m < 4; ++m) _Pragma("unroll") for (int k = 0; k < 2; ++k) dst[m][k] = *(const PG8_LAS bf16x8*)(lds + PG8_SA(b, h) + aoff + m * 2048 + k * 1024); } while (0)
#define PG8_LDB(dst, b, h) do { _Pragma("unroll") for (int n = 0; n < 2; ++n) _Pragma("unroll") for (int k = 0; k < 2; ++k) dst[n][k] = *(const PG8_LAS bf16x8*)(lds + PG8_SB(b, h) + boff + n * 2048 + k * 1024); } while (0)
    typedef int i32x4 __attribute__((ext_vector_type(4)));
#define PG8_MMA(ai, bj, At, Bt) do { __builtin_amdgcn_s_setprio(1); _Pragma("unroll") for (int m = 0; m < 4; ++m) _Pragma("unroll") for (int n = 0; n < 2; ++n) _Pragma("unroll") for (int k = 0; k < 2; ++k) { \
        if constexpr (I8) acc[ai][bj][m][n] = __builtin_bit_cast(f32x4, __builtin_amdgcn_mfma_i32_16x16x64_i8(__builtin_bit_cast(i32x4, Bt[n][k]), __builtin_bit_cast(i32x4, At[m][k]), __builtin_bit_cast(i32x4, acc[ai][bj][m][n]), 0, 0, 0)); \
        else acc[ai][bj][m][n] = __builtin_amdgcn_mfma_f32_16x16x32_bf16(Bt[n][k], At[m][k], acc[ai][bj][m][n], 0, 0, 0); } __builtin_amdgcn_s_setprio(0); } while (0)
#define PG8_WAIT_V(n) asm volatile("s_waitcnt vmcnt(" #n ")" ::: "memory")
#define PG8_WAIT_VI(n) asm volatile("s_waitcnt vmcnt(%0)" :: "n"(n) : "memory")
#define PG8_WAIT_V8R() do { if (relax) PG8_WAIT_VI(8 + Epi::VM_MIN); else PG8_WAIT_V(8); } while (0)
#define PG8_WAIT_L(n) asm volatile("s_waitcnt lgkmcnt(" #n ")" ::: "memory")
#define PG8_BAR __builtin_amdgcn_s_barrier()
#define PG8_SCHED __builtin_amdgcn_sched_barrier(0)
#if defined(DBGT) && DBGT
#define PG8_STAMP(slot) do { if (g.dbg && wid == 0 && lane == 0) g.dbg[ui * 4 + (slot)] = (unsigned)__builtin_amdgcn_s_memrealtime(); } while (0)
#else
#define PG8_STAMP(slot) do {} while (0)
#endif
#define PG8_UA(u) ((const char*)((u).sel ? g.A2 : g.A) + (size_t)(u).pm * tstep)
#define PG8_UB(u) ((const char*)((u).sel ? g.Bt2 : g.Bt) + (size_t)(u).pn * tstep)
    Unit cur, nxt; int ui = 0;
    if (!S.next(0, cur)) return;
    f32x4 acc[2][2][4][2];
#pragma unroll
    for (int a = 0; a < 2; ++a)
#pragma unroll
        for (int b = 0; b < 2; ++b)
#pragma unroll
            for (int m = 0; m < 4; ++m)
#pragma unroll
                for (int n = 0; n < 2; ++n) acc[a][b][m][n] = (f32x4){0.f, 0.f, 0.f, 0.f};
    bf16x8 At[4][2], B0[2][2], B1[2][2];
    const char* cA = PG8_UA(cur); const char* cB = PG8_UB(cur);
    PG8_STAGE(PG8_SB(0, 0), cB); PG8_STAGE(PG8_SB(0, 1), cB + hstep); PG8_STAGE(PG8_SA(0, 0), cA); PG8_STAGE(PG8_SA(0, 1), cA + hstep);
    if (wr == 1) PG8_BAR;
    PG8_WAIT_V(2); PG8_BAR;
    PG8_STAGE(PG8_SB(1, 0), cB + kstep); PG8_STAGE(PG8_SA(1, 0), cA + kstep); PG8_STAGE(PG8_SB(1, 1), cB + hstep + kstep);
    PG8_WAIT_V(6); PG8_BAR;
    for (;;) {
        const bool has_next = S.next(ui + 1, nxt);
        const char* nA = has_next ? PG8_UA(nxt) : cA; const char* nB = has_next ? PG8_UB(nxt) : cB;
        PG8_STAMP(0);
        for (int krep = 0; krep < KREP; ++krep)
        for (int t = 0; t < nt; t += 2) {
            if (KREP > 1 && krep > 0 && t == 0) {
#pragma unroll
                for (int a = 0; a < 2; ++a)
#pragma unroll
                    for (int b = 0; b < 2; ++b)
#pragma unroll
                        for (int m = 0; m < 4; ++m)
#pragma unroll
                            for (int n = 0; n < 2; ++n) acc[a][b][m][n] = (f32x4){0.f, 0.f, 0.f, 0.f};
            }
            const bool last = (t == nt - 2) && (krep == KREP - 1);
            const char* a1 = cA + (size_t)(t + 1) * kstep;
            const bool wrap = (t == nt - 2) && !last;
            const char* a2 = last ? nA : (wrap ? cA : cA + (size_t)(t + 2) * kstep); const char* b2 = last ? nB : (wrap ? cB : cB + (size_t)(t + 2) * kstep);
            const char* a3 = a2 + kstep; const char* b3 = b2 + kstep;
#ifdef NO_RELAX
            constexpr bool relax = false;
#else
            const bool relax = (t == 0) && (ui > 0) && (krep == 0);
#endif
            PG8_LDB(B0, 0, 0); PG8_LDB(B1, 0, 1); PG8_SCHED; PG8_LDA(At, 0, 0); PG8_STAGE(PG8_SA(1, 1), a1 + hstep);
            PG8_WAIT_V8R(); PG8_WAIT_L(0); PG8_BAR; PG8_MMA(0, 0, At, B0); PG8_MMA(0, 1, At, B1); PG8_BAR; PG8_SCHED;
            PG8_LDA(At, 0, 1); PG8_STAGE(PG8_SB(0, 0), b2); PG8_STAGE(PG8_SB(0, 1), b2 + hstep); PG8_STAGE(PG8_SA(0, 0), a2);
            PG8_WAIT_V8R(); PG8_WAIT_L(0); PG8_BAR; PG8_MMA(1, 0, At, B0); PG8_MMA(1, 1, At, B1); PG8_BAR; PG8_SCHED;
            PG8_LDB(B0, 1, 0); PG8_LDB(B1, 1, 1); PG8_SCHED; PG8_LDA(At, 1, 0); PG8_STAGE(PG8_SA(0, 1), a2 + hstep);
            PG8_WAIT_V(8); PG8_WAIT_L(0); PG8_BAR; PG8_MMA(0, 0, At, B0); PG8_MMA(0, 1, At, B1); PG8_BAR; PG8_SCHED;
            PG8_LDA(At, 1, 1); PG8_STAGE(PG8_SB(1, 0), b3); PG8_STAGE(PG8_SB(1, 1), b3 + hstep); PG8_STAGE(PG8_SA(1, 0), a3);
            PG8_WAIT_V(8); PG8_WAIT_L(0); PG8_BAR; PG8_MMA(1, 0, At, B0); PG8_MMA(1, 1, At, B1); PG8_BAR; PG8_SCHED;
        }
        PG8_STAMP(1);
        if (wr == 0) PG8_BAR;
        PG8_STAMP(2);
#pragma unroll
        for (int er = 0; er < EREP; ++er) E(acc, cur, wr, wc, fr, fq, xl);
        PG8_STAMP(3);
        if (!has_next) break;
        if (nxt.sel == 0) {
#pragma unroll
            for (int a = 0; a < 2; ++a)
#pragma unroll
                for (int b = 0; b < 2; ++b)
#pragma unroll
                    for (int m = 0; m < 4; ++m)
#pragma unroll
                        for (int n = 0; n < 2; ++n) acc[a][b][m][n] = (f32x4){0.f, 0.f, 0.f, 0.f};
        }
        cur = nxt; cA = nA; cB = nB; ++ui;
        if (wr == 1) PG8_BAR;
    }
    PG8_WAIT_V(0);
    PG8_BAR;
#undef PG8_SA
#undef PG8_SB
#undef PG8_STAGE
#undef PG8_STAGE_V
#undef PG8_LDA
#undef PG8_LDB
#undef PG8_MMA
#undef PG8_WAIT_V
#undef PG8_WAIT_VI
#undef PG8_WAIT_V8R
#undef PG8_WAIT_L
#undef PG8_BAR
#undef PG8_SCHED
#undef PG8_UA
#undef PG8_STAMP
#undef PG8_UB
}
}

constexpr int NWAVES = 8;
constexpr int N_PHASES = 8;
constexpr int RING_OFF = 0, RING_BYTES = 131072;
constexpr int LDSCTL_OFF = RING_BYTES, MISC_OFF = LDSCTL_OFF + 320, XCH_OFF = RING_BYTES + 1024;
constexpr int LDS_BYTES = 151552;
static_assert(XCH_OFF + 16384 <= LDS_BYTES, "LDS map");
constexpr int CW_BAR = 4096;
constexpr size_t WO_IN = 0, WO_A = (size_t)NIN * DM * 2, WO_B = WO_A + (size_t)DM * 1024 * 2, WO_OUT = WO_B + (size_t)DM * 1024 * 2, WO_UP = WO_OUT + (size_t)DM * DM * 2, WO_DN = WO_UP + (size_t)NUP * DM * 2;
static_assert(WS_W + WO_DN + (size_t)DM * DFF * 2 <= WS_QKV, "weights fit");

#define GAS __attribute__((address_space(1)))
#define LAS __attribute__((address_space(3)))
typedef GAS unsigned gu32;
#define RLX_AGENT __ATOMIC_RELAXED, __HIP_MEMORY_SCOPE_AGENT
#define LDS_WAIT() asm volatile("s_waitcnt lgkmcnt(0)" ::: "memory")

#define XB_TMO      128
#define XB_XCNT(j)  (256  + 64 * (j))
#define XB_XSUB(j)  (1280 + 64 * (j))
#define XB_XGEN(j)  (2304 + 64 * (j))
#define XB_TOP      3328
#define XB_TOPGEN   3392
#define XCD_BAR_WORDS 3456
#define XB_SPIN_CAP (1u << 18)
__device__ __forceinline__ unsigned xb_ld(unsigned* p)              { return __hip_atomic_load(p, __ATOMIC_RELAXED, __HIP_MEMORY_SCOPE_AGENT); }
__device__ __forceinline__ unsigned xb_add(unsigned* p, unsigned v) { return __hip_atomic_fetch_add(p, v, __ATOMIC_RELAXED, __HIP_MEMORY_SCOPE_AGENT); }
__device__ __forceinline__ unsigned xb_xcc_id() { return (unsigned)__builtin_amdgcn_s_getreg((3 << 11) | 20) & 0xFu; }
#define XB_SPIN(cond, bar) do { unsigned _sp = 0; while (cond) { __builtin_amdgcn_s_sleep(1); \
    if ((++_sp & 255u) == 0u) { if (xb_ld(&(bar)[XB_TMO])) break; if (_sp > XB_SPIN_CAP) { atomicAdd(&(bar)[XB_TMO], 1u); break; } } } } while (0)
struct XcdBarrier { unsigned* bar; unsigned x; volatile LAS unsigned* st; };
__device__ __forceinline__ XcdBarrier xcd_barrier_post(unsigned* bar, volatile LAS unsigned* st) {
    XcdBarrier b; b.bar = bar; b.x = xb_xcc_id(); b.st = st;
    if (threadIdx.x == 0) st[2] = xb_add(&bar[XB_XCNT(b.x)], 1u);
    return b;
}
__device__ __forceinline__ void xcd_barrier_complete(unsigned* bar, unsigned x, unsigned& nloc, unsigned& nx, unsigned& uni) {
    const unsigned G = gridDim.x * gridDim.y * gridDim.z;
    unsigned sum, cnt, mine, sp = 0u, low8;
    for (;;) {
        sum = 0u; cnt = 0u; mine = 0u; low8 = 1u;
#pragma unroll
        for (unsigned j = 0; j < 16; ++j) { const unsigned c = xb_ld(&bar[XB_XCNT(j)]); sum += c; cnt += (c > 0u) ? 1u : 0u; mine = (j == x) ? c : mine; if (c != (j < 8u ? 32u : 0u)) low8 = 0u; }
        if (sum == G) break;
        __builtin_amdgcn_s_sleep(1);
        if ((++sp & 255u) == 0u) { if (xb_ld(&bar[XB_TMO])) break; if (sp > XB_SPIN_CAP) { atomicAdd(&bar[XB_TMO], 1u); break; } }
    }
    nloc = mine > 0u ? mine : 1u; nx = cnt > 0u ? cnt : 1u; uni = (sum == G) ? low8 : 0u;
}
template <bool FENCE = true>
__device__ __forceinline__ void xcd_barrier(const XcdBarrier& b) {
    asm volatile("s_waitcnt vmcnt(0)" ::: "memory");
    __syncthreads();
    if (threadIdx.x == 0) {
        unsigned* bar = b.bar;
        __builtin_amdgcn_s_waitcnt(0);
        unsigned nloc = b.st[0], nx = b.st[1];
        if (nloc == 0u) { unsigned uni; xcd_barrier_complete(bar, b.x, nloc, nx, uni); b.st[0] = nloc; b.st[1] = nx; b.st[3] = uni; }
        const unsigned old = xb_add(&bar[XB_XSUB(b.x)], 1u);
        const unsigned gen = old / nloc;
        if (old + 1u == (gen + 1u) * nloc) {
            if (FENCE) __builtin_amdgcn_fence(__ATOMIC_RELEASE, "agent");
            asm volatile("s_waitcnt vmcnt(0)" ::: "memory");
            const unsigned og = xb_add(&bar[XB_TOP], 1u);
            const unsigned tg = og / nx;
            if (og + 1u == (tg + 1u) * nx) xb_add(&bar[XB_TOPGEN], 1u);
            else XB_SPIN(xb_ld(&bar[XB_TOPGEN]) == tg, bar);
            if (FENCE) __builtin_amdgcn_fence(__ATOMIC_ACQUIRE, "agent");
            xb_add(&bar[XB_XGEN(b.x)], 1u);
            asm volatile("s_waitcnt vmcnt(0)" ::: "memory");
        } else {
            XB_SPIN(xb_ld(&bar[XB_XGEN(b.x)]) == gen, bar);
            if (FENCE) __builtin_amdgcn_fence(__ATOMIC_ACQUIRE, "agent");
            asm volatile("s_waitcnt vmcnt(0)" ::: "memory");
        }
    }
    __syncthreads();
}

__device__ __forceinline__ void xcd_barrier_local(const XcdBarrier& b) {
    asm volatile("s_waitcnt vmcnt(0)" ::: "memory");
    __syncthreads();
    if (threadIdx.x == 0) {
        unsigned* bar = b.bar;
        __builtin_amdgcn_s_waitcnt(0);
        const unsigned nloc = b.st[0];
        const unsigned old = xb_add(&bar[XB_XSUB(b.x)], 1u);
        const unsigned gen = old / nloc;
        if (old + 1u == (gen + 1u) * nloc) xb_add(&bar[XB_XGEN(b.x)], 1u);
        else XB_SPIN(xb_ld(&bar[XB_XGEN(b.x)]) == gen, bar);
        __builtin_amdgcn_fence(__ATOMIC_ACQUIRE, "agent");
        asm volatile("s_waitcnt vmcnt(0)" ::: "memory");
    }
    __syncthreads();
}

__device__ __forceinline__ unsigned pk2(float lo, float hi) { return (unsigned)f2bf(lo) | ((unsigned)f2bf(hi) << 16); }
__device__ __forceinline__ int map_head(int c) { const int cc = c & 255; return (c & ~255) + 128 * ((cc >> 6) & 1) + 32 * (2 * (cc >> 7) + ((cc >> 5) & 1)) + 16 * ((cc >> 2) & 1) + 4 * ((cc >> 3) & 3) + (cc & 3); }
__device__ __forceinline__ int map_p32(int c) { return (c & ~31) + 16 * ((c >> 2) & 1) + 4 * ((c >> 3) & 3) + (c & 3); }
__device__ __forceinline__ int map_up(int c) { const int half = c >= DFF ? 1 : 0, cc = c - half * DFF, j = cc & 127; return 256 * (cc >> 7) + 128 * half + (j & ~31) + 16 * ((j >> 2) & 1) + 4 * ((j >> 3) & 3) + (j & 3); }
__device__ __forceinline__ void p0_item_load(f32x4 (&v)[16], const float* __restrict__ W, int N, int item, int lane) {
    const int nblk = N >> 6, kb = item / nblk, nb = item - kb * nblk;
    const float* base = W + (size_t)(64 * kb + (lane >> 4)) * N + 64 * nb + 4 * (lane & 15);
#pragma unroll
    for (int i = 0; i < 16; ++i) v[i] = *(const f32x4*)(base + (size_t)(4 * i) * N);
}
__device__ __forceinline__ void p0_lds_write(const f32x4 (&v)[16], int k0, const float* __restrict__ ksc, LAS float* T, int lane) {
    const int kr = lane >> 4, q4 = 4 * (lane & 15);
#pragma unroll
    for (int i = 0; i < 16; ++i) { const int k = 4 * i + kr; const float sc = ksc ? ksc[k0 + k] : 1.f;
#pragma unroll
        for (int e = 0; e < 4; ++e) T[k * 64 + ((q4 + e) ^ (k & 31))] = v[i][e] * sc; }
}
template <int MAP>
__device__ __forceinline__ void p0_lds_read_store(bf16_t* __restrict__ WT, int K, int N, LAS float* T, int item, int lane) {
    const int nblk = N >> 6, kb = item / nblk, nb = item - kb * nblk, k0 = 64 * kb, n0 = 64 * nb;
    const int c = lane >> 3, nl = lane & 7;
#pragma unroll
    for (int j = 0; j < 8; ++j) { const int n = nl + 8 * j; float f[8];
#pragma unroll
        for (int i = 0; i < 8; ++i) { const int k = 8 * c + i; f[i] = T[k * 64 + (n ^ (k & 31))]; }
        u32x4 o; o.x = pk2(f[0], f[1]); o.y = pk2(f[2], f[3]); o.z = pk2(f[4], f[5]); o.w = pk2(f[6], f[7]);
        const int src = n0 + n; const int dst = MAP == 0 ? map_head(src) : MAP == 1 ? map_p32(src) : MAP == 2 ? map_up(src) : src;
        *(u32x4*)(WT + (size_t)dst * K + k0 + 8 * c) = o; }
}

struct Args { const float* in[17]; float* out; unsigned char* ws; int ph_lo, ph_hi, li, pad; };

__device__ __forceinline__ void attn_a_item(const bf16_t* __restrict__ QKV, const float* __restrict__ sink, bf16_t* __restrict__ OA, int item, LAS float* scr, int lane) {
    LAS float* qs = scr; LAS float* ps = scr + 128;
    const int t = item >> 3, h = item & 7, b = t / SEQ, s = t % SEQ, kvh = h >> 2;
    const bf16_t* q = QKV + (size_t)t * NQKV + C_QA + h * 128;
    qs[lane] = bf2f(q[lane]); qs[lane + 64] = bf2f(q[lane + 64]);
    const int k0 = s - 128 < 0 ? 0 : s - 128, k1 = s + 128 > SEQ - 1 ? SEQ - 1 : s + 128, nk = k1 - k0 + 1;
    float sc[5]; float mx = -1e30f;
#pragma unroll
    for (int i = 0; i < 5; ++i) {
        const int kk = lane + 64 * i; sc[i] = -1e30f;
        if (kk < nk) {
            const bf16_t* kp = QKV + (size_t)(b * SEQ + k0 + kk) * NQKV + C_KA + kvh * 128;
            float d = 0.f;
            for (int c = 0; c < 16; ++c) { const u32x4 kv = *(const u32x4*)(kp + 8 * c);
#pragma unroll
                for (int e = 0; e < 4; ++e) { d += qs[8 * c + 2 * e] * __uint_as_float(kv[e] << 16) + qs[8 * c + 2 * e + 1] * __uint_as_float(kv[e] & 0xffff0000u); } }
            sc[i] = d * 0.08838834764831845f;
        }
        mx = fmaxf(mx, sc[i]);
    }
    const float sk = sink[h];
    mx = fmaxf(wave_max(mx), sk);
    float sum = 0.f;
#pragma unroll
    for (int i = 0; i < 5; ++i) { const int kk = lane + 64 * i; if (kk < nk) { const float p = __expf(sc[i] - mx); ps[kk] = p; sum += p; } }
    sum = wave_sum(sum) + __expf(sk - mx);
    const float inv = 1.f / sum;
    float o0 = 0.f, o1 = 0.f;
    const bf16_t* vp = QKV + (size_t)(b * SEQ + k0) * NQKV + C_VA + kvh * 128;
    for (int kk = 0; kk < nk; ++kk) { const float p = ps[kk]; o0 += p * bf2f(vp[(size_t)kk * NQKV + lane]); o1 += p * bf2f(vp[(size_t)kk * NQKV + lane + 64]); }
    bf16_t* o = OA + (size_t)t * 1024 + h * 128;
    o[lane] = f2bf(o0 * inv); o[lane + 64] = f2bf(o1 * inv);
}
__device__ __forceinline__ void attn_b_item(const bf16_t* __restrict__ QKV, const float* __restrict__ rpb, bf16_t* __restrict__ OB, int item, LAS float* scr, int lane) {
    LAS float* qs = scr; LAS float* ps = scr + 128;
    const int t = item >> 3, h = item & 7, b = t / SEQ, s = t % SEQ, qr = s / GW, qc = s % GW;
    const bf16_t* q = QKV + (size_t)t * NQKV + C_QB + h * 128;
    qs[lane] = bf2f(q[lane]); qs[lane + 64] = bf2f(q[lane + 64]);
    int rs = qr - 4; rs = rs < 0 ? 0 : (rs > GROWS - 8 ? GROWS - 8 : rs);
    int cs = qc - 8; cs = cs < 0 ? 0 : (cs > GW - 16 ? GW - 16 : cs);
    float sc[2]; float mx = -1e30f;
#pragma unroll
    for (int i = 0; i < 2; ++i) {
        const int kk = lane + 64 * i, kr = rs + (kk >> 4), kc = cs + (kk & 15);
        const bf16_t* kp = QKV + (size_t)(b * SEQ + kr * GW + kc) * NQKV + C_KB + h * 128;
        float d = 0.f;
        for (int c = 0; c < 16; ++c) { const u32x4 kv = *(const u32x4*)(kp + 8 * c);
#pragma unroll
            for (int e = 0; e < 4; ++e) { d += qs[8 * c + 2 * e] * __uint_as_float(kv[e] << 16) + qs[8 * c + 2 * e + 1] * __uint_as_float(kv[e] & 0xffff0000u); } }
        sc[i] = d * 0.08838834764831845f + rpb[(h * 15 + (kr - qr + 7)) * 31 + (kc - qc + 15)];
        mx = fmaxf(mx, sc[i]);
    }
    mx = wave_max(mx);
    float sum = 0.f;
#pragma unroll
    for (int i = 0; i < 2; ++i) { const float p = __expf(sc[i] - mx); ps[lane + 64 * i] = p; sum += p; }
    sum = wave_sum(sum);
    const float inv = 1.f / sum;
    float o0 = 0.f, o1 = 0.f;
    for (int kk = 0; kk < 128; ++kk) {
        const int kr = rs + (kk >> 4), kc = cs + (kk & 15);
        const bf16_t* vp = QKV + (size_t)(b * SEQ + kr * GW + kc) * NQKV + C_VB + h * 128;
        const float p = ps[kk]; o0 += p * bf2f(vp[lane]); o1 += p * bf2f(vp[lane + 64]);
    }
    bf16_t* o = OB + (size_t)t * 1024 + h * 128;
    o[lane] = f2bf(o0 * inv); o[lane + 64] = f2bf(o1 * inv);
}


namespace att {
typedef short bf16x8 __attribute__((ext_vector_type(8)));
typedef short s16x4 __attribute__((ext_vector_type(4)));
typedef float f32x16 __attribute__((ext_vector_type(16)));
constexpr int KT = 64 * 256, VT = 64 * 256;
constexpr int OFF_K = 0, OFF_V = 3 * KT, OFF_RPB = 3 * KT + 4 * VT, ATT_LDS = OFF_RPB + 2048;
constexpr float SC_L2 = 0.08838834764831845f * 1.4426950408889634f;
constexpr float L2E = 1.4426950408889634f;
constexpr float NEGBIG = -1e30f;

__device__ __forceinline__ s16x4 vtr(const LAS char* p) { return __builtin_bit_cast(s16x4, __builtin_amdgcn_ds_read_tr16_b64_v4i16((LAS s16x4*)p)); }

template <int KIND = 0>
__device__ __forceinline__ void stage_dma(const bf16_t* __restrict__ QKV, int tok0, int kcol, int vcol, LAS char* Kt, LAS char* Vt, int wave) {
    int l; asm volatile("v_mbcnt_lo_u32_b32 %0, -1, 0\n\tv_mbcnt_hi_u32_b32 %0, -1, %0" : "=v"(l));
#pragma unroll
    for (int i = 0; i < 2; ++i) { const int blk = 2 * wave + i, r = blk * 4 + (l >> 4), p = l & 15;
        const int key = KIND ? r : ((r & ~12) | ((r & 4) << 1) | ((r & 8) >> 1));
        const bf16_t* ks = QKV + (size_t)(tok0 + key) * NQKV + kcol + ((p ^ (r & 15)) << 3);
        const bf16_t* vs = QKV + (size_t)(tok0 + r) * NQKV + vcol + ((p ^ (KIND ? ((r & 7) << 1) : ((r & 3) << 2))) << 3);
        __builtin_amdgcn_global_load_lds((const unsigned*)ks, (LAS unsigned*)(Kt + blk * 1024), 16, 0, 0);
        __builtin_amdgcn_global_load_lds((const unsigned*)vs, (LAS unsigned*)(Vt + blk * 1024), 16, 0, 0); }
}
#define ATT_WAIT_V(n) asm volatile("s_waitcnt vmcnt(" #n ")" ::: "memory")

#ifndef ATT_PV_DEPTH
#define ATT_PV_DEPTH 4
#endif
#ifndef ATT_QK_DEPTH
#define ATT_QK_DEPTH 2
#endif
#define ATT_DSR_TR(dst, addr, off) asm volatile("ds_read_b64_tr_b16 %0, %1 offset:%2" : "=v"(dst) : "v"(addr), "n"(off) : "memory")
#define ATT_DSR_128(dst, addr, off) asm volatile("ds_read_b128 %0, %1 offset:%2" : "=v"(dst) : "v"(addr), "n"(off) : "memory")
#define ATT_WAIT_L2(a, b, n) asm volatile("s_waitcnt lgkmcnt(%2)" : "+v"(a), "+v"(b) : "n"(n) : "memory")
template <int MODE, bool HASB, class Mid>
__device__ __forceinline__ void tile_qksm(const LAS char* Kt, const bf16x8 (&qf)[8], bf16x8 (&pf)[4], float& l, int lane_, unsigned M0, unsigned M1, float negC, const LAS float* brow, const Mid& mid) {
    int lane; asm volatile("v_mbcnt_lo_u32_b32 %0, -1, 0\n\tv_mbcnt_hi_u32_b32 %0, -1, %0" : "=v"(lane)); (void)lane_;
    const int r32 = lane & 31, hi = lane >> 5;
    f32x16 S0, S1;
#pragma unroll
    for (int g = 0; g < 16; ++g) { S0[g] = negC; S1[g] = negC; }
    const unsigned kb = (unsigned)(unsigned long)Kt, kz = (unsigned)r32 * 256u + (unsigned)((hi ^ (r32 & 15)) << 4);
    constexpr int KD = ATT_QK_DEPTH; bf16x8 kf[2 * KD];
#define QK_ISSUE(d) do { if constexpr ((d) < 8) { const unsigned ka = (kz ^ (unsigned)((d) << 5)) + kb; ATT_DSR_128(kf[2 * ((d) % KD)], ka, 0); ATT_DSR_128(kf[2 * ((d) % KD) + 1], ka, 8192); } } while (0)
#define QK_STEP(d) do { ATT_WAIT_L2(kf[2 * ((d) % KD)], kf[2 * ((d) % KD) + 1], 2 * (((d) + KD - 1 < 7 ? (d) + KD - 1 : 7) - (d))); \
        S0 = __builtin_amdgcn_mfma_f32_32x32x16_bf16(kf[2 * ((d) % KD)], qf[d], S0, 0, 0, 0); S1 = __builtin_amdgcn_mfma_f32_32x32x16_bf16(kf[2 * ((d) % KD) + 1], qf[d], S1, 0, 0, 0); \
        QK_ISSUE((d) + KD); __builtin_amdgcn_sched_barrier(0); } while (0)
    QK_ISSUE(0); QK_ISSUE(1); if constexpr (KD > 2) { QK_ISSUE(2); }
    QK_STEP(0); QK_STEP(1); QK_STEP(2); QK_STEP(3); QK_STEP(4); QK_STEP(5); QK_STEP(6); QK_STEP(7);
#undef QK_ISSUE
#undef QK_STEP
    mid();
    float ps = 0.f;
#define ATT_SM(S, blk, Mb) _Pragma("unroll") for (int g = 0; g < 16; ++g) { \
            const bool skip = (MODE == 2 && (blk) == 1 && g >= 8) || (MODE == 3 && (blk) == 0 && g < 8); \
            if (skip) { S[g] = 0.f; } else { \
            const int kk = (g & 7) + 8 * hi + 16 * (g >> 3) + 32 * (blk); \
            float t = S[g]; \
            if (HASB) t += brow[kk]; \
            if (MODE != 0) { const unsigned m = (unsigned)(((int)((Mb) << (31 - g))) >> 31); t = __uint_as_float((__float_as_uint(t) & m) | (0xF149F2CAu & ~m)); } \
            S[g] = __builtin_amdgcn_exp2f(t); ps += S[g]; } }
    if (MODE == 1) {
        const int q8 = (int)M0;
        if (M1 == 0u) {
#pragma unroll
            for (int g = 0; g < 16; ++g) { S0[g] = __builtin_amdgcn_exp2f(S0[g]); S1[g] = __builtin_amdgcn_exp2f(S1[g]); ps += S0[g] + S1[g]; }
        } else if (M1 == 1u) {
#pragma unroll
            for (int g = 0; g < 16; ++g) { const int kc = (g & 7) + 16 * (g >> 3);
                S0[g] = __builtin_amdgcn_exp2f(kc >= q8 ? S0[g] : NEGBIG); S1[g] = __builtin_amdgcn_exp2f(kc + 32 >= q8 ? S1[g] : NEGBIG); ps += S0[g] + S1[g]; }
        } else {
#pragma unroll
            for (int g = 0; g < 16; ++g) { const int kc = (g & 7) + 16 * (g >> 3);
                S0[g] = __builtin_amdgcn_exp2f(kc <= q8 ? S0[g] : NEGBIG); S1[g] = __builtin_amdgcn_exp2f(kc + 32 <= q8 ? S1[g] : NEGBIG); ps += S0[g] + S1[g]; }
        }
    } else {
    ATT_SM(S0, 0, M0)
    ATT_SM(S1, 1, M1)
    }
#undef ATT_SM
    l += ps;
#pragma unroll
    for (int s2 = 0; s2 < 2; ++s2) {
        u32x4 w0, w1;
#pragma unroll
        for (int j = 0; j < 4; ++j) { w0[j] = pg8::cvt_pk_bf16(S0[8 * s2 + 2 * j], S0[8 * s2 + 2 * j + 1]); w1[j] = pg8::cvt_pk_bf16(S1[8 * s2 + 2 * j], S1[8 * s2 + 2 * j + 1]); }
        pf[s2] = __builtin_bit_cast(bf16x8, w0); pf[2 + s2] = __builtin_bit_cast(bf16x8, w1);
    }
}
template <int MODE>
__device__ __forceinline__ void tile_pv(const LAS char* Vt, const bf16x8 (&pf)[4], f32x16 (&o)[4], int lane_) {
    int lane; asm volatile("v_mbcnt_lo_u32_b32 %0, -1, 0\n\tv_mbcnt_hi_u32_b32 %0, -1, %0" : "=v"(lane)); (void)lane_;
    const int hi = lane >> 5, l16 = lane & 15, gi = lane >> 4;
    const unsigned vz = (unsigned)(8 * hi + (l16 >> 2)) * 256u + (unsigned)((l16 >> 2) << 6) + (unsigned)(32 * (gi & 1) + 8 * (l16 & 3));
    constexpr int NK = (MODE >= 2) ? 12 : 16;
    unsigned vb[4];
#pragma unroll
    for (int db = 0; db < 4; ++db) vb[db] = (unsigned)(unsigned long)Vt + (vz ^ (unsigned)(db << 6));
    constexpr int PD = ATT_PV_DEPTH; s16x4 fa[PD], fb[PD];
#define PV_DB(i) (MODE >= 2 ? (i) / 3 : (i) / 4)
#define PV_KS(i) (MODE == 2 ? (i) % 3 : MODE == 3 ? 1 + (i) % 3 : (i) % 4)
#define PV_ISSUE(i) do { if constexpr ((i) < NK) { ATT_DSR_TR(fa[(i) % PD], vb[PV_DB(i)], PV_KS(i) * 4096); ATT_DSR_TR(fb[(i) % PD], vb[PV_DB(i)], PV_KS(i) * 4096 + 1024); } } while (0)
#define PV_STEP(i) do { if constexpr ((i) < NK) { ATT_WAIT_L2(fa[(i) % PD], fb[(i) % PD], 2 * (((i) + PD - 1 < NK - 1 ? (i) + PD - 1 : NK - 1) - (i))); \
        const bf16x8 vf = {fa[(i) % PD][0], fa[(i) % PD][1], fa[(i) % PD][2], fa[(i) % PD][3], fb[(i) % PD][0], fb[(i) % PD][1], fb[(i) % PD][2], fb[(i) % PD][3]}; \
        o[PV_DB(i)] = __builtin_amdgcn_mfma_f32_32x32x16_bf16(vf, pf[PV_KS(i)], o[PV_DB(i)], 0, 0, 0); PV_ISSUE((i) + PD); __builtin_amdgcn_sched_barrier(0); } } while (0)
    PV_ISSUE(0); PV_ISSUE(1); PV_ISSUE(2); PV_ISSUE(3); if constexpr (PD > 4) { PV_ISSUE(4); } if constexpr (PD > 5) { PV_ISSUE(5); }
    PV_STEP(0); PV_STEP(1); PV_STEP(2); PV_STEP(3); PV_STEP(4); PV_STEP(5); PV_STEP(6); PV_STEP(7);
    PV_STEP(8); PV_STEP(9); PV_STEP(10); PV_STEP(11); PV_STEP(12); PV_STEP(13); PV_STEP(14); PV_STEP(15);
#undef PV_DB
#undef PV_KS
#undef PV_ISSUE
#undef PV_STEP
}

__device__ __forceinline__ void store_o(const f32x16 (&o)[4], float l, bf16_t* __restrict__ orow, int lane) {
    const int hi = lane >> 5;
    const float lt = l + __shfl_xor(l, 32), inv = 1.f / lt;
    bf16_t* dst = orow + 8 * hi;
#pragma unroll
    for (int db = 0; db < 4; ++db)
#pragma unroll
        for (int gp = 0; gp < 2; ++gp) {
            u32x2 a, b;
            a.x = pg8::cvt_pk_bf16(o[db][8 * gp] * inv, o[db][8 * gp + 1] * inv); a.y = pg8::cvt_pk_bf16(o[db][8 * gp + 2] * inv, o[db][8 * gp + 3] * inv);
            b.x = pg8::cvt_pk_bf16(o[db][8 * gp + 4] * inv, o[db][8 * gp + 5] * inv); b.y = pg8::cvt_pk_bf16(o[db][8 * gp + 6] * inv, o[db][8 * gp + 7] * inv);
            { auto r = __builtin_amdgcn_permlane32_swap(a.x, b.x, false, false); a.x = r[0]; b.x = r[1]; }
            { auto r = __builtin_amdgcn_permlane32_swap(a.y, b.y, false, false); a.y = r[0]; b.y = r[1]; }
            u32x4 w; w.x = a.x; w.y = a.y; w.z = b.x; w.w = b.y;
            *(u32x4*)(dst + 32 * db + 16 * gp) = w;
        }
}
__device__ __forceinline__ float qk_bound_l2(const float* __restrict__ gq, const float* __restrict__ gk, int lane) {
    const float a = wave_max(fmaxf(fabsf(gq[lane]), fabsf(gq[lane + 64]))), b = wave_max(fmaxf(fabsf(gk[lane]), fabsf(gk[lane + 64])));
    return 1.01f * 11.313708498984761f * L2E * a * b;
}

__device__ __forceinline__ void unit_a(LAS char* L, const bf16_t* __restrict__ QKV, const float* __restrict__ sink, float cqk, bf16_t* __restrict__ OA, int ua, int tid, int wave, int lane) {
    const int b = ua >> 7, kvh = (ua >> 6) & 1, n2 = ua & 63, q0 = n2 * 64;
    const int head = kvh * 4 + (wave >> 1), qi = 32 * (wave & 1) + (lane & 31), hi = lane >> 5;
    const int tokq = b * SEQ + q0 + qi;
    bf16x8 qf[8];
    { const bf16_t* qp = QKV + (size_t)tokq * NQKV + C_QA + head * 128 + 8 * hi;
#pragma unroll
      for (int ds = 0; ds < 8; ++ds) qf[ds] = *(const bf16x8*)(qp + 16 * ds); }
    f32x16 o[4];
#pragma unroll
    for (int d = 0; d < 4; ++d)
#pragma unroll
        for (int g = 0; g < 16; ++g) o[d][g] = 0.f;
    const float sk = sink[head] * L2E, C = fmaxf(cqk, sk);
    float l = hi == 0 ? __builtin_amdgcn_exp2f(sk - C) : 0.f;
    const unsigned q8 = (unsigned)(qi - 8 * hi);
    const int t_lo = q0 >= 128 ? 0 : (q0 >= 64 ? 1 : 2), t_hi = q0 + 191 < SEQ ? 5 : (q0 + 127 < SEQ ? 4 : 3);
    const int kcol = C_KA + kvh * 128, vcol = C_VA + kvh * 128, tokb = b * SEQ + q0 - 128;
    const bool late = wave >= 4;
    bf16x8 pf[4];
    const int nt = t_hi - t_lo;
    stage_dma(QKV, tokb + 64 * t_lo, kcol, vcol, L + OFF_K, L + OFF_V, wave);
    stage_dma(QKV, tokb + 64 * (t_lo + 1), kcol, vcol, L + OFF_K + KT, L + OFF_V + VT, wave);
    ATT_WAIT_V(4); PG8_XBAR();
    int kcur = 0, kn1 = KT, kn2 = 2 * KT, vprev = 3 * VT, vcur = 0, vn1 = VT, vn2 = 2 * VT;
    for (int i = 0; i < nt; ++i) {
        const int t = t_lo + i;
        if (late && i > 0) tile_pv<1>(L + OFF_V + vprev, pf, o, lane);
        tile_qksm<1, false>(L + OFF_K + kcur, qf, pf, l, lane, q8, t == 0 ? 1u : (t == 4 ? 2u : 0u), -C, nullptr,
                            [&]() { if (i + 2 < nt) stage_dma(QKV, tokb + 64 * (t + 2), kcol, vcol, L + OFF_K + kn2, L + OFF_V + vn2, wave); });
        if (!late) tile_pv<1>(L + OFF_V + vcur, pf, o, lane);
        if (i + 2 < nt) ATT_WAIT_V(4); else ATT_WAIT_V(0);
        PG8_XBAR();
        { const int k0 = kcur; kcur = kn1; kn1 = kn2; kn2 = k0; const int v0 = vprev; vprev = vcur; vcur = vn1; vn1 = vn2; vn2 = v0; }
    }
    if (late) tile_pv<1>(L + OFF_V + vprev, pf, o, lane);
    PG8_XBAR();
    store_o(o, l, OA + (size_t)tokq * 1024 + head * 128, lane);
}

template <int HF>
__device__ __forceinline__ void unit_b(LAS char* L, const bf16_t* __restrict__ QKV, const float* __restrict__ rpb, float cqk, bf16_t* __restrict__ OB, int ub, int tid, int wave, int lane) {
    const int b = ub >> 7, h = (ub >> 4) & 7, rb = (ub >> 1) & 7; constexpr int hf = HF;
    const int qr = 8 * rb + wave, qc = 32 * hf + (lane & 31), hi = lane >> 5;
    const int tokq = b * SEQ + qr * GW + qc;
    LAS float* rp = (LAS float*)(L + OFF_RPB);
    float bmax = 0.f;
    { const float v0 = tid < 15 * 31 ? rpb[h * 15 * 31 + tid] * L2E : 0.f; if (tid < 15 * 31) rp[tid] = v0;
      bmax = wave_max(fabsf(wave < 8 ? rpb[h * 15 * 31 + (lane < 58 ? lane * 8 : 0)] : 0.f)); }
    { float mx = 0.f;
#pragma unroll
      for (int i = 0; i < 8; ++i) { const int j = lane * 8 + i; mx = fmaxf(mx, j < 15 * 31 ? fabsf(rpb[h * 15 * 31 + j]) : 0.f); }
      bmax = wave_max(mx) * L2E; }
    const float C = cqk + bmax;
    bf16x8 qf[8];
    { const bf16_t* qp = QKV + (size_t)tokq * NQKV + C_QB + h * 128 + 8 * hi;
#pragma unroll
      for (int ds = 0; ds < 8; ++ds) qf[ds] = *(const bf16x8*)(qp + 16 * ds); }
    f32x16 o[4];
#pragma unroll
    for (int d = 0; d < 4; ++d)
#pragma unroll
        for (int g = 0; g < 16; ++g) o[d][g] = 0.f;
    float l = 0.f;
    int rs = qr - 4; rs = rs < 0 ? 0 : (rs > GROWS - 8 ? GROWS - 8 : rs);
    int cs = qc - 8; cs = cs < 0 ? 0 : (cs > GW - 16 ? GW - 16 : cs);
    unsigned M0 = 0u, M1 = 0u;
#pragma unroll
    for (int g = 0; g < 16; ++g) { const int kk = (g & 7) + 8 * hi + 16 * (g >> 3);
        M0 |= ((kk >= cs && kk < cs + 16) ? 1u : 0u) << g; M1 |= ((kk + 32 >= cs && kk + 32 < cs + 16) ? 1u : 0u) << g; }
    int kr_lo = 8 * rb - 4; kr_lo = kr_lo < 0 ? 0 : (kr_lo > GROWS - 8 ? GROWS - 8 : kr_lo);
    int kr_hi = 8 * rb + 3; kr_hi = (kr_hi < 0 ? 0 : (kr_hi > GROWS - 8 ? GROWS - 8 : kr_hi)) + 8;
    const int kcol = C_KB + h * 128, vcol = C_VB + h * 128, tokb = b * SEQ;
    const bool late = wave >= 4;
    bf16x8 pf[4]; bool have = false;
    stage_dma(QKV, tokb + GW * kr_lo, kcol, vcol, L + OFF_K, L + OFF_V, wave);
    stage_dma(QKV, tokb + GW * (kr_lo + 1), kcol, vcol, L + OFF_K + KT, L + OFF_V + VT, wave);
    ATT_WAIT_V(4); PG8_XBAR();
    int kcur = 0, kn1 = KT, kn2 = 2 * KT, vprev = 3 * VT, vcur = 0, vn1 = VT, vn2 = 2 * VT;
    for (int kr = kr_lo; kr < kr_hi; ++kr) {
        if (late && have) tile_pv<2 + HF>(L + OFF_V + vprev, pf, o, lane);
        have = (kr >= rs && kr < rs + 8);
        if (have) {
            const LAS float* brow = rp + (kr - qr + 7) * 31 + 15 - qc;
            tile_qksm<2 + HF, true>(L + OFF_K + kcur, qf, pf, l, lane, M0, M1, -C, brow,
                                    [&]() { if (kr + 2 < kr_hi) stage_dma(QKV, tokb + GW * (kr + 2), kcol, vcol, L + OFF_K + kn2, L + OFF_V + vn2, wave); });
            if (!late) tile_pv<2 + HF>(L + OFF_V + vcur, pf, o, lane);
        } else if (kr + 2 < kr_hi) stage_dma(QKV, tokb + GW * (kr + 2), kcol, vcol, L + OFF_K + kn2, L + OFF_V + vn2, wave);
        if (kr + 2 < kr_hi) ATT_WAIT_V(4); else ATT_WAIT_V(0);
        PG8_XBAR();
        { const int k0 = kcur; kcur = kn1; kn1 = kn2; kn2 = k0; const int v0 = vprev; vprev = vcur; vcur = vn1; vn1 = vn2; vn2 = v0; }
    }
    if (late && have) tile_pv<2 + HF>(L + OFF_V + vprev, pf, o, lane);
    PG8_XBAR();
    store_o(o, l, OB + (size_t)tokq * 1024 + h * 128, lane);
}

template <int HF>
__device__ __forceinline__ void unit_b16(LAS char* L, const bf16_t* __restrict__ QKV, const float* __restrict__ rpb, float cqk, bf16_t* __restrict__ OB, int ub, int tid, int wave, int lane) {
    const int b = ub >> 7, h = (ub >> 4) & 7, rb = (ub >> 1) & 7;
    const int fr = lane & 15, fq = lane >> 4;
    const int qr = 8 * rb + wave;
    constexpr int KB0 = HF ? 24 : 0, KB1 = HF ? 32 : 8;
    LAS float* rp = (LAS float*)(L + OFF_RPB);
    float bmax;
    { const float v0 = tid < 15 * 31 ? rpb[h * 15 * 31 + tid] * L2E : 0.f; if (tid < 15 * 31) rp[tid] = v0; }
    { float mx = 0.f;
#pragma unroll
      for (int i = 0; i < 8; ++i) { const int j = lane * 8 + i; mx = fmaxf(mx, j < 15 * 31 ? fabsf(rpb[h * 15 * 31 + j]) : 0.f); }
      bmax = wave_max(mx) * L2E; }
    const float C = cqk + bmax;
    bf16x8 qf[2][4];
    unsigned vm = 0u;
#pragma unroll
    for (int g = 0; g < 2; ++g) { const int qc = 32 * HF + 16 * g + fr, kb = g ? KB1 : KB0;
        const bf16_t* qp = QKV + (size_t)(b * SEQ + qr * GW + qc) * NQKV + C_QB + h * 128 + 8 * fq;
#pragma unroll
        for (int dc = 0; dc < 4; ++dc) qf[g][dc] = *(const bf16x8*)(qp + 32 * dc);
        int cs = qc - 8; cs = cs < 0 ? 0 : (cs > GW - 16 ? GW - 16 : cs);
#pragma unroll
        for (int sb = 0; sb < 2; ++sb)
#pragma unroll
            for (int e = 0; e < 4; ++e) { const int kk = kb + 16 * sb + 4 * fq + e; vm |= ((kk >= cs && kk < cs + 16) ? 1u : 0u) << (8 * g + 4 * sb + e); } }
    f32x4 o[2][8];
#pragma unroll
    for (int g = 0; g < 2; ++g)
#pragma unroll
        for (int d = 0; d < 8; ++d) o[g][d] = (f32x4){0.f, 0.f, 0.f, 0.f};
    float l0 = 0.f, l1 = 0.f;
    int rs = qr - 4; rs = rs < 0 ? 0 : (rs > GROWS - 8 ? GROWS - 8 : rs);
    int kr_lo = 8 * rb - 4; kr_lo = kr_lo < 0 ? 0 : (kr_lo > GROWS - 8 ? GROWS - 8 : kr_lo);
    int kr_hi = 8 * rb + 3; kr_hi = (kr_hi < 0 ? 0 : (kr_hi > GROWS - 8 ? GROWS - 8 : kr_hi)) + 8;
    const int kcol = C_KB + h * 128, vcol = C_VB + h * 128, tokb = b * SEQ;
    stage_dma<1>(QKV, tokb + GW * kr_lo, kcol, vcol, L + OFF_K, L + OFF_V, wave);
    stage_dma<1>(QKV, tokb + GW * (kr_lo + 1), kcol, vcol, L + OFF_K + KT, L + OFF_V + VT, wave);
    ATT_WAIT_V(4); PG8_XBAR();
    int kcur = 0, kn1 = KT, kn2 = 2 * KT, vcur = 0, vn1 = VT, vn2 = 2 * VT;
    for (int kr = kr_lo; kr < kr_hi; ++kr) {
        const bool have = (kr >= rs && kr < rs + 8);
        if (have) {
            int ln; asm volatile("v_mbcnt_lo_u32_b32 %0, -1, 0\n\tv_mbcnt_hi_u32_b32 %0, -1, %0" : "=v"(ln));
            const int r_ = ln & 15, q_ = ln >> 4;
            f32x4 S[2][2];
#pragma unroll
            for (int g = 0; g < 2; ++g)
#pragma unroll
                for (int sb = 0; sb < 2; ++sb) S[g][sb] = (f32x4){-C, -C, -C, -C};
            const unsigned kbase = (unsigned)(unsigned long)(L + OFF_K + kcur);
            const unsigned kz0 = (unsigned)(KB0 + r_) * 256u + (unsigned)((q_ ^ ((KB0 + r_) & 15)) << 4), kz1 = (unsigned)(KB1 + r_) * 256u + (unsigned)((q_ ^ ((KB1 + r_) & 15)) << 4);
            bf16x8 kf[4];
#define B16_QK_ISSUE(s_) do { if constexpr ((s_) < 8) { const unsigned ka = ((((s_) >> 2) ? kz1 : kz0) ^ (unsigned)(((s_) & 3) << 6)) + kbase; ATT_DSR_128(kf[2 * ((s_) & 1)], ka, 0); ATT_DSR_128(kf[2 * ((s_) & 1) + 1], ka, 4096); } } while (0)
#define B16_QK_STEP(s_) do { ATT_WAIT_L2(kf[2 * ((s_) & 1)], kf[2 * ((s_) & 1) + 1], ((s_) < 7 ? 2 : 0)); \
                S[(s_) >> 2][0] = __builtin_amdgcn_mfma_f32_16x16x32_bf16(kf[2 * ((s_) & 1)], qf[(s_) >> 2][(s_) & 3], S[(s_) >> 2][0], 0, 0, 0); \
                S[(s_) >> 2][1] = __builtin_amdgcn_mfma_f32_16x16x32_bf16(kf[2 * ((s_) & 1) + 1], qf[(s_) >> 2][(s_) & 3], S[(s_) >> 2][1], 0, 0, 0); \
                B16_QK_ISSUE((s_) + 2); __builtin_amdgcn_sched_barrier(0); } while (0)
            B16_QK_ISSUE(0); B16_QK_ISSUE(1);
            B16_QK_STEP(0); B16_QK_STEP(1); B16_QK_STEP(2); B16_QK_STEP(3); B16_QK_STEP(4); B16_QK_STEP(5); B16_QK_STEP(6); B16_QK_STEP(7);
#undef B16_QK_ISSUE
#undef B16_QK_STEP
            if (kr + 2 < kr_hi) stage_dma<1>(QKV, tokb + GW * (kr + 2), kcol, vcol, L + OFF_K + kn2, L + OFF_V + vn2, wave);
            bf16x8 pf[2];
#pragma unroll
            for (int g = 0; g < 2; ++g) { const int qc = 32 * HF + 16 * g + r_;
                const LAS float* brow = rp + (kr - qr + 7) * 31 + 15 - qc + (g ? KB1 : KB0) + 4 * q_;
                float ps = 0.f; float pv[8];
#pragma unroll
                for (int sb = 0; sb < 2; ++sb)
#pragma unroll
                    for (int e = 0; e < 4; ++e) { float t = S[g][sb][e] + brow[16 * sb + e];
                        t = ((vm >> (8 * g + 4 * sb + e)) & 1u) ? t : NEGBIG;
                        const float pe = __builtin_amdgcn_exp2f(t); pv[4 * sb + e] = pe; ps += pe; }
                if (g) l1 += ps; else l0 += ps;
                u32x4 w; w.x = pg8::cvt_pk_bf16(pv[0], pv[1]); w.y = pg8::cvt_pk_bf16(pv[2], pv[3]); w.z = pg8::cvt_pk_bf16(pv[4], pv[5]); w.w = pg8::cvt_pk_bf16(pv[6], pv[7]);
                pf[g] = __builtin_bit_cast(bf16x8, w); }
            const unsigned vbase = (unsigned)(unsigned long)(L + OFF_V + vcur);
            const unsigned vr0 = (unsigned)(KB0 + 4 * q_ + (r_ >> 2)), vr1 = (unsigned)(KB1 + 4 * q_ + (r_ >> 2));
            const unsigned vz0 = vr0 * 256u + ((vr0 & 7u) << 5) + (unsigned)((r_ & 3) * 8), vz1 = vr1 * 256u + ((vr1 & 7u) << 5) + (unsigned)((r_ & 3) * 8);
            s16x4 fa[4], fb[4];
#define B16_PV_ISSUE(i_) do { if constexpr ((i_) < 16) { const unsigned va = ((((i_) >> 3) ? vz1 : vz0) ^ (unsigned)(((i_) & 7) << 5)) + vbase; ATT_DSR_TR(fa[(i_) & 3], va, 0); ATT_DSR_TR(fb[(i_) & 3], va, 4096); } } while (0)
#define B16_PV_STEP(i_) do { ATT_WAIT_L2(fa[(i_) & 3], fb[(i_) & 3], 2 * (((i_) + 3 < 15 ? (i_) + 3 : 15) - (i_))); \
                const bf16x8 vf = {fa[(i_) & 3][0], fa[(i_) & 3][1], fa[(i_) & 3][2], fa[(i_) & 3][3], fb[(i_) & 3][0], fb[(i_) & 3][1], fb[(i_) & 3][2], fb[(i_) & 3][3]}; \
                o[(i_) >> 3][(i_) & 7] = __builtin_amdgcn_mfma_f32_16x16x32_bf16(vf, pf[(i_) >> 3], o[(i_) >> 3][(i_) & 7], 0, 0, 0); B16_PV_ISSUE((i_) + 4); __builtin_amdgcn_sched_barrier(0); } while (0)
            B16_PV_ISSUE(0); B16_PV_ISSUE(1); B16_PV_ISSUE(2); B16_PV_ISSUE(3);
            B16_PV_STEP(0); B16_PV_STEP(1); B16_PV_STEP(2); B16_PV_STEP(3); B16_PV_STEP(4); B16_PV_STEP(5); B16_PV_STEP(6); B16_PV_STEP(7);
            B16_PV_STEP(8); B16_PV_STEP(9); B16_PV_STEP(10); B16_PV_STEP(11); B16_PV_STEP(12); B16_PV_STEP(13); B16_PV_STEP(14); B16_PV_STEP(15);
#undef B16_PV_ISSUE
#undef B16_PV_STEP
        } else if (kr + 2 < kr_hi) stage_dma<1>(QKV, tokb + GW * (kr + 2), kcol, vcol, L + OFF_K + kn2, L + OFF_V + vn2, wave);
        if (kr + 2 < kr_hi) ATT_WAIT_V(4); else ATT_WAIT_V(0);
        PG8_XBAR();
        { const int k0 = kcur; kcur = kn1; kn1 = kn2; kn2 = k0; const int v0 = vcur; vcur = vn1; vn1 = vn2; vn2 = v0; }
    }
#pragma unroll
    for (int g = 0; g < 2; ++g) { float lt = g ? l1 : l0; lt += __shfl_xor(lt, 16); lt += __shfl_xor(lt, 32); const float inv = 1.f / lt;
        bf16_t* orow = OB + (size_t)(b * SEQ + qr * GW + 32 * HF + 16 * g + fr) * 1024 + h * 128 + 4 * fq;
#pragma unroll
        for (int db = 0; db < 8; ++db) { u32x2 w; w.x = pg8::cvt_pk_bf16(o[g][db][0] * inv, o[g][db][1] * inv); w.y = pg8::cvt_pk_bf16(o[g][db][2] * inv, o[g][db][3] * inv);
            *(u32x2*)(orow + 16 * db) = w; } }
}
}

__global__ void __launch_bounds__(NWAVES * 64, 2) mk_fwd(Args args) {
    extern __shared__ __attribute__((aligned(16))) unsigned char lds[];
    LAS unsigned char* L = (LAS unsigned char*)lds;
    volatile LAS unsigned* MISC = (volatile LAS unsigned*)(L + MISC_OFF);
    const int tid = threadIdx.x, lane = tid & 63, wave = __builtin_amdgcn_readfirstlane(tid >> 6);
    const int G = gridDim.x; const int bx = blockIdx.x; const int vcu = (G % 8 == 0) ? (bx % 8) * (G / 8) + bx / 8 : bx;
    unsigned char* ws = args.ws;
    gu32* ctl = (gu32*)(ws + WS_CTL);
    const float* x = args.in[0]; float* out = args.out;
    bf16_t* Wt = (bf16_t*)(ws + WS_W);
    bf16_t* Win_t = (bf16_t*)(ws + WS_W + WO_IN); bf16_t* Wa_t = (bf16_t*)(ws + WS_W + WO_A); bf16_t* Wb_t = (bf16_t*)(ws + WS_W + WO_B);
    bf16_t* Wo_t = (bf16_t*)(ws + WS_W + WO_OUT); bf16_t* Wup_t = (bf16_t*)(ws + WS_W + WO_UP); bf16_t* Wdn_t = (bf16_t*)(ws + WS_W + WO_DN);
    float* rope = (float*)(ws + WS_ROPE); float* RS1 = (float*)(ws + WS_RS1); float* CSC = (float*)(ws + WS_CSC); signed char* Win8_t = (signed char*)(ws + WS_W + WO_IN); float* NORMS = (float*)(ws + WS_NORMS); float* SSQ = (float*)(ws + WS_SSQ); float* HALO = (float*)(ws + WS_HALO);
    bf16_t* QKV = (bf16_t*)(ws + WS_QKV); bf16_t* Gt = (bf16_t*)(ws + WS_G); bf16_t* MG = (bf16_t*)(ws + WS_MG); bf16_t* ACT = (bf16_t*)(ws + WS_ACT); bf16_t* X1B = (bf16_t*)(ws + WS_X1B);
    bf16_t* XN = (bf16_t*)out; signed char* XN8 = (signed char*)out; bf16_t* OA = (bf16_t*)((unsigned char*)out + 64 * MiB); bf16_t* OB = (bf16_t*)((unsigned char*)out + 96 * MiB);
    (void)Wt; (void)XN; (void)Win_t;
    for (int u = tid; u < (LDS_BYTES - LDSCTL_OFF) / 4; u += NWAVES * 64) ((LAS unsigned*)(L + LDSCTL_OFF))[u] = 0u;
    __syncthreads();
    const int lo = args.ph_lo, hi = args.ph_hi;
    XcdBarrier bar; bar.bar = (unsigned*)(ctl + CW_BAR) + args.li * XCD_BAR_WORDS; bar.x = 0; bar.st = nullptr;
    if (hi - lo > 1) bar = xcd_barrier_post((unsigned*)(ctl + CW_BAR) + args.li * XCD_BAR_WORDS, MISC + 8);
#ifndef PHMASK
#define PHMASK 255
#endif
#define IN(k) (((PHMASK >> (k)) & 1) && lo <= (k) && (k) < hi)
#define SEAM(k) do { if (IN(k) && IN((k) + 1)) xcd_barrier(bar); } while (0)
#ifndef XCD_LOCAL
#define XCD_LOCAL 1
#endif
#ifndef XCD_ROTATE
#define XCD_ROTATE 1
#endif
#define XCD_ROT(c_) ((XCD_ROTATE && G == 256) ? ((c_) & 7) : 0)
#ifndef XCD_ROTATE1
#define XCD_ROTATE1 1
#endif
#define XCD_ROT1(c_) ((XCD_ROTATE1 && G == 256) ? ((c_) & 7) : 0)
#define SEAML(k) do { if (IN(k) && IN((k) + 1)) { if (modeL) xcd_barrier_local(bar); else xcd_barrier(bar); } } while (0)
    const int gw = vcu * NWAVES + wave, NGW = G * NWAVES;
#if defined(DBGT) && DBGT
#ifndef DBG_BLK
#define DBG_BLK 0
#endif
    unsigned* dbgbase = (unsigned*)(ws + WS_CTL + 512 * 1024);
#define DBGP(ph) (bx == DBG_BLK ? dbgbase + (ph) * 64 : (unsigned*)nullptr)
#else
#define DBGP(ph) ((unsigned*)nullptr)
#endif

    constexpr int I_IN = (DM / 64) * (NIN / 64), I_U = (DM / 64) * (NUP / 64), I_A = (1024 / 64) * (DM / 64), I_O = (DM / 64) * (DM / 64), I_D = (DFF / 64) * (DM / 64);
#ifndef CV_SPLIT
#define CV_SPLIT 0
#endif
    constexpr int CV_UPEND = I_IN + I_U, CV_G1 = CV_UPEND + (CV_SPLIT >= 1 ? 2 * I_A : 0) + (CV_SPLIT >= 2 ? I_O : 0), CV_ALL = CV_UPEND + 2 * I_A + I_O + I_D;
#define CV_SEL(it_, W_, N_, r_) do { int r0_ = (it_); \
        if (r0_ < I_IN) { W_ = args.in[2]; N_ = NIN; r_ = r0_; } else if ((r0_ -= I_IN) < I_U) { W_ = args.in[13]; N_ = NUP; r_ = r0_; } else if ((r0_ -= I_U) < I_A) { W_ = args.in[9]; N_ = DM; r_ = r0_; } \
        else if ((r0_ -= I_A) < I_A) { W_ = args.in[10]; N_ = DM; r_ = r0_; } else if ((r0_ -= I_A) < I_O) { W_ = args.in[11]; N_ = DM; r_ = r0_; } else { r0_ -= I_O; W_ = args.in[16]; N_ = DM; r_ = r0_; } } while (0)
#define CONVERT_ITEMS(first_, stride_, lo_, hi_) do { LAS float* scr = (LAS float*)(L + RING_OFF + wave * 16384); f32x4 cur[16]; \
        int it = (lo_) + (first_); const float* W; int N, r; \
        if (it < (hi_)) { CV_SEL(it, W, N, r); p0_item_load(cur, W, N, r, lane); } \
        for (; it < (hi_); it += (stride_)) { __builtin_assume(it >= (lo_)); \
            CV_SEL(it, W, N, r); const bool isup = (it >= I_IN) && (it < CV_UPEND); \
            p0_lds_write(cur, 64 * (r / (N >> 6)), isup ? args.in[12] : nullptr, scr, lane); \
            const int itn = it + (stride_); \
            if (itn < (hi_)) { const float* Wn; int Nn, rn; CV_SEL(itn, Wn, Nn, rn); p0_item_load(cur, Wn, Nn, rn, lane); } \
            LDS_WAIT(); asm volatile("" ::: "memory"); \
            int r0 = it; \
            if (r0 < I_IN) p0_lds_read_store<0>(Win_t, DM, NIN, scr, r0, lane); \
            else if ((r0 -= I_IN) < I_U) p0_lds_read_store<2>(Wup_t, DM, NUP, scr, r0, lane); \
            else if ((r0 -= I_U) < I_A) p0_lds_read_store<1>(Wa_t, 1024, DM, scr, r0, lane); \
            else if ((r0 -= I_A) < I_A) p0_lds_read_store<1>(Wb_t, 1024, DM, scr, r0, lane); \
            else if ((r0 -= I_A) < I_O) p0_lds_read_store<1>(Wo_t, DM, DM, scr, r0, lane); \
            else { r0 -= I_O; p0_lds_read_store<1>(Wdn_t, DFF, DM, scr, r0, lane); } \
            LDS_WAIT(); asm volatile("" ::: "memory"); \
        } } while (0)
    constexpr int P1_UNITS = (M / 256) * (NIN / 256);
    const int p1_rounds = (P1_UNITS + G - 1) / G, p1_last = P1_UNITS - (p1_rounds - 1) * G;
    const int p1_fillers = (p1_last < G) ? G - p1_last : 0;
#define P0_WIN_ONEPASS() do { \
        LAS unsigned* IMG = (LAS unsigned*)(L + RING_OFF); LAS float* CMX = (LAS float*)(L + XCH_OFF + 8192); \
        for (int blk = bx; blk < NIN / 32; blk += G) { \
            const int n0 = blk * 32, cg = lane & 7, rr = lane >> 3; \
            const float* wb = args.in[2] + (size_t)(256 * wave + 2 * rr) * NIN + n0 + 4 * cg; \
            f32x4 mx = {0.f, 0.f, 0.f, 0.f}; \
            _Pragma("unroll 1") for (int i0 = 0; i0 < 16; i0 += 4) { \
                f32x4 ra[4], rb[4]; \
                _Pragma("unroll") for (int i = 0; i < 4; ++i) { ra[i] = *(const f32x4*)(wb + (size_t)(16 * (i0 + i)) * NIN); rb[i] = *(const f32x4*)(wb + (size_t)(16 * (i0 + i) + 1) * NIN); } \
                _Pragma("unroll") for (int i = 0; i < 4; ++i) { const int kd = 128 * wave + 8 * (i0 + i) + rr; \
                    _Pragma("unroll") for (int e = 0; e < 4; ++e) { mx[e] = fmaxf(mx[e], fmaxf(fabsf(ra[i][e]), fabsf(rb[i][e]))); \
                        IMG[(4 * cg + e) * 1024 + (kd ^ (cg << 3))] = pg8::cvt_pk_bf16(ra[i][e], rb[i][e]); } } \
            } \
            _Pragma("unroll") for (int e = 0; e < 4; ++e) { mx[e] = fmaxf(mx[e], __shfl_xor(mx[e], 8)); mx[e] = fmaxf(mx[e], __shfl_xor(mx[e], 16)); mx[e] = fmaxf(mx[e], __shfl_xor(mx[e], 32)); } \
            if (rr == 0) { _Pragma("unroll") for (int e = 0; e < 4; ++e) CMX[wave * 32 + 4 * cg + e] = mx[e]; } \
            LDS_WAIT(); __syncthreads(); \
            _Pragma("unroll 1") for (int cc = 0; cc < 4; ++cc) { const int c = 4 * wave + cc, src = n0 + c, dst = map_head(src); \
                float cm = 0.f; _Pragma("unroll") for (int w8 = 0; w8 < 8; ++w8) cm = fmaxf(cm, CMX[w8 * 32 + c]); \
                cm = __uint_as_float(((unsigned)pg8::cvt_pk_bf16(cm, cm)) << 16); \
                const float inv = cm > 0.f ? 127.f / cm : 0.f; \
                if (lane == 0) CSC[dst] = cm * (1.f / 127.f); \
                signed char* orow = (signed char*)Win8_t + (size_t)dst * DM; \
                _Pragma("unroll") for (int g2 = 0; g2 < 2; ++g2) { const int g8 = lane + 64 * g2; \
                    const LAS u32x4* ip = (const LAS u32x4*)(IMG + c * 1024 + ((g8 ^ wave) << 3)); const u32x4 p0 = ip[0], p1 = ip[1]; u32x4 o; \
                    _Pragma("unroll") for (int d = 0; d < 4; ++d) { const unsigned wa = d < 2 ? p0[2 * d] : p1[2 * d - 4], wb2 = d < 2 ? p0[2 * d + 1] : p1[2 * d - 3]; \
                        const int q0 = (int)rintf(__uint_as_float(wa << 16) * inv), q1 = (int)rintf(__uint_as_float(wa & 0xffff0000u) * inv), q2 = (int)rintf(__uint_as_float(wb2 << 16) * inv), q3 = (int)rintf(__uint_as_float(wb2 & 0xffff0000u) * inv); \
                        o[d] = (unsigned)(q0 & 255) | ((unsigned)(q1 & 255) << 8) | ((unsigned)(q2 & 255) << 16) | ((unsigned)(q3 & 255) << 24); } \
                    *(u32x4*)(orow + 16 * g8) = o; } \
            } \
            LDS_WAIT(); __syncthreads(); \
        } } while (0)
    if (IN(0)) {
        const int p0part = args.pad;
        unsigned* CMAXU = (unsigned*)(ws + WS_CTL + WS_CMAX);
        if (p0part != 2) {
            P0_WIN_ONEPASS();
            CONVERT_ITEMS(gw, NGW, I_IN, (p1_fillers > 0 ? CV_G1 : CV_ALL));
            if (bx == 0) { const int k = tid >> 7, j = tid & 127; NORMS[tid] = args.in[k == 0 ? 3 : k == 1 ? 4 : k == 2 ? 6 : 7][j]; }
            const float* g = args.in[1];
            for (int m = gw; m < M; m += NGW) {
                const f32x4* xr = (const f32x4*)(x + (size_t)m * DM) + lane;
                f32x4 v[8]; float s = 0.f;
#pragma unroll
                for (int j = 0; j < 8; ++j) { v[j] = xr[64 * j]; s += (v[j].x * v[j].x + v[j].y * v[j].y) + (v[j].z * v[j].z + v[j].w * v[j].w); }
                const float rs = rsqrtf(wave_sum(s) * (1.f / DM) + EPS);
                float amax = 0.f;
#pragma unroll
                for (int j = 0; j < 8; ++j) { const f32x4 gv = ((const f32x4*)g)[lane + 64 * j]; v[j] = v[j] * rs * gv;
                    amax = fmaxf(amax, fmaxf(fmaxf(fabsf(v[j].x), fabsf(v[j].y)), fmaxf(fabsf(v[j].z), fabsf(v[j].w)))); }
                amax = wave_max(amax);
                const float inv = amax > 0.f ? 127.f / amax : 0.f;
#pragma unroll
                for (int j = 0; j < 8; ++j) { const int q0 = (int)rintf(v[j].x * inv), q1 = (int)rintf(v[j].y * inv), q2 = (int)rintf(v[j].z * inv), q3 = (int)rintf(v[j].w * inv);
                    ((unsigned*)(XN8 + (size_t)m * DM))[lane + 64 * j] = (unsigned)(q0 & 255) | ((unsigned)(q1 & 255) << 8) | ((unsigned)(q2 & 255) << 16) | ((unsigned)(q3 & 255) << 24); }
                if (lane == 0) RS1[m] = amax * (1.f / 127.f);
            }
            for (int idx = vcu * (NWAVES * 64) + tid; idx < SEQ * 64; idx += G * NWAVES * 64) {
                const int pos = idx >> 6, j = idx & 63;
                const double inv = exp2(-(double)j * (1.0 / 64.0) * 13.287712379549449);
                const double ang = (double)pos * inv;
                const double TWO_PI = 6.283185307179586476925286766559;
                const double k = rint(ang / TWO_PI);
                const float r = (float)(ang - k * TWO_PI);
                rope[idx] = cosf(r); rope[SEQ * 64 + idx] = sinf(r);
            }
        }
    }
    SEAM(0);
    if (IN(1)) {
        pg8::Gemm g{(const bf16_t*)XN8, (const bf16_t*)Win8_t, (const bf16_t*)XN8, (const bf16_t*)Win8_t, M, NIN, DM / 2, DBGP(1)};     pg8::StaticOrderT<M / 256, NIN / 256> S; S.init(G, bx, XCD_ROT1(bx));
        int pm0 = -1; { pg8::Unit u0; if (S.next(0, u0)) pm0 = u0.pm; }
        { LAS float* T = (LAS float*)(L + XCH_OFF);
          if (pm0 >= 0 && tid < 256) T[1024 + tid] = RS1[pm0 * 256 + tid];
          T[1280 + tid] = NORMS[tid];
          pg8::Unit uu; for (int i = 0; i < 9 && S.next(i, uu); ++i) if (tid < 256) T[1792 + i * 256 + tid] = CSC[uu.pn * 256 + tid];
          LDS_WAIT(); __syncthreads(); }
        pg8::EpiProj E{QKV, Gt, NORMS, rope, RS1, CSC, pm0};
#ifndef P1_EREP
#define P1_EREP 1
#endif
#ifndef P1_KREP
#define P1_KREP 1
#endif
        pg8::gemm_phase<P1_EREP, P1_KREP, true>(L + RING_OFF, L + XCH_OFF, g, S, E);
        if (p1_fillers > 0 && bx >= p1_last) CONVERT_ITEMS((bx - p1_last) * NWAVES + wave, p1_fillers * NWAVES, CV_G1, CV_ALL);
    }
    SEAM(1);
    const bool modeL = XCD_LOCAL && (hi - lo > 1) && lo <= 1 && G == 256 && MISC[8 + 3] == 1u;
    const int xr = (int)MISC[8 + 2], xx = (int)bar.x, cL = modeL ? xr * 8 + xx : bx;
    if (IN(2)) {
#if defined(ATTN_VALU) && ATTN_VALU
        LAS float* scr = (LAS float*)(L + RING_OFF + wave * 2048);
        for (int it = gw; it < M * 8; it += NGW) attn_a_item(QKV, args.in[5], OA, it, scr, lane);
        for (int it = gw; it < M * 8; it += NGW) attn_b_item(QKV, args.in[8], OB, it, scr, lane);
#else
        static_assert(att::ATT_LDS <= RING_BYTES, "attention LDS");
#ifndef ATT_B16
#define ATT_B16 1
#endif
#if ATT_B16
#define ATT_UNIT_B att::unit_b16
#else
#define ATT_UNIT_B att::unit_b
#endif
#ifndef ATT_REP_A
#define ATT_REP_A 1
#endif
#ifndef ATT_REP_B
#define ATT_REP_B 1
#endif
        const float cqa = att::qk_bound_l2(args.in[3], args.in[4], lane), cqb = att::qk_bound_l2(args.in[6], args.in[7], lane);
#if defined(ATT_PRIO) && ATT_PRIO
        if (wave >= 4) __builtin_amdgcn_s_setprio(1);
#endif
        if (modeL) {
            for (int rep = 0; rep < ATT_REP_A; ++rep)
            for (int j = 0; j < 2; ++j) { const int i = xr + 32 * j, ua = (xx >> 1) * 128 + (i >> 5) * 64 + 32 * (xx & 1) + (i & 31);
                att::unit_a((LAS char*)(L + RING_OFF), QKV, args.in[5], cqa, OA, ua, tid, wave, lane); }
            if (!(xr & 1)) { for (int rep = 0; rep < ATT_REP_B; ++rep) for (int j = 0; j < 2; ++j) { const int idx = (xr >> 1) + 16 * j, ub = (xx >> 1) * 128 + (idx >> 2) * 16 + (4 * (xx & 1) + (idx & 3)) * 2;
                ATT_UNIT_B<0>((LAS char*)(L + RING_OFF), QKV, args.in[8], cqb, OB, ub, tid, wave, lane); } }
            else { for (int j = 0; j < 2; ++j) { const int idx = (xr >> 1) + 16 * j, ub = (xx >> 1) * 128 + (idx >> 2) * 16 + (4 * (xx & 1) + (idx & 3)) * 2 + 1;
                ATT_UNIT_B<1>((LAS char*)(L + RING_OFF), QKV, args.in[8], cqb, OB, ub, tid, wave, lane); } }
        } else {
        for (int rep = 0; rep < ATT_REP_A; ++rep)
        for (int ua = vcu; ua < 512; ua += G) att::unit_a((LAS char*)(L + RING_OFF), QKV, args.in[5], cqa, OA, ua, tid, wave, lane);
        for (int rep = 0; rep < ATT_REP_B; ++rep)
        for (int ub = vcu; ub < 512; ub += G) if (!(ub & 1)) ATT_UNIT_B<0>((LAS char*)(L + RING_OFF), QKV, args.in[8], cqb, OB, ub, tid, wave, lane);
        for (int ub = vcu; ub < 512; ub += G) if (ub & 1) ATT_UNIT_B<1>((LAS char*)(L + RING_OFF), QKV, args.in[8], cqb, OB, ub, tid, wave, lane);
        }
#if defined(ATT_PRIO) && ATT_PRIO
        __builtin_amdgcn_s_setprio(0);
#endif
#endif
    }
    SEAML(2);
    if (IN(3)) {
        pg8::Gemm g{OA, Wa_t, OB, Wb_t, M, DM, 1024, DBGP(3)}; pg8::StaticOrderT<M / 256, DM / 256, 1> S; S.init(G, cL, XCD_ROT(cL));
        pg8::EpiBranch E{MG, Gt};
        pg8::gemm_phase(L + RING_OFF, L + XCH_OFF, g, S, E);
    }
    SEAML(3);
    if (IN(4)) {
        pg8::Gemm g{MG, Wo_t, MG, Wo_t, M, DM, DM, DBGP(4)}; pg8::StaticOrderT<M / 256, DM / 256> S; S.init(G, cL, XCD_ROT(cL));
        pg8::EpiOut E{x, out, X1B, SSQ};
        pg8::gemm_phase(L + RING_OFF, L + XCH_OFF, g, S, E);
    }
    SEAML(4);
    if (IN(5)) {
        pg8::Gemm g{X1B, Wup_t, X1B, Wup_t, M, NUP, DM, DBGP(5)}; pg8::StaticOrderT<M / 256, NUP / 256> S; S.init(G, cL, XCD_ROT(cL));
        int pm0 = -1; { pg8::Unit u0; if (S.next(0, u0)) pm0 = u0.pm; }
        if (pm0 >= 0 && tid < 256) { const float* sp = SSQ + (size_t)(pm0 * 256 + tid) * 8; const f32x4 a = *(const f32x4*)sp, b = *(const f32x4*)(sp + 4);
            ((LAS float*)(L + XCH_OFF + 12288))[tid] = __builtin_amdgcn_rsqf(((a[0] + a[1]) + (a[2] + a[3]) + (b[0] + b[1]) + (b[2] + b[3])) * (1.f / DM) + EPS); }
        LDS_WAIT(); __syncthreads();
        pg8::EpiUp E{ACT, HALO, SSQ, args.in[14], args.in[15], pm0};
        pg8::gemm_phase<1, 1, false, true>(L + RING_OFF, L + XCH_OFF, g, S, E);
    }
    do { if (IN(5) && IN(7)) xcd_barrier(bar); } while (0);
    if (IN(7)) {
        pg8::Gemm g{ACT, Wdn_t, ACT, Wdn_t, M, DM, DFF, DBGP(7)}; pg8::StaticOrderT<M / 256, DM / 256> S; S.init(G, cL, XCD_ROT(cL));
        { const float* cw = args.in[14]; const float* cb = args.in[15]; pg8::Unit uu; int pm_done = -1;
          for (int i = 0; S.next(i, uu); ++i) { if (uu.pm == pm_done) continue; pm_done = uu.pm; const int pm = uu.pm;
            for (int idx = tid; idx < 2 * (DFF / 4); idx += NWAVES * 64) {
                const int side = idx / (DFF / 4), j = (idx % (DFF / 4)) * 4;
                const int row = pm * 256 + (side ? 255 : 0);
                const float* hc = HALO + (size_t)(pm * 4 + (side ? 3 : 0)) * NUP;
                const float* hp = side ? HALO + (size_t)(pm * 4 + 2) * NUP : ((pm & 15) == 0 ? nullptr : HALO + (size_t)((pm - 1) * 4 + 3) * NUP);
                const float* hn = side ? ((pm & 15) == 15 ? nullptr : HALO + (size_t)((pm + 1) * 4 + 0) * NUP) : HALO + (size_t)(pm * 4 + 1) * NUP;
                f32x4 o[2];
#pragma unroll
                for (int bj = 0; bj < 2; ++bj) {
                    const int c = bj * DFF + j;
                    f32x4 a = *(const f32x4*)(cb + c) + *(const f32x4*)(cw + NUP + c) * *(const f32x4*)(hc + c);
                    if (hp) a += *(const f32x4*)(cw + c) * *(const f32x4*)(hp + c);
                    if (hn) a += *(const f32x4*)(cw + 2 * NUP + c) * *(const f32x4*)(hn + c);
                    o[bj] = a;
                }
                u32x2 w; float r[4];
#pragma unroll
                for (int e = 0; e < 4; ++e) r[e] = o[0][e] / (1.f + __expf(-o[0][e])) * o[1][e];
                w.x = pk2(r[0], r[1]); w.y = pk2(r[2], r[3]);
                *(u32x2*)(ACT + (size_t)row * DFF + j) = w;
            } }
          asm volatile("s_waitcnt vmcnt(0)" ::: "memory"); __syncthreads(); }
        pg8::EpiDown E{out, X1B};
        pg8::gemm_phase(L + RING_OFF, L + XCH_OFF, g, S, E);
    }
#if defined(DBGT) && DBGT
    if (hi - lo > 1) {
        xcd_barrier(bar);
        if (bx == DBG_BLK && tid == 0) {
            const unsigned* d = dbgbase + DBG_PH * 64; int n = 0; while (n < 16 && d[n * 4 + 3] != 0u) ++n;
            float sk = 0.f, sa = 0.f, se = 0.f, sg = 0.f;
            for (int i = 0; i < n; ++i) { sk += (float)(d[i * 4 + 1] - d[i * 4 + 0]); sa += (float)(d[i * 4 + 2] - d[i * 4 + 1]); se += (float)(d[i * 4 + 3] - d[i * 4 + 2]); if (i + 1 < n) sg += (float)(d[i * 4 + 4] - d[i * 4 + 3]); }
            const float tot = (float)(d[(n - 1) * 4 + 3] - d[0]);
            float val = DBG_METRIC == 0 ? sk / n : DBG_METRIC == 1 ? sa / n : DBG_METRIC == 2 ? se / n : DBG_METRIC == 3 ? sg / (n > 1 ? n - 1 : 1) : DBG_METRIC == 4 ? tot * 0.1f : (float)n * 100.f;
            val *= 0.01f;
            out[0] = 100.f * exp2f(val * 0.01f * 3.321928f);
        }
    }
#endif
#undef IN
#undef SEAM
}

#ifndef OPTMASK
#define OPTMASK 31
#endif
#ifndef FUSED
#define FUSED 1
#endif
extern "C" void kernel_launch(void* const* d_in, const int* in_sizes, int n_in, void* d_out, int out_size, void* d_ws, size_t ws_size, hipStream_t stream) {
    if (n_in != 17 || out_size != M * DM || ws_size < WS_END) { fprintf(stderr, "kernel_launch: unexpected shapes (n_in %d out %d ws %zu)\n", n_in, out_size, ws_size); return; }
    static int grid = 0;
    if (grid == 0) {
        int dev = 0, cus = 0, per_cu = 0;
        if (hipGetDevice(&dev) != hipSuccess || hipDeviceGetAttribute(&cus, hipDeviceAttributeMultiprocessorCount, dev) != hipSuccess) { grid = -1; return; }
        if (hipFuncSetAttribute((const void*)mk_fwd, hipFuncAttributeMaxDynamicSharedMemorySize, LDS_BYTES) != hipSuccess) { fprintf(stderr, "kernel_launch: hipFuncSetAttribute failed\n"); grid = -1; return; }
        if (hipOccupancyMaxActiveBlocksPerMultiprocessor(&per_cu, (const void*)mk_fwd, NWAVES * 64, LDS_BYTES) != hipSuccess || per_cu < 1) { fprintf(stderr, "kernel_launch: occupancy query says %d\n", per_cu); }
        (void)hipGetLastError();
        grid = cus;
    }
    if (grid < 0) return;
    const float* x = (const float*)d_in[0]; const float* norm_mix = (const float*)d_in[1]; const float* w_in = (const float*)d_in[2];
    const float* aqn = (const float*)d_in[3]; const float* akn = (const float*)d_in[4]; const float* sink = (const float*)d_in[5];
    const float* bqn = (const float*)d_in[6]; const float* bkn = (const float*)d_in[7]; const float* rpb = (const float*)d_in[8];
    const float* wba = (const float*)d_in[9]; const float* wbb = (const float*)d_in[10]; const float* w_out = (const float*)d_in[11];
    const float* norm_ffn = (const float*)d_in[12]; const float* w_up = (const float*)d_in[13]; const float* conv_w = (const float*)d_in[14];
    const float* conv_b = (const float*)d_in[15]; const float* w_down = (const float*)d_in[16];
    unsigned char* ws = (unsigned char*)d_ws; float* out = (float*)d_out;
    float* rope = (float*)(ws + WS_ROPE);
    bf16_t* QKV = (bf16_t*)(ws + WS_QKV); bf16_t* G = (bf16_t*)(ws + WS_G); bf16_t* MG = (bf16_t*)(ws + WS_MG); bf16_t* ACT = (bf16_t*)(ws + WS_ACT);
    bf16_t* X1B = (bf16_t*)(ws + WS_X1B); bf16_t* UCH = (bf16_t*)(ws + WS_UCH);
    bf16_t* XN = (bf16_t*)d_out; bf16_t* OA = (bf16_t*)((unsigned char*)d_out + 64 * MiB); bf16_t* OB = (bf16_t*)((unsigned char*)d_out + 96 * MiB);
    (void)hipMemsetAsync(ws + WS_CTL, 0, WS_CTL_ZERO, stream);
    Args a{};
    for (int i = 0; i < 17; ++i) a.in[i] = (const float*)d_in[i];
    a.out = out; a.ws = ws;
    int li = 0;
#ifndef DUP
#define DUP -1
#endif
#define MK(lo_, hi_) do { for (int rep_ = 0; rep_ < (((lo_) == DUP && (hi_) == DUP + 1) ? 2 : 1); ++rep_) { a.ph_lo = (lo_); a.ph_hi = (hi_); a.li = li++; hipLaunchKernelGGL(mk_fwd, dim3(grid), dim3(NWAVES * 64), LDS_BYTES, stream, a); } } while (0)
    if (FUSED && OPTMASK == 31) { MK(0, N_PHASES); return; }
    if (OPTMASK & 1) { a.pad = 1; MK(0, 1); a.pad = 2; MK(0, 1); a.pad = 0; MK(1, 2);
#if defined(PROBE) && PROBE == 1
        { nv::NEpi e = nv::mk_epi(0, QKV, NQKV, nullptr, 0, nullptr, nullptr, 0); nv::k_ngemm<<<4096, 256, 0, stream>>>(XN, DM, w_in, NIN, M, NQKV, DM, e); }
        nv::k_proj_post<<<2048, 256, 0, stream>>>(QKV, G, aqn, akn, bqn, bkn, rope, 1, 0);
#elif defined(PROBE) && PROBE == 2
        { nv::NEpi e = nv::mk_epi(0, G, NGATE, nullptr, 0, nullptr, nullptr, 0); nv::k_ngemm<<<4096, 256, 0, stream>>>(XN, DM, w_in + NQKV, NIN, M, NGATE, DM, e); }
        nv::k_proj_post<<<2048, 256, 0, stream>>>(QKV, G, aqn, akn, bqn, bkn, rope, 0, 1);
#endif
    }
    else {
        if (OPTMASK) { a.pad = 1; MK(0, 1); a.pad = 2; MK(0, 1); a.pad = 0; }
        nv::k_rope_table<<<SEQ * 64 / 256, 256, 0, stream>>>(rope);
        nv::k_rmsnorm_rows<<<2048, 256, 0, stream>>>(x, norm_mix, XN, M);
        { nv::NEpi e = nv::mk_epi(0, QKV, NQKV, nullptr, 0, nullptr, nullptr, 0); nv::k_ngemm<<<4096, 256, 0, stream>>>(XN, DM, w_in, NIN, M, NQKV, DM, e); }
        { nv::NEpi e = nv::mk_epi(0, G, NGATE, nullptr, 0, nullptr, nullptr, 0); nv::k_ngemm<<<4096, 256, 0, stream>>>(XN, DM, w_in + NQKV, NIN, M, NGATE, DM, e); }
        nv::k_proj_post<<<2048, 256, 0, stream>>>(QKV, G, aqn, akn, bqn, bkn, rope, 1, 1);
    }
    if (OPTMASK & 2) MK(2, 3);
    else { nv::k_attn_a<<<4096, 256, 0, stream>>>(QKV, sink, OA); nv::k_attn_b<<<4096, 256, 0, stream>>>(QKV, rpb, OB); }
    if (OPTMASK & 4) MK(3, 4);
    else {
        { nv::NEpi e = nv::mk_epi(1, MG, DM, G, NGATE, nullptr, nullptr, 0); nv::k_ngemm<<<4096, 256, 0, stream>>>(OA, 1024, wba, DM, M, DM, 1024, e); }
        { nv::NEpi e = nv::mk_epi(2, MG, DM, G + 2048, NGATE, nullptr, nullptr, 0); nv::k_ngemm<<<4096, 256, 0, stream>>>(OB, 1024, wbb, DM, M, DM, 1024, e); }
    }
    if (OPTMASK & 8) { MK(4, 5); MK(5, 6); MK(6, 7); }
    else {
        { nv::NEpi e = nv::mk_epi(3, nullptr, 0, nullptr, 0, x, out, DM); nv::k_ngemm<<<4096, 256, 0, stream>>>(MG, DM, w_out, DM, M, DM, DM, e); }
        nv::k_rmsnorm_rows<<<2048, 256, 0, stream>>>(out, norm_ffn, X1B, M);
        for (int b = 0; b < BATCH; ++b) {
            nv::NEpi e = nv::mk_epi(0, UCH, NUP, nullptr, 0, nullptr, nullptr, 0);
            nv::k_ngemm<<<4096, 256, 0, stream>>>(X1B + (size_t)b * SEQ * DM, DM, w_up, NUP, SEQ, NUP, DM, e);
            nv::k_conv_glu<<<4096, 256, 0, stream>>>(UCH, conv_w, conv_b, ACT + (size_t)b * SEQ * DFF);
        }
    }
    if (OPTMASK & 16) MK(7, 8);
    else { nv::NEpi e = nv::mk_epi(3, nullptr, 0, nullptr, 0, out, out, DM); nv::k_ngemm<<<4096, 256, 0, stream>>>(ACT, DFF, w_down, DM, M, DM, DFF, e); }
#undef MK
}
```

```cpp
#define OPTMASK 31
#define FUSED 1
#define PROBE 0
#define DUP -1
#define NO_RELAX 1
#include <hip/hip_runtime.h>
#include <cstdint>
#include <cstdio>

typedef unsigned short bf16_t;
typedef float f32x4 __attribute__((ext_vector_type(4)));
typedef unsigned u32x4 __attribute__((ext_vector_type(4)));
typedef unsigned u32x2 __attribute__((ext_vector_type(2)));

constexpr int BATCH = 4, SEQ = 4096, DM = 2048, M = BATCH * SEQ;
constexpr int HD = 128, AQH = 8, AKVH = 2, BH = 8;
constexpr int NQKV = 4608, NGATE = 4096, NIN = NQKV + NGATE;
constexpr int C_QA = 0, C_KA = 1024, C_VA = 1280, C_QB = 1536, C_KB = 2560, C_VB = 3584;
constexpr int DFF = 5632, NUP = 2 * DFF;
constexpr int GW = 64, GROWS = SEQ / GW;
constexpr float EPS = 1e-6f;

constexpr size_t MiB = 1u << 20;
constexpr size_t WS_CTL = 0;
constexpr size_t WS_ROPE = 1 * MiB;
constexpr size_t WS_SSQ = 3 * MiB;
constexpr size_t WS_NORMS = 3 * MiB + 768 * 1024;
constexpr size_t WS_RS1 = 3 * MiB + 832 * 1024;
constexpr size_t WS_CSC = 3 * MiB + 896 * 1024;
constexpr size_t WS_CMAX = 32 * 1024, WS_CTL_ZERO = 72 * 1024;
constexpr size_t WS_HALO = 4 * MiB;
constexpr size_t WS_W = 16 * MiB;
constexpr size_t WS_QKV = 132 * MiB;
constexpr size_t WS_G = 276 * MiB;
constexpr size_t WS_MG = 132 * MiB;
constexpr size_t WS_ACT = 132 * MiB;
constexpr size_t WS_X1B = 340 * MiB;
constexpr size_t WS_UCH = 404 * MiB;
constexpr size_t WS_END = 492 * MiB;

__device__ __forceinline__ float bf2f(bf16_t v) { return __uint_as_float((unsigned)v << 16); }
__device__ __forceinline__ bf16_t f2bf(float f) { unsigned u = __float_as_uint(f); return (bf16_t)((u + 0x7fffu + ((u >> 16) & 1u)) >> 16); }
__device__ __forceinline__ float wave_sum(float v) {
#pragma unroll
    for (int o = 1; o < 64; o <<= 1) v += __shfl_xor(v, o);
    return v;
}
__device__ __forceinline__ float wave_max(float v) {
#pragma unroll
    for (int o = 1; o < 64; o <<= 1) v = fmaxf(v, __shfl_xor(v, o));
    return v;
}

namespace nv {

__global__ void k_rope_table(float* tab) {
    const int idx = blockIdx.x * blockDim.x + threadIdx.x;
    if (idx >= SEQ * 64) return;
    const int pos = idx >> 6, j = idx & 63;
    const double inv = exp2(-(double)j * (1.0 / 64.0) * 13.287712379549449);
    const double ang = (double)pos * inv;
    const double TWO_PI = 6.283185307179586476925286766559;
    const double k = rint(ang / TWO_PI);
    const float r = (float)(ang - k * TWO_PI);
    tab[idx] = cosf(r);
    tab[SEQ * 64 + idx] = sinf(r);
}

__global__ void k_rmsnorm_rows(const float* __restrict__ x, const float* __restrict__ g, bf16_t* __restrict__ out, int rows) {
    const int lane = threadIdx.x & 63, wpb = blockDim.x >> 6;
    for (int r = blockIdx.x * wpb + (threadIdx.x >> 6); r < rows; r += gridDim.x * wpb) {
        const f32x4* xr = (const f32x4*)(x + (size_t)r * DM) + lane;
        f32x4 v[8]; float s = 0.f;
#pragma unroll
        for (int j = 0; j < 8; ++j) { v[j] = xr[64 * j]; s += v[j].x * v[j].x + v[j].y * v[j].y + v[j].z * v[j].z + v[j].w * v[j].w; }
        const float rs = rsqrtf(wave_sum(s) * (1.f / DM) + EPS);
#pragma unroll
        for (int j = 0; j < 8; ++j) {
            const f32x4 gv = ((const f32x4*)g)[lane + 64 * j];
            u32x2 o; o.x = (unsigned)f2bf(v[j].x * rs * gv.x) | ((unsigned)f2bf(v[j].y * rs * gv.y) << 16);
            o.y = (unsigned)f2bf(v[j].z * rs * gv.z) | ((unsigned)f2bf(v[j].w * rs * gv.w) << 16);
            ((u32x2*)(out + (size_t)r * DM))[lane + 64 * j] = o;
        }
    }
}

struct NEpi { bf16_t* Cb; const bf16_t* gate; const float* resid; float* Cf; int mode, ldc, ldg, ldf; };
static inline NEpi mk_epi(int mode, bf16_t* Cb, int ldc, const bf16_t* gate, int ldg, const float* resid, float* Cf, int ldf) { NEpi e{}; e.Cb = Cb; e.gate = gate; e.resid = resid; e.Cf = Cf; e.mode = mode; e.ldc = ldc; e.ldg = ldg; e.ldf = ldf; return e; }
__global__ void __launch_bounds__(256) k_ngemm(const bf16_t* __restrict__ A, int lda, const float* __restrict__ W, int ldw, int Mr, int N, int K, NEpi E) {
    __shared__ float As[16][68];
    __shared__ float Bs[16][68];
    const int tid = threadIdx.x, tx = tid & 15, ty = tid >> 4;
    const int ntn = N / 64, ntm = Mr / 64;
    for (int tile = blockIdx.x; tile < ntn * ntm; tile += gridDim.x) {
        const int tm = tile / ntn, tn = tile % ntn;
        float acc[4][4];
#pragma unroll
        for (int i = 0; i < 4; ++i)
#pragma unroll
            for (int j = 0; j < 4; ++j) acc[i][j] = 0.f;
        const int ar = tid >> 2, ak = (tid & 3) * 4;
        const int bk = tid >> 4, bn = (tid & 15) * 4;
        const bf16_t* Ap = A + (size_t)(tm * 64 + ar) * lda + ak;
        const float* Wp = W + (size_t)bk * ldw + tn * 64 + bn;
        for (int k0 = 0; k0 < K; k0 += 16) {
            const u32x2 av = *(const u32x2*)(Ap + k0);
            const f32x4 wv = *(const f32x4*)(Wp + (size_t)k0 * ldw);
            __syncthreads();
            As[ak + 0][ar] = __uint_as_float(av.x << 16); As[ak + 1][ar] = __uint_as_float(av.x & 0xffff0000u);
            As[ak + 2][ar] = __uint_as_float(av.y << 16); As[ak + 3][ar] = __uint_as_float(av.y & 0xffff0000u);
            *(f32x4*)&Bs[bk][bn] = wv;
            __syncthreads();
#pragma unroll
            for (int k = 0; k < 16; ++k) {
                const f32x4 a = *(const f32x4*)&As[k][ty * 4];
                const f32x4 b = *(const f32x4*)&Bs[k][tx * 4];
#pragma unroll
                for (int i = 0; i < 4; ++i)
#pragma unroll
                    for (int j = 0; j < 4; ++j) acc[i][j] = fmaf(a[i], b[j], acc[i][j]);
            }
        }
#pragma unroll
        for (int i = 0; i < 4; ++i) {
            const int row = tm * 64 + ty * 4 + i, col = tn * 64 + tx * 4;
#pragma unroll
            for (int j = 0; j < 4; ++j) {
                float v = acc[i][j];
                if (E.mode == 0) E.Cb[(size_t)row * E.ldc + col + j] = f2bf(v);
                else if (E.mode == 1) E.Cb[(size_t)row * E.ldc + col + j] = f2bf(v * bf2f(E.gate[(size_t)row * E.ldg + col + j]));
                else if (E.mode == 2) { bf16_t* p = E.Cb + (size_t)row * E.ldc + col + j; *p = f2bf(bf2f(*p) + v * bf2f(E.gate[(size_t)row * E.ldg + col + j])); }
                else E.Cf[(size_t)row * E.ldf + col + j] = E.resid[(size_t)row * E.ldf + col + j] + v;
            }
        }
    }
}

__global__ void k_proj_post(bf16_t* __restrict__ QKV, bf16_t* __restrict__ G, const float* __restrict__ aqn, const float* __restrict__ akn,
                            const float* __restrict__ bqn, const float* __restrict__ bkn, const float* __restrict__ rope, int do_qkv, int do_g) {
    const int lane = threadIdx.x & 63, wpb = blockDim.x >> 6;
    for (int r = blockIdx.x * wpb + (threadIdx.x >> 6); r < M; r += gridDim.x * wpb) {
        const int pos = r % SEQ;
        bf16_t* q = QKV + (size_t)r * NQKV;
        const float cs = rope[pos * 64 + lane], sn = rope[SEQ * 64 + pos * 64 + lane];
        for (int h = 0; h < (do_qkv ? 36 : 0); ++h) {
            if ((h >= 10 && h < 12) || h >= 28) continue;
            bf16_t* p = q + h * 128;
            const float x1 = bf2f(p[lane]), x2 = bf2f(p[lane + 64]);
            const float rs = rsqrtf(wave_sum(x1 * x1 + x2 * x2) * (1.f / 128.f) + EPS);
            const float* g = h < 8 ? aqn : h < 10 ? akn : h < 20 ? bqn : bkn;
            const float y1 = x1 * rs * g[lane], y2 = x2 * rs * g[lane + 64];
            if (h < 10) { p[lane] = f2bf(y1 * cs - y2 * sn); p[lane + 64] = f2bf(y2 * cs + y1 * sn); }
            else { p[lane] = f2bf(y1); p[lane + 64] = f2bf(y2); }
        }
        bf16_t* gp = G + (size_t)r * NGATE;
        for (int j = 0; j < (do_g ? NGATE / 64 : 0); ++j) { const float v = bf2f(gp[lane + 64 * j]); gp[lane + 64 * j] = f2bf(1.f / (1.f + __expf(-v))); }
    }
}

__global__ void __launch_bounds__(256) k_attn_a(const bf16_t* __restrict__ QKV, const float* __restrict__ sink, bf16_t* __restrict__ OA) {
    __shared__ float qs[4][128];
    __shared__ float ps[4][320];
    const int lane = threadIdx.x & 63, w = threadIdx.x >> 6;
    for (int item = blockIdx.x * 4 + w; item < M * AQH; item += gridDim.x * 4) {
        const int t = item >> 3, h = item & 7, b = t / SEQ, s = t % SEQ, kvh = h >> 2;
        const bf16_t* q = QKV + (size_t)t * NQKV + C_QA + h * 128;
        qs[w][lane] = bf2f(q[lane]); qs[w][lane + 64] = bf2f(q[lane + 64]);
        const int k0 = s - 128 < 0 ? 0 : s - 128, k1 = s + 128 > SEQ - 1 ? SEQ - 1 : s + 128, nk = k1 - k0 + 1;
        float sc[5]; float mx = -1e30f;
#pragma unroll
        for (int i = 0; i < 5; ++i) {
            const int kk = lane + 64 * i; sc[i] = -1e30f;
            if (kk < nk) {
                const bf16_t* kp = QKV + (size_t)(b * SEQ + k0 + kk) * NQKV + C_KA + kvh * 128;
                float d = 0.f;
                for (int c = 0; c < 16; ++c) { const u32x4 kv = *(const u32x4*)(kp + 8 * c);
#pragma unroll
                    for (int e = 0; e < 4; ++e) { d += qs[w][8 * c + 2 * e] * __uint_as_float(kv[e] << 16) + qs[w][8 * c + 2 * e + 1] * __uint_as_float(kv[e] & 0xffff0000u); } }
                sc[i] = d * 0.08838834764831845f;
            }
            mx = fmaxf(mx, sc[i]);
        }
        const float sk = sink[h];
        mx = fmaxf(wave_max(mx), sk);
        float sum = 0.f;
#pragma unroll
        for (int i = 0; i < 5; ++i) { const int kk = lane + 64 * i; if (kk < nk) { const float p = __expf(sc[i] - mx); ps[w][kk] = p; sum += p; } }
        sum = wave_sum(sum) + __expf(sk - mx);
        const float inv = 1.f / sum;
        float o0 = 0.f, o1 = 0.f;
        const bf16_t* vp = QKV + (size_t)(b * SEQ + k0) * NQKV + C_VA + kvh * 128;
        for (int kk = 0; kk < nk; ++kk) { const float p = ps[w][kk]; o0 += p * bf2f(vp[(size_t)kk * NQKV + lane]); o1 += p * bf2f(vp[(size_t)kk * NQKV + lane + 64]); }
        bf16_t* o = OA + (size_t)t * 1024 + h * 128;
        o[lane] = f2bf(o0 * inv); o[lane + 64] = f2bf(o1 * inv);
    }
}

__global__ void __launch_bounds__(256) k_attn_b(const bf16_t* __restrict__ QKV, const float* __restrict__ rpb, bf16_t* __restrict__ OB) {
    __shared__ float qs[4][128];
    __shared__ float ps[4][128];
    const int lane = threadIdx.x & 63, w = threadIdx.x >> 6;
    for (int item = blockIdx.x * 4 + w; item < M * BH; item += gridDim.x * 4) {
        const int t = item >> 3, h = item & 7, b = t / SEQ, s = t % SEQ, qr = s / GW, qc = s % GW;
        const bf16_t* q = QKV + (size_t)t * NQKV + C_QB + h * 128;
        qs[w][lane] = bf2f(q[lane]); qs[w][lane + 64] = bf2f(q[lane + 64]);
        int rs = qr - 4; rs = rs < 0 ? 0 : (rs > GROWS - 8 ? GROWS - 8 : rs);
        int cs = qc - 8; cs = cs < 0 ? 0 : (cs > GW - 16 ? GW - 16 : cs);
        float sc[2]; float mx = -1e30f;
#pragma unroll
        for (int i = 0; i < 2; ++i) {
            const int kk = lane + 64 * i, kr = rs + (kk >> 4), kc = cs + (kk & 15);
            const bf16_t* kp = QKV + (size_t)(b * SEQ + kr * GW + kc) * NQKV + C_KB + h * 128;
            float d = 0.f;
            for (int c = 0; c < 16; ++c) { const u32x4 kv = *(const u32x4*)(kp + 8 * c);
#pragma unroll
                for (int e = 0; e < 4; ++e) { d += qs[w][8 * c + 2 * e] * __uint_as_float(kv[e] << 16) + qs[w][8 * c + 2 * e + 1] * __uint_as_float(kv[e] & 0xffff0000u); } }
            sc[i] = d * 0.08838834764831845f + rpb[(h * 15 + (kr - qr + 7)) * 31 + (kc - qc + 15)];
            mx = fmaxf(mx, sc[i]);
        }
        mx = wave_max(mx);
        float sum = 0.f;
#pragma unroll
        for (int i = 0; i < 2; ++i) { const float p = __expf(sc[i] - mx); ps[w][lane + 64 * i] = p; sum += p; }
        sum = wave_sum(sum);
        const float inv = 1.f / sum;
        float o0 = 0.f, o1 = 0.f;
        for (int kk = 0; kk < 128; ++kk) {
            const int kr = rs + (kk >> 4), kc = cs + (kk & 15);
            const bf16_t* vp = QKV + (size_t)(b * SEQ + kr * GW + kc) * NQKV + C_VB + h * 128;
            const float p = ps[w][kk]; o0 += p * bf2f(vp[lane]); o1 += p * bf2f(vp[lane + 64]);
        }
        bf16_t* o = OB + (size_t)t * 1024 + h * 128;
        o[lane] = f2bf(o0 * inv); o[lane + 64] = f2bf(o1 * inv);
    }
}

__global__ void k_conv_glu(const bf16_t* __restrict__ U, const float* __restrict__ cw, const float* __restrict__ cb, bf16_t* __restrict__ ACT) {
    const size_t n = (size_t)SEQ * DFF;
    for (size_t idx = (size_t)blockIdx.x * blockDim.x + threadIdx.x; idx < n; idx += (size_t)gridDim.x * blockDim.x) {
        const int s = (int)(idx / DFF), j = (int)(idx % DFF);
        float gt = cb[j], vl = cb[j + DFF];
#pragma unroll
        for (int t = 0; t < 3; ++t) {
            const int ss = s + t - 1;
            if (ss >= 0 && ss < SEQ) { gt += cw[t * NUP + j] * bf2f(U[(size_t)ss * NUP + j]); vl += cw[t * NUP + j + DFF] * bf2f(U[(size_t)ss * NUP + j + DFF]); }
        }
        ACT[(size_t)s * DFF + j] = f2bf(gt / (1.f + __expf(-gt)) * vl);
    }
}

}

namespace pg8 {
#define PG8_LAS __attribute__((address_space(3)))
typedef short bf16x8 __attribute__((ext_vector_type(8)));
constexpr int BM = 256, BK = 64, HALF = 128, HTB = HALF * BK * 2  , STAGE_BYTES = 8 * HTB, NXCD = 8, WGM = 8;

__host__ __device__ __forceinline__ int lds_byte(int r, int c) { const int st = (r >> 4) * 2 + (c >> 5), rr = r & 15, cc = c & 31, ob = rr * 64 + cc * 2; return st * 1024 + (ob ^ (((ob >> 9) & 1) << 5)); }
__host__ __device__ __forceinline__ void stage_rc(int b, int& R, int& C) { const int st = b / 1024, sb = b % 1024, swz = sb ^ (((sb >> 9) & 1) << 5); R = (st >> 1) * 16 + swz / 64; C = (st & 1) * 32 + (swz % 64) / 2; }

struct Unit { int pm, pn, sel, idx; };
struct Gemm { const bf16_t* A; const bf16_t* Bt; const bf16_t* A2; const bf16_t* Bt2; int M, N, K; unsigned* dbg; };

template <int NM, int NN, int PAIR = 0>
struct StaticOrderT {
    int G, c, shift;
    __host__ __device__ void init(int G_, int c_, int rot_ = 0) { G = G_; c = c_; constexpr int q = (NM * NN) / NXCD; shift = ((NM * NN) % NXCD == 0 && rot_) ? (32 * rot_) % q : 0; }
    __host__ __device__ bool next(int i, Unit& u) const {
        constexpr int nwg = NM * NN;
        const int ii = PAIR ? (i >> 1) : i; u.sel = PAIR ? (i & 1) : 0; u.idx = i;
        const long L = (long)ii * G + c; if (L >= nwg) return false;
        int wgid = (int)L; { constexpr int q = nwg / NXCD, r = nwg % NXCD; const int xcd = wgid % NXCD; int off = wgid / NXCD;
            if (shift) { off += shift; off -= (off >= q) ? q : 0; }
            wgid = (xcd < r ? xcd * (q + 1) : r * (q + 1) + (xcd - r) * q) + off; }
        constexpr int nig = WGM * NN; const int gid = wgid / nig, fm = gid * WGM, gsz = (NM - fm) < WGM ? (NM - fm) : WGM;
        u.pm = fm + ((wgid % nig) % gsz); u.pn = (wgid % nig) / gsz; return true;
    }
};

typedef float f32x2_t __attribute__((ext_vector_type(2))); typedef int i32x4_t __attribute__((ext_vector_type(4))); typedef __bf16 bf16x2_t __attribute__((ext_vector_type(2)));
__device__ __forceinline__ unsigned cvt_pk_bf16(float lo, float hi) { f32x2_t v = {lo, hi}; bf16x2_t b = __builtin_convertvector(v, bf16x2_t); return __builtin_bit_cast(unsigned, b); }
__device__ __forceinline__ u32x4 pack8(const f32x4& a, const f32x4& b) { u32x4 w; w.x = cvt_pk_bf16(a[0], a[1]); w.y = cvt_pk_bf16(a[2], a[3]); w.z = cvt_pk_bf16(b[0], b[1]); w.w = cvt_pk_bf16(b[2], b[3]); return w; }
__device__ __forceinline__ void unpack8(const u32x4& w, f32x4& a, f32x4& b) {
    a[0] = __uint_as_float(w.x << 16); a[1] = __uint_as_float(w.x & 0xffff0000u); a[2] = __uint_as_float(w.y << 16); a[3] = __uint_as_float(w.y & 0xffff0000u);
    b[0] = __uint_as_float(w.z << 16); b[1] = __uint_as_float(w.z & 0xffff0000u); b[2] = __uint_as_float(w.w << 16); b[3] = __uint_as_float(w.w & 0xffff0000u); }
#define PG8_XBAR() do { asm volatile("s_waitcnt lgkmcnt(0)" ::: "memory"); __builtin_amdgcn_s_barrier(); asm volatile("" ::: "memory"); } while (0)


struct EpiProj {
    static constexpr int VM_MIN = 14;
    bf16_t* QKV; bf16_t* G; const float* norms; const float* rope; const float* rs1; const float* csc; int pm0;
    __device__ __forceinline__ void operator()(f32x4 (&acc)[2][2][4][2], const Unit& u, int wr, int wc, int fr, int fq, PG8_LAS unsigned char* xl) const {
        const int pn = u.pn, hd = wc >> 1, w1 = wc & 1;
        const int colt = 128 * hd + 32 * w1 + 8 * fq;
        const int row0 = u.pm * BM + wr * 64 + fr;
        {
            const bool tab = (u.pm == pm0) && (u.idx < 9);
            const PG8_LAS float* RST = (const PG8_LAS float*)(xl + 4096); const PG8_LAS float* CST = (const PG8_LAS float*)(xl + 7168) + u.idx * 256;
            f32x4 cs[2][2];
#pragma unroll
            for (int bj = 0; bj < 2; ++bj)
#pragma unroll
                for (int n = 0; n < 2; ++n) { cs[bj][n] = tab ? *(const PG8_LAS f32x4*)(CST + 128 * bj + 32 * wc + 16 * n + 4 * fq) : *(const f32x4*)(csc + pn * 256 + 128 * bj + 32 * wc + 16 * n + 4 * fq);
                    if (pn >= 18) cs[bj][n] *= -1.4426950408889634f; }
#pragma unroll
            for (int ai = 0; ai < 2; ++ai)
#pragma unroll
                for (int m = 0; m < 4; ++m) { const float rs = tab ? RST[ai * 128 + wr * 64 + m * 16 + fr] : rs1[row0 + ai * 128 + m * 16];
#pragma unroll
                    for (int bj = 0; bj < 2; ++bj)
#pragma unroll
                        for (int n = 0; n < 2; ++n) { const i32x4_t iv = __builtin_bit_cast(i32x4_t, acc[ai][bj][m][n]); acc[ai][bj][m][n] = __builtin_convertvector(iv, f32x4) * (cs[bj][n] * rs); } }
        }
        if (pn >= 18) {
            unsigned char* base = (unsigned char*)G + (size_t)row0 * NGATE + (pn - 18) * 256 + colt;
#pragma unroll
            for (int ai = 0; ai < 2; ++ai)
#pragma unroll
                for (int m = 0; m < 4; ++m) { unsigned char* rowp = base + (size_t)(ai * 128 + m * 16) * NGATE;
#pragma unroll
                    for (int bj = 0; bj < 2; ++bj) { u32x2 w;
#pragma unroll
                        for (int n = 0; n < 2; ++n) { unsigned pk = 0u;
#pragma unroll
                            for (int e = 0; e < 4; ++e) { const float sg = __builtin_amdgcn_rcpf(fmaf(__builtin_amdgcn_exp2f(acc[ai][bj][m][n][e]), 1.f / 255.f, 1.f / 255.f)); pk = __builtin_amdgcn_cvt_pk_u8_f32(sg, e, pk); }
                            w[n] = pk; }
                        *(u32x2*)(rowp + 64 * bj) = w; } }
            return;
        }
        bf16_t* base = QKV + (size_t)row0 * NQKV + pn * 256 + colt;
        if (pn == 5 || pn >= 14) {
#pragma unroll
            for (int ai = 0; ai < 2; ++ai)
#pragma unroll
                for (int m = 0; m < 4; ++m) { bf16_t* rowp = base + (size_t)(ai * 128 + m * 16) * NQKV;
#pragma unroll
                    for (int bj = 0; bj < 2; ++bj) *(u32x4*)(rowp + 64 * bj) = pack8(acc[ai][bj][m][0], acc[ai][bj][m][1]); }
            return;
        }
        const bool do_rope = pn < 5;
        const float* g = norms + 128 * (pn < 4 ? 0 : pn == 4 ? 1 : pn < 10 ? 2 : 3);
        float ss[2][4];
#pragma unroll
        for (int ai = 0; ai < 2; ++ai)
#pragma unroll
            for (int m = 0; m < 4; ++m) { float s; f32x2_t s2 = {0.f, 0.f};
#pragma unroll
                for (int bj = 0; bj < 2; ++bj)
#pragma unroll
                    for (int n = 0; n < 2; ++n) { const f32x4 v = acc[ai][bj][m][n]; const f32x2_t lo = {v[0], v[1]}, hi = {v[2], v[3]}; s2 = __builtin_elementwise_fma(lo, lo, s2); s2 = __builtin_elementwise_fma(hi, hi, s2); }
                s = s2[0] + s2[1];
                s += __shfl_xor(s, 16); s += __shfl_xor(s, 32); ss[ai][m] = s; }
        PG8_LAS float* X = (PG8_LAS float*)xl;
        if (fq == 0) {
#pragma unroll
            for (int ai = 0; ai < 2; ++ai)
#pragma unroll
                for (int m = 0; m < 4; ++m) X[(ai * 128 + wr * 64 + m * 16 + fr) * 4 + wc] = ss[ai][m];
        }
        PG8_XBAR();
#pragma unroll
        for (int ai = 0; ai < 2; ++ai)
#pragma unroll
            for (int m = 0; m < 4; ++m) ss[ai][m] = __builtin_amdgcn_rsqf((ss[ai][m] + X[(ai * 128 + wr * 64 + m * 16 + fr) * 4 + (wc ^ 1)]) * (1.f / 128.f) + EPS);
        const float qsc = (pn < 4 || (pn >= 6 && pn < 10)) ? 0.08838834764831845f * 1.4426950408889634f : 1.f;
        const PG8_LAS float* gp = (const PG8_LAS float*)(xl + 5120) + (g - norms) + 32 * w1 + 8 * fq;
        const f32x4 g00 = *(const PG8_LAS f32x4*)(gp), g01 = *(const PG8_LAS f32x4*)(gp + 4), g10 = *(const PG8_LAS f32x4*)(gp + 64), g11 = *(const PG8_LAS f32x4*)(gp + 68);
#pragma unroll
        for (int ai = 0; ai < 2; ++ai)
#pragma unroll
            for (int m = 0; m < 4; ++m) {
                const float r = ss[ai][m] * qsc;
                f32x4 a0 = acc[ai][0][m][0] * r * g00, a1 = acc[ai][0][m][1] * r * g01, b0 = acc[ai][1][m][0] * r * g10, b1 = acc[ai][1][m][1] * r * g11;
                if (do_rope) {
                    const int pos = (row0 + ai * 128 + m * 16) & (SEQ - 1);
                    const float* cp = rope + (size_t)pos * 64 + 32 * w1 + 8 * fq;
                    const f32x4 c0 = *(const f32x4*)(cp), c1 = *(const f32x4*)(cp + 4), s0 = *(const f32x4*)(cp + SEQ * 64), s1 = *(const f32x4*)(cp + SEQ * 64 + 4);
                    const f32x4 ta0 = a0 * c0 - b0 * s0, tb0 = b0 * c0 + a0 * s0, ta1 = a1 * c1 - b1 * s1, tb1 = b1 * c1 + a1 * s1;
                    a0 = ta0; b0 = tb0; a1 = ta1; b1 = tb1;
                }
                bf16_t* rowp = base + (size_t)(ai * 128 + m * 16) * NQKV;
                *(u32x4*)(rowp) = pack8(a0, a1); *(u32x4*)(rowp + 64) = pack8(b0, b1);
                if (m & 1) asm volatile("" ::: "memory");
            }
    }
};

struct EpiBranch {
    static constexpr int VM_MIN = 28;
    bf16_t* MG; const bf16_t* G;
    __device__ __forceinline__ void operator()(f32x4 (&acc)[2][2][4][2], const Unit& u, int wr, int wc, int fr, int fq, PG8_LAS unsigned char* xl) const {
        const int row0 = u.pm * BM + wr * 64 + fr, colt = u.pn * 256 + 32 * wc + 8 * fq;
#pragma unroll
        for (int ai = 0; ai < 2; ++ai)
#pragma unroll
            for (int m = 0; m < 4; ++m) { const size_t row = (size_t)(row0 + ai * 128 + m * 16);
#pragma unroll
                for (int bj = 0; bj < 2; ++bj) {
                    const u32x2 gbw = *(const u32x2*)((const unsigned char*)G + row * NGATE + 2048 + colt + 128 * bj);
                    f32x4 b0, b1;
#pragma unroll
                    for (int e = 0; e < 4; ++e) { b0[e] = fmaxf((float)((gbw.x >> (8 * e)) & 255u), 255e-30f); b1[e] = fmaxf((float)((gbw.y >> (8 * e)) & 255u), 255e-30f); }
                    if (u.sel == 0) {
                        const u32x2 gaw = *(const u32x2*)((const unsigned char*)G + row * NGATE + colt + 128 * bj);
                        f32x4 a0, a1;
#pragma unroll
                        for (int e = 0; e < 4; ++e) { a0[e] = (float)((gaw.x >> (8 * e)) & 255u); a1[e] = (float)((gaw.y >> (8 * e)) & 255u); b0[e] = __builtin_amdgcn_rcpf(b0[e]); b1[e] = __builtin_amdgcn_rcpf(b1[e]); }
                        acc[ai][bj][m][0] *= a0 * b0; acc[ai][bj][m][1] *= a1 * b1;
                    } else {
                        *(u32x4*)(MG + row * DM + colt + 128 * bj) = pack8(acc[ai][bj][m][0] * (b0 * (1.f / 255.f)), acc[ai][bj][m][1] * (b1 * (1.f / 255.f)));
                    }
                }
                if (m & 1) asm volatile("" ::: "memory"); }
    }
};

struct EpiOut {
    static constexpr int VM_MIN = 40;
    const float* x; float* X1; bf16_t* X1B; float* SSQ;
    __device__ __forceinline__ void operator()(f32x4 (&acc)[2][2][4][2], const Unit& u, int wr, int wc, int fr, int fq, PG8_LAS unsigned char* xl) const {
        const int row0 = u.pm * BM + wr * 64 + fr, colt = u.pn * 256 + 32 * wc + 8 * fq;
        PG8_LAS float* X = (PG8_LAS float*)xl;
#pragma unroll
        for (int ai = 0; ai < 2; ++ai)
#pragma unroll
            for (int m = 0; m < 4; ++m) { const size_t row = (size_t)(row0 + ai * 128 + m * 16); float s = 0.f;
#pragma unroll
                for (int bj = 0; bj < 2; ++bj) {
                    const size_t off = row * DM + colt + 128 * bj;
                    const f32x4 v0 = *(const f32x4*)(x + off) + acc[ai][bj][m][0], v1 = *(const f32x4*)(x + off + 4) + acc[ai][bj][m][1];
                    *(u32x4*)(X1B + off) = pack8(v0, v1);
                    s += (v0[0] * v0[0] + v0[1] * v0[1]) + (v0[2] * v0[2] + v0[3] * v0[3]) + (v1[0] * v1[0] + v1[1] * v1[1]) + (v1[2] * v1[2] + v1[3] * v1[3]);
                }
                s += __shfl_xor(s, 16); s += __shfl_xor(s, 32);
                if (fq == 0) X[(ai * 128 + wr * 64 + m * 16 + fr) * 4 + wc] = s; }
        PG8_XBAR();
        if (wc == 0 && fq == 0) {
#pragma unroll
            for (int ai = 0; ai < 2; ++ai)
#pragma unroll
                for (int m = 0; m < 4; ++m) { const int r = ai * 128 + wr * 64 + m * 16 + fr; const f32x4 p = *(const PG8_LAS f32x4*)(X + r * 4);
                    SSQ[(size_t)(u.pm * BM + r) * 8 + u.pn] = (p[0] + p[1]) + (p[2] + p[3]); }
        }
    }
};

struct EpiUp {
    static constexpr int VM_MIN = 8;
    bf16_t* ACT; float* HALO; const float* SSQ; const float* cw; const float* cb; int pm0;
    __device__ __forceinline__ void operator()(f32x4 (&acc)[2][2][4][2], const Unit& u, int wr, int wc, int fr, int fq, PG8_LAS unsigned char* xl) const {
        const int lane = fq * 16 + fr, wid = wr * 4 + wc;
        const int rowb = u.pm * BM + wr * 64 + 4 * fr;
        const int ucol = u.pn * 128 + wc * 32 + 8 * fq;
        PG8_LAS f32x4* E = (PG8_LAS f32x4*)xl;
        PG8_LAS float* CF = (PG8_LAS float*)(xl + 8192);
        {
            const float* src = (wid < 6 ? cw + (size_t)(wid >> 1) * NUP : cb) + (wid & 1) * DFF + u.pn * 128;
            const float fs = (wid & 1) ? -0.6931471805599453f : -1.4426950408889634f;
            const float c0 = src[lane] * fs, c1 = src[lane + 64] * fs;
            CF[wid * 128 + lane] = c0; CF[wid * 128 + lane + 64] = c1;
        }
        const PG8_LAS float* RS = (const PG8_LAS float*)(xl + 12288);
        const bool rs_lds = (u.pm == pm0);
#pragma unroll
        for (int ai = 0; ai < 2; ++ai)
#pragma unroll
            for (int m = 0; m < 4; ++m) { float r;
                if (rs_lds) r = RS[ai * 128 + wr * 64 + 4 * fr + m];
                else { const float* sp = SSQ + (size_t)(rowb + ai * 128 + m) * 8; const f32x4 a = *(const f32x4*)sp, b = *(const f32x4*)(sp + 4);
                    r = __builtin_amdgcn_rsqf(((a[0] + a[1]) + (a[2] + a[3]) + (b[0] + b[1]) + (b[2] + b[3])) * (1.f / DM) + EPS); }
#pragma unroll
                for (int bj = 0; bj < 2; ++bj)
#pragma unroll
                    for (int n = 0; n < 2; ++n) acc[ai][bj][m][n] *= r;
                if (m & 1) asm volatile("" ::: "memory"); }
        if (wr == 0 && fr == 0) {
#pragma unroll
            for (int mm = 0; mm < 2; ++mm)
#pragma unroll
                for (int bj = 0; bj < 2; ++bj)
#pragma unroll
                    for (int n = 0; n < 2; ++n) *(f32x4*)(HALO + (size_t)(u.pm * 4 + mm) * NUP + bj * DFF + ucol + 4 * n) = acc[0][bj][mm][n];
        }
        if (wr == 1 && fr == 15) {
#pragma unroll
            for (int mm = 2; mm < 4; ++mm)
#pragma unroll
                for (int bj = 0; bj < 2; ++bj)
#pragma unroll
                    for (int n = 0; n < 2; ++n) *(f32x4*)(HALO + (size_t)(u.pm * 4 + mm) * NUP + bj * DFF + ucol + 4 * n) = acc[1][bj][mm][n];
        }
        if (fr == 0) {
#pragma unroll
            for (int ai = 0; ai < 2; ++ai)
#pragma unroll
                for (int bj = 0; bj < 2; ++bj)
#pragma unroll
                    for (int n = 0; n < 2; ++n) E[((wid * 2 + ai) * 2 + 0) * 16 + 8 * bj + 4 * n + fq] = acc[ai][bj][0][n];
        }
        if (fr == 15) {
#pragma unroll
            for (int ai = 0; ai < 2; ++ai)
#pragma unroll
                for (int bj = 0; bj < 2; ++bj)
#pragma unroll
                    for (int n = 0; n < 2; ++n) E[((wid * 2 + ai) * 2 + 1) * 16 + 8 * bj + 4 * n + fq] = acc[ai][bj][3][n];
        }
        PG8_XBAR();
        __builtin_amdgcn_sched_barrier(0);
        const PG8_LAS float* Ef = (const PG8_LAS float*)E;
        const PG8_LAS float* cfp = CF + 32 * wc + 8 * fq;
#pragma unroll
        for (int n = 0; n < 2; ++n) {
#pragma unroll
            for (int ep = 0; ep < 2; ++ep) {
                f32x2_t cf[8];
#pragma unroll
                for (int k = 0; k < 8; ++k) cf[k] = *(const PG8_LAS f32x2_t*)(cfp + k * 128 + 4 * n + 2 * ep);
#pragma unroll
                for (int ai = 0; ai < 2; ++ai) {
                    const bool pext = (wr == 0 && ai == 0), next_ext = (wr == 1 && ai == 1);
                    const int pidx = wr == 1 ? (((wid - 4) * 2 + ai) * 2 + 1) * 16 : (((wid + 4) * 2 + 0) * 2 + 1) * 16;
                    const int nidx = wr == 0 ? (((wid + 4) * 2 + ai) * 2 + 0) * 16 : (((wid - 4) * 2 + 1) * 2 + 0) * 16;
                    f32x2_t o[2][4], Uv[2][4];
#pragma unroll
                    for (int bj = 0; bj < 2; ++bj)
#pragma unroll
                        for (int m = 0; m < 4; ++m) { Uv[bj][m][0] = acc[ai][bj][m][n][2 * ep]; Uv[bj][m][1] = acc[ai][bj][m][n][2 * ep + 1]; }
                    asm volatile("" : "+v"(Uv[0][0]), "+v"(Uv[0][1]), "+v"(Uv[0][2]), "+v"(Uv[0][3]), "+v"(Uv[1][0]), "+v"(Uv[1][1]), "+v"(Uv[1][2]), "+v"(Uv[1][3]));
#pragma unroll
                    for (int bj = 0; bj < 2; ++bj) {
                        f32x2_t pe = {0.f, 0.f}, ne = {0.f, 0.f};
                        if (!pext) pe = *(const PG8_LAS f32x2_t*)(Ef + (pidx + 8 * bj + 4 * n + fq) * 4 + 2 * ep);
                        if (!next_ext) ne = *(const PG8_LAS f32x2_t*)(Ef + (nidx + 8 * bj + 4 * n + fq) * 4 + 2 * ep);
                        f32x2_t pA, nA;
#pragma unroll
                        for (int c = 0; c < 2; ++c) {
                            pA[c] = __int_as_float(__builtin_amdgcn_update_dpp(__float_as_int(pe[c]), __float_as_int(Uv[bj][3][c]), 0x111, 0xF, 0xF, false));
                            nA[c] = __int_as_float(__builtin_amdgcn_update_dpp(__float_as_int(ne[c]), __float_as_int(Uv[bj][0][c]), 0x101, 0xF, 0xF, false));
                        }
#pragma unroll
                        for (int m = 0; m < 4; ++m) {
                            const f32x2_t pv = m == 0 ? pA : Uv[bj][m == 0 ? 0 : m - 1];
                            const f32x2_t nx = m == 3 ? nA : Uv[bj][m == 3 ? 3 : m + 1];
                            o[bj][m] = __builtin_elementwise_fma(cf[bj], pv, __builtin_elementwise_fma(cf[2 + bj], Uv[bj][m], __builtin_elementwise_fma(cf[4 + bj], nx, cf[6 + bj])));
                        }
                    }
                    f32x2_t rs[4];
#pragma unroll
                    for (int m = 0; m < 4; ++m) { const f32x2_t t = o[0][m]; f32x2_t d; d[0] = __builtin_amdgcn_exp2f(t[0]); d[1] = __builtin_amdgcn_exp2f(t[1]); d = d + 1.f;
                        f32x2_t rc; rc[0] = __builtin_amdgcn_rcpf(d[0]); rc[1] = __builtin_amdgcn_rcpf(d[1]); rs[m] = (t * rc) * o[1][m]; }
                    asm volatile("" : "+v"(rs[0]), "+v"(rs[1]), "+v"(rs[2]), "+v"(rs[3]));
#pragma unroll
                    for (int m = 0; m < 4; ++m) { acc[ai][0][m][n][2 * ep] = rs[m][0]; acc[ai][0][m][n][2 * ep + 1] = rs[m][1]; }
                    __builtin_amdgcn_sched_barrier(0);
                }
            }
        }
#pragma unroll
        for (int ai = 0; ai < 2; ++ai)
#pragma unroll
            for (int m = 0; m < 4; ++m) { *(u32x4*)(ACT + (size_t)(rowb + ai * 128 + m) * DFF + ucol) = pack8(acc[ai][0][m][0], acc[ai][0][m][1]);
                if (m & 1) asm volatile("" ::: "memory"); }
    }
};

struct EpiDown {
    static constexpr int VM_MIN = 40;
    float* out; const bf16_t* X1B;
    __device__ __forceinline__ void operator()(f32x4 (&acc)[2][2][4][2], const Unit& u, int wr, int wc, int fr, int fq, PG8_LAS unsigned char* xl) const {
        const int row0 = u.pm * BM + wr * 64 + fr, colt = u.pn * 256 + 32 * wc + 8 * fq;
#pragma unroll
        for (int ai = 0; ai < 2; ++ai)
#pragma unroll
            for (int m = 0; m < 4; ++m) { const size_t rowoff = (size_t)(row0 + ai * 128 + m * 16) * DM + colt;
#pragma unroll
                for (int bj = 0; bj < 2; ++bj) { const u32x4 xw = *(const u32x4*)(X1B + rowoff + 128 * bj); f32x4 x0, x1; unpack8(xw, x0, x1);
                    float* op = out + rowoff + 128 * bj; *(f32x4*)op = x0 + acc[ai][bj][m][0]; *(f32x4*)(op + 4) = x1 + acc[ai][bj][m][1]; }
                if (m & 1) asm volatile("" ::: "memory"); }
    }
};

template <int EREP = 1, int KREP = 1, bool I8 = false, bool APERM = false, class Epi, class Sched>
__device__ __forceinline__ void gemm_phase(PG8_LAS unsigned char* lds, PG8_LAS unsigned char* xl, const Gemm g, const Sched& S, const Epi& E) {
    const int tid = threadIdx.x, wid = __builtin_amdgcn_readfirstlane(tid >> 6), lane = tid & 63, wr = wid >> 2, wc = wid & 3, fr = lane & 15, fq = lane >> 4;
    const int K = g.K, nt = K / BK;
    unsigned voffA[2], voffB[2];
#pragma unroll
    for (int i = 0; i < 2; ++i) { int R, C; stage_rc(tid * 16 + i * 8192, R, C); const int Ra = APERM ? ((R & 64) | ((R & 15) << 2) | ((R >> 4) & 3)) : R;
        voffA[i] = (unsigned)(Ra * K + C) * 2u; voffB[i] = (unsigned)(R * K + C) * 2u; }
    const size_t kstep = (size_t)(BK * 2);
    const size_t hstep = (size_t)HALF * K * 2;
    const size_t tstep = 2 * hstep;
    const unsigned ldsw = (unsigned)wid * 1024u;
    const int aoff = lds_byte(wr * 64 + fr, fq * 8), boff = lds_byte(wc * 32 + fr, fq * 8);
#define PG8_SA(b, h) (((b) * 2 + (h)) * HTB)
#define PG8_SB(b, h) ((4 + (b) * 2 + (h)) * HTB)
#define PG8_STAGE_V(bufoff, gbase, voff) do { _Pragma("unroll") for (int _i = 0; _i < 2; ++_i) \
        __builtin_amdgcn_global_load_lds((const unsigned*)((const char*)(gbase) + (voff)[_i]), (PG8_LAS unsigned*)(lds + (bufoff) + ldsw + _i * 8192), 16, 0, 0); } while (0)
#define PG8_STAGE(bufoff, gbase) PG8_STAGE_V(bufoff, gbase, ((bufoff) >= 4 * HTB ? voffB : voffA))
#define PG8_LDA(dst, b, h) do { _Pragma("unroll") for (int m = 0; m < 4; ++m) _Pragma("unroll") for (int k = 0; k < 2; ++k) dst[m][k] = *(const PG8_LAS bf16x8*)(lds + PG8_SA(b, h) + aoff + m * 2048 + k * 1024); } while (0)
#define PG8_LDB(dst, b, h) do { _Pragma("unroll") for (int n = 0; n < 2; ++n) _Pragma("unroll") for (int k = 0; k < 2; ++k) dst[n][k] = *(const PG8_LAS bf16x8*)(lds + PG8_SB(b, h) + boff + n * 2048 + k * 1024); } while (0)
    typedef int i32x4 __attribute__((ext_vector_type(4)));
#define PG8_MMA(ai, bj, At, Bt) do { __builtin_amdgcn_s_setprio(1); _Pragma("unroll") for (int m = 0; m < 4; ++m) _Pragma("unroll") for (int n = 0; n < 2; ++n) _Pragma("unroll") for (int k = 0; k < 2; ++k) { \
        if constexpr (I8) acc[ai][bj][m][n] = __builtin_bit_cast(f32x4, __builtin_amdgcn_mfma_i32_16x16x64_i8(__builtin_bit_cast(i32x4, Bt[n][k]), __builtin_bit_cast(i32x4, At[m][k]), __builtin_bit_cast(i32x4, acc[ai][bj][m][n]), 0, 0, 0)); \
        else acc[ai][bj][m][n] = __builtin_amdgcn_mfma_f32_16x16x32_bf16(Bt[n][k], At[m][k], acc[ai][bj][m][n], 0, 0, 0); } __builtin_amdgcn_s_setprio(0); } while (0)
#define PG8_WAIT_V(n) asm volatile("s_waitcnt vmcnt(" #n ")" ::: "memory")
#define PG8_WAIT_VI(n) asm volatile("s_waitcnt vmcnt(%0)" :: "n"(n) : "memory")
#define PG8_WAIT_V8R() do { if (relax) PG8_WAIT_VI(8 + Epi::VM_MIN); else PG8_WAIT_V(8); } while (0)
#define PG8_WAIT_L(n) asm volatile("s_waitcnt lgkmcnt(" #n ")" ::: "memory")
#define PG8_BAR __builtin_amdgcn_s_barrier()
#define PG8_SCHED __builtin_amdgcn_sched_barrier(0)
#if defined(DBGT) && DBGT
#define PG8_STAMP(slot) do { if (g.dbg && wid == 0 && lane == 0) g.dbg[ui * 4 + (slot)] = (unsigned)__builtin_amdgcn_s_memrealtime(); } while (0)
#else
#define PG8_STAMP(slot) do {} while (0)
#endif
#define PG8_UA(u) ((const char*)((u).sel ? g.A2 : g.A) + (size_t)(u).pm * tstep)
#define PG8_UB(u) ((const char*)((u).sel ? g.Bt2 : g.Bt) + (size_t)(u).pn * tstep)
    Unit cur, nxt; int ui = 0;
    if (!S.next(0, cur)) return;
    f32x4 acc[2][2][4][2];
#pragma unroll
    for (int a = 0; a < 2; ++a)
#pragma unroll
        for (int b = 0; b < 2; ++b)
#pragma unroll
            for (int m = 0; m < 4; ++m)
#pragma unroll
                for (int n = 0; n < 2; ++n) acc[a][b][m][n] = (f32x4){0.f, 0.f, 0.f, 0.f};
    bf16x8 At[4][2], B0[2][2], B1[2][2];
    const char* cA = PG8_UA(cur); const char* cB = PG8_UB(cur);
    PG8_STAGE(PG8_SB(0, 0), cB); PG8_STAGE(PG8_SB(0, 1), cB + hstep); PG8_STAGE(PG8_SA(0, 0), cA); PG8_STAGE(PG8_SA(0, 1), cA + hstep);
    if (wr == 1) PG8_BAR;
    PG8_WAIT_V(2); PG8_BAR;
    PG8_STAGE(PG8_SB(1, 0), cB + kstep); PG8_STAGE(PG8_SA(1, 0), cA + kstep); PG8_STAGE(PG8_SB(1, 1), cB + hstep + kstep);
    PG8_WAIT_V(6); PG8_BAR;
    for (;;) {
        const bool has_next = S.next(ui + 1, nxt);
        const char* nA = has_next ? PG8_UA(nxt) : cA; const char* nB = has_next ? PG8_UB(nxt) : cB;
        PG8_STAMP(0);
        for (int krep = 0; krep < KREP; ++krep)
        for (int t = 0; t < nt; t += 2) {
            if (KREP > 1 && krep > 0 && t == 0) {
#pragma unroll
                for (int a = 0; a < 2; ++a)
#pragma unroll
                    for (int b = 0; b < 2; ++b)
#pragma unroll
                        for (int m = 0; m < 4; ++m)
#pragma unroll
                            for (int n = 0; n < 2; ++n) acc[a][b][m][n] = (f32x4){0.f, 0.f, 0.f, 0.f};
            }
            const bool last = (t == nt - 2) && (krep == KREP - 1);
            const char* a1 = cA + (size_t)(t + 1) * kstep;
            const bool wrap = (t == nt - 2) && !last;
            const char* a2 = last ? nA : (wrap ? cA : cA + (size_t)(t + 2) * kstep); const char* b2 = last ? nB : (wrap ? cB : cB + (size_t)(t + 2) * kstep);
            const char* a3 = a2 + kstep; const char* b3 = b2 + kstep;
#ifdef NO_RELAX
            constexpr bool relax = false;
#else
            const bool relax = (t == 0) && (ui > 0) && (krep == 0);
#endif
            PG8_LDB(B0, 0, 0); PG8_LDB(B1, 0, 1); PG8_SCHED; PG8_LDA(At, 0, 0); PG8_STAGE(PG8_SA(1, 1), a1 + hstep);
            PG8_WAIT_V8R(); PG8_WAIT_L(0); PG8_BAR; PG8_MMA(0, 0, At, B0); PG8_MMA(0, 1, At, B1); PG8_BAR; PG8_SCHED;
            PG8_LDA(At, 0, 1); PG8_STAGE(PG8_SB(0, 0), b2); PG8_STAGE(PG8_SB(0, 1), b2 + hstep); PG8_STAGE(PG8_SA(0, 0), a2);
            PG8_WAIT_V8R(); PG8_WAIT_L(0); PG8_BAR; PG8_MMA(1, 0, At, B0); PG8_MMA(1, 1, At, B1); PG8_BAR; PG8_SCHED;
            PG8_LDB(B0, 1, 0); PG8_LDB(B1, 1, 1); PG8_SCHED; PG8_LDA(At, 1, 0); PG8_STAGE(PG8_SA(0, 1), a2 + hstep);
            PG8_WAIT_V(8); PG8_WAIT_L(0); PG8_BAR; PG8_MMA(0, 0, At, B0); PG8_MMA(0, 1, At, B1); PG8_BAR; PG8_SCHED;
            PG8_LDA(At, 1, 1); PG8_STAGE(PG8_SB(1, 0), b3); PG8_STAGE(PG8_SB(1, 1), b3 + hstep); PG8_STAGE(PG8_SA(1, 0), a3);
            PG8_WAIT_V(8); PG8_WAIT_L(0); PG8_BAR; PG8_MMA(1, 0, At, B0); PG8_MMA(1, 1, At, B1); PG8_BAR; PG8_SCHED;
        }
        PG8_STAMP(1);
        if (wr == 0) PG8_BAR;
        PG8_STAMP(2);
#pragma unroll
        for (int er = 0; er < EREP; ++er) E(acc, cur, wr, wc, fr, fq, xl);
        PG8_STAMP(3);
        if (!has_next) break;
        if (nxt.sel == 0) {
#pragma unroll
            for (int a = 0; a < 2; ++a)
#pragma unroll
                for (int b = 0; b < 2; ++b)
#pragma unroll
                    for (int m = 0; m < 4; ++m)
#pragma unroll
                        for (int n = 0; n < 2; ++n) acc[a][b][m][n] = (f32x4){0.f, 0.f, 0.f, 0.f};
        }
        cur = nxt; cA = nA; cB = nB; ++ui;
        if (wr == 1) PG8_BAR;
    }
    PG8_WAIT_V(0);
    PG8_BAR;
#undef PG8_SA
#undef PG8_SB
#undef PG8_STAGE
#undef PG8_STAGE_V
#undef PG8_LDA
#undef PG8_LDB
#undef PG8_MMA
#undef PG8_WAIT_V
#undef PG8_WAIT_VI
#undef PG8_WAIT_V8R
#undef PG8_WAIT_L
#undef PG8_BAR
#undef PG8_SCHED
#undef PG8_UA
#undef PG8_STAMP
#undef PG8_UB
}
}

constexpr int NWAVES = 8;
constexpr int N_PHASES = 8;
constexpr int RING_OFF = 0, RING_BYTES = 131072;
constexpr int LDSCTL_OFF = RING_BYTES, MISC_OFF = LDSCTL_OFF + 320, XCH_OFF = RING_BYTES + 1024;
constexpr int LDS_BYTES = 151552;
static_assert(XCH_OFF + 16384 <= LDS_BYTES, "LDS map");
constexpr int CW_BAR = 4096;
constexpr size_t WO_IN = 0, WO_A = (size_t)NIN * DM * 2, WO_B = WO_A + (size_t)DM * 1024 * 2, WO_OUT = WO_B + (size_t)DM * 1024 * 2, WO_UP = WO_OUT + (size_t)DM * DM * 2, WO_DN = WO_UP + (size_t)NUP * DM * 2;
static_assert(WS_W + WO_DN + (size_t)DM * DFF * 2 <= WS_QKV, "weights fit");

#define GAS __attribute__((address_space(1)))
#define LAS __attribute__((address_space(3)))
typedef GAS unsigned gu32;
#define RLX_AGENT __ATOMIC_RELAXED, __HIP_MEMORY_SCOPE_AGENT
#define LDS_WAIT() asm volatile("s_waitcnt lgkmcnt(0)" ::: "memory")

#define XB_TMO      128
#define XB_XCNT(j)  (256  + 64 * (j))
#define XB_XSUB(j)  (1280 + 64 * (j))
#define XB_XGEN(j)  (2304 + 64 * (j))
#define XB_TOP      3328
#define XB_TOPGEN   3392
#define XCD_BAR_WORDS 3456
#define XB_SPIN_CAP (1u << 18)
__device__ __forceinline__ unsigned xb_ld(unsigned* p)              { return __hip_atomic_load(p, __ATOMIC_RELAXED, __HIP_MEMORY_SCOPE_AGENT); }
__device__ __forceinline__ unsigned xb_add(unsigned* p, unsigned v) { return __hip_atomic_fetch_add(p, v, __ATOMIC_RELAXED, __HIP_MEMORY_SCOPE_AGENT); }
__device__ __forceinline__ unsigned xb_xcc_id() { return (unsigned)__builtin_amdgcn_s_getreg((3 << 11) | 20) & 0xFu; }
#define XB_SPIN(cond, bar) do { unsigned _sp = 0; while (cond) { __builtin_amdgcn_s_sleep(1); \
    if ((++_sp & 255u) == 0u) { if (xb_ld(&(bar)[XB_TMO])) break; if (_sp > XB_SPIN_CAP) { atomicAdd(&(bar)[XB_TMO], 1u); break; } } } } while (0)
struct XcdBarrier { unsigned* bar; unsigned x; volatile LAS unsigned* st; };
__device__ __forceinline__ XcdBarrier xcd_barrier_post(unsigned* bar, volatile LAS unsigned* st) {
    XcdBarrier b; b.bar = bar; b.x = xb_xcc_id(); b.st = st;
    if (threadIdx.x == 0) st[2] = xb_add(&bar[XB_XCNT(b.x)], 1u);
    return b;
}
__device__ __forceinline__ void xcd_barrier_complete(unsigned* bar, unsigned x, unsigned& nloc, unsigned& nx, unsigned& uni) {
    const unsigned G = gridDim.x * gridDim.y * gridDim.z;
    unsigned sum, cnt, mine, sp = 0u, low8;
    for (;;) {
        sum = 0u; cnt = 0u; mine = 0u; low8 = 1u;
#pragma unroll
        for (unsigned j = 0; j < 16; ++j) { const unsigned c = xb_ld(&bar[XB_XCNT(j)]); sum += c; cnt += (c > 0u) ? 1u : 0u; mine = (j == x) ? c : mine; if (c != (j < 8u ? 32u : 0u)) low8 = 0u; }
        if (sum == G) break;
        __builtin_amdgcn_s_sleep(1);
        if ((++sp & 255u) == 0u) { if (xb_ld(&bar[XB_TMO])) break; if (sp > XB_SPIN_CAP) { atomicAdd(&bar[XB_TMO], 1u); break; } }
    }
    nloc = mine > 0u ? mine : 1u; nx = cnt > 0u ? cnt : 1u; uni = (sum == G) ? low8 : 0u;
}
template <bool FENCE = true>
__device__ __forceinline__ void xcd_barrier(const XcdBarrier& b) {
    asm volatile("s_waitcnt vmcnt(0)" ::: "memory");
    __syncthreads();
    if (threadIdx.x == 0) {
        unsigned* bar = b.bar;
        __builtin_amdgcn_s_waitcnt(0);
        unsigned nloc = b.st[0], nx = b.st[1];
        if (nloc == 0u) { unsigned uni; xcd_barrier_complete(bar, b.x, nloc, nx, uni); b.st[0] = nloc; b.st[1] = nx; b.st[3] = uni; }
        const unsigned old = xb_add(&bar[XB_XSUB(b.x)], 1u);
        const unsigned gen = old / nloc;
        if (old + 1u == (gen + 1u) * nloc) {
            if (FENCE) __builtin_amdgcn_fence(__ATOMIC_RELEASE, "agent");
            asm volatile("s_waitcnt vmcnt(0)" ::: "memory");
            const unsigned og = xb_add(&bar[XB_TOP], 1u);
            const unsigned tg = og / nx;
            if (og + 1u == (tg + 1u) * nx) xb_add(&bar[XB_TOPGEN], 1u);
            else XB_SPIN(xb_ld(&bar[XB_TOPGEN]) == tg, bar);
            if (FENCE) __builtin_amdgcn_fence(__ATOMIC_ACQUIRE, "agent");
            xb_add(&bar[XB_XGEN(b.x)], 1u);
            asm volatile("s_waitcnt vmcnt(0)" ::: "memory");
        } else {
            XB_SPIN(xb_ld(&bar[XB_XGEN(b.x)]) == gen, bar);
            if (FENCE) __builtin_amdgcn_fence(__ATOMIC_ACQUIRE, "agent");
            asm volatile("s_waitcnt vmcnt(0)" ::: "memory");
        }
    }
    __syncthreads();
}

__device__ __forceinline__ void xcd_barrier_local(const XcdBarrier& b) {
    asm volatile("s_waitcnt vmcnt(0)" ::: "memory");
    __syncthreads();
    if (threadIdx.x == 0) {
        unsigned* bar = b.bar;
        __builtin_amdgcn_s_waitcnt(0);
        const unsigned nloc = b.st[0];
        const unsigned old = xb_add(&bar[XB_XSUB(b.x)], 1u);
        const unsigned gen = old / nloc;
        if (old + 1u == (gen + 1u) * nloc) xb_add(&bar[XB_XGEN(b.x)], 1u);
        else XB_SPIN(xb_ld(&bar[XB_XGEN(b.x)]) == gen, bar);
        __builtin_amdgcn_fence(__ATOMIC_ACQUIRE, "agent");
        asm volatile("s_waitcnt vmcnt(0)" ::: "memory");
    }
    __syncthreads();
}

__device__ __forceinline__ unsigned pk2(float lo, float hi) { return (unsigned)f2bf(lo) | ((unsigned)f2bf(hi) << 16); }
__device__ __forceinline__ int map_head(int c) { const int cc = c & 255; return (c & ~255) + 128 * ((cc >> 6) & 1) + 32 * (2 * (cc >> 7) + ((cc >> 5) & 1)) + 16 * ((cc >> 2) & 1) + 4 * ((cc >> 3) & 3) + (cc & 3); }
__device__ __forceinline__ int map_p32(int c) { return (c & ~31) + 16 * ((c >> 2) & 1) + 4 * ((c >> 3) & 3) + (c & 3); }
__device__ __forceinline__ int map_up(int c) { const int half = c >= DFF ? 1 : 0, cc = c - half * DFF, j = cc & 127; return 256 * (cc >> 7) + 128 * half + (j & ~31) + 16 * ((j >> 2) & 1) + 4 * ((j >> 3) & 3) + (j & 3); }
__device__ __forceinline__ void p0_item_load(f32x4 (&v)[16], const float* __restrict__ W, int N, int item, int lane) {
    const int nblk = N >> 6, kb = item / nblk, nb = item - kb * nblk;
    const float* base = W + (size_t)(64 * kb + (lane >> 4)) * N + 64 * nb + 4 * (lane & 15);
#pragma unroll
    for (int i = 0; i < 16; ++i) v[i] = *(const f32x4*)(base + (size_t)(4 * i) * N);
}
__device__ __forceinline__ void p0_lds_write(const f32x4 (&v)[16], int k0, const float* __restrict__ ksc, LAS float* T, int lane) {
    const int kr = lane >> 4, q4 = 4 * (lane & 15);
#pragma unroll
    for (int i = 0; i < 16; ++i) { const int k = 4 * i + kr; const float sc = ksc ? ksc[k0 + k] : 1.f;
#pragma unroll
        for (int e = 0; e < 4; ++e) T[k * 64 + ((q4 + e) ^ (k & 31))] = v[i][e] * sc; }
}
template <int MAP>
__device__ __forceinline__ void p0_lds_read_store(bf16_t* __restrict__ WT, int K, int N, LAS float* T, int item, int lane) {
    const int nblk = N >> 6, kb = item / nblk, nb = item - kb * nblk, k0 = 64 * kb, n0 = 64 * nb;
    const int c = lane >> 3, nl = lane & 7;
#pragma unroll
    for (int j = 0; j < 8; ++j) { const int n = nl + 8 * j; float f[8];
#pragma unroll
        for (int i = 0; i < 8; ++i) { const int k = 8 * c + i; f[i] = T[k * 64 + (n ^ (k & 31))]; }
        u32x4 o; o.x = pk2(f[0], f[1]); o.y = pk2(f[2], f[3]); o.z = pk2(f[4], f[5]); o.w = pk2(f[6], f[7]);
        const int src = n0 + n; const int dst = MAP == 0 ? map_head(src) : MAP == 1 ? map_p32(src) : MAP == 2 ? map_up(src) : src;
        *(u32x4*)(WT + (size_t)dst * K + k0 + 8 * c) = o; }
}

struct Args { const float* in[17]; float* out; unsigned char* ws; int ph_lo, ph_hi, li, pad; };

__device__ __forceinline__ void attn_a_item(const bf16_t* __restrict__ QKV, const float* __restrict__ sink, bf16_t* __restrict__ OA, int item, LAS float* scr, int lane) {
    LAS float* qs = scr; LAS float* ps = scr + 128;
    const int t = item >> 3, h = item & 7, b = t / SEQ, s = t % SEQ, kvh = h >> 2;
    const bf16_t* q = QKV + (size_t)t * NQKV + C_QA + h * 128;
    qs[lane] = bf2f(q[lane]); qs[lane + 64] = bf2f(q[lane + 64]);
    const int k0 = s - 128 < 0 ? 0 : s - 128, k1 = s + 128 > SEQ - 1 ? SEQ - 1 : s + 128, nk = k1 - k0 + 1;
    float sc[5]; float mx = -1e30f;
#pragma unroll
    for (int i = 0; i < 5; ++i) {
        const int kk = lane + 64 * i; sc[i] = -1e30f;
        if (kk < nk) {
            const bf16_t* kp = QKV + (size_t)(b * SEQ + k0 + kk) * NQKV + C_KA + kvh * 128;
            float d = 0.f;
            for (int c = 0; c < 16; ++c) { const u32x4 kv = *(const u32x4*)(kp + 8 * c);
#pragma unroll
                for (int e = 0; e < 4; ++e) { d += qs[8 * c + 2 * e] * __uint_as_float(kv[e] << 16) + qs[8 * c + 2 * e + 1] * __uint_as_float(kv[e] & 0xffff0000u); } }
            sc[i] = d * 0.08838834764831845f;
        }
        mx = fmaxf(mx, sc[i]);
    }
    const float sk = sink[h];
    mx = fmaxf(wave_max(mx), sk);
    float sum = 0.f;
#pragma unroll
    for (int i = 0; i < 5; ++i) { const int kk = lane + 64 * i; if (kk < nk) { const float p = __expf(sc[i] - mx); ps[kk] = p; sum += p; } }
    sum = wave_sum(sum) + __expf(sk - mx);
    const float inv = 1.f / sum;
    float o0 = 0.f, o1 = 0.f;
    const bf16_t* vp = QKV + (size_t)(b * SEQ + k0) * NQKV + C_VA + kvh * 128;
    for (int kk = 0; kk < nk; ++kk) { const float p = ps[kk]; o0 += p * bf2f(vp[(size_t)kk * NQKV + lane]); o1 += p * bf2f(vp[(size_t)kk * NQKV + lane + 64]); }
    bf16_t* o = OA + (size_t)t * 1024 + h * 128;
    o[lane] = f2bf(o0 * inv); o[lane + 64] = f2bf(o1 * inv);
}
__device__ __forceinline__ void attn_b_item(const bf16_t* __restrict__ QKV, const float* __restrict__ rpb, bf16_t* __restrict__ OB, int item, LAS float* scr, int lane) {
    LAS float* qs = scr; LAS float* ps = scr + 128;
    const int t = item >> 3, h = item & 7, b = t / SEQ, s = t % SEQ, qr = s / GW, qc = s % GW;
    const bf16_t* q = QKV + (size_t)t * NQKV + C_QB + h * 128;
    qs[lane] = bf2f(q[lane]); qs[lane + 64] = bf2f(q[lane + 64]);
    int rs = qr - 4; rs = rs < 0 ? 0 : (rs > GROWS - 8 ? GROWS - 8 : rs);
    int cs = qc - 8; cs = cs < 0 ? 0 : (cs > GW - 16 ? GW - 16 : cs);
    float sc[2]; float mx = -1e30f;
#pragma unroll
    for (int i = 0; i < 2; ++i) {
        const int kk = lane + 64 * i, kr = rs + (kk >> 4), kc = cs + (kk & 15);
        const bf16_t* kp = QKV + (size_t)(b * SEQ + kr * GW + kc) * NQKV + C_KB + h * 128;
        float d = 0.f;
        for (int c = 0; c < 16; ++c) { const u32x4 kv = *(const u32x4*)(kp + 8 * c);
#pragma unroll
            for (int e = 0; e < 4; ++e) { d += qs[8 * c + 2 * e] * __uint_as_float(kv[e] << 16) + qs[8 * c + 2 * e + 1] * __uint_as_float(kv[e] & 0xffff0000u); } }
        sc[i] = d * 0.08838834764831845f + rpb[(h * 15 + (kr - qr + 7)) * 31 + (kc - qc + 15)];
        mx = fmaxf(mx, sc[i]);
    }
    mx = wave_max(mx);
    float sum = 0.f;
#pragma unroll
    for (int i = 0; i < 2; ++i) { const float p = __expf(sc[i] - mx); ps[lane + 64 * i] = p; sum += p; }
    sum = wave_sum(sum);
    const float inv = 1.f / sum;
    float o0 = 0.f, o1 = 0.f;
    for (int kk = 0; kk < 128; ++kk) {
        const int kr = rs + (kk >> 4), kc = cs + (kk & 15);
        const bf16_t* vp = QKV + (size_t)(b * SEQ + kr * GW + kc) * NQKV + C_VB + h * 128;
        const float p = ps[kk]; o0 += p * bf2f(vp[lane]); o1 += p * bf2f(vp[lane + 64]);
    }
    bf16_t* o = OB + (size_t)t * 1024 + h * 128;
    o[lane] = f2bf(o0 * inv); o[lane + 64] = f2bf(o1 * inv);
}


namespace att {
typedef short bf16x8 __attribute__((ext_vector_type(8)));
typedef short s16x4 __attribute__((ext_vector_type(4)));
typedef float f32x16 __attribute__((ext_vector_type(16)));
constexpr int KT = 64 * 256, VT = 64 * 256;
constexpr int OFF_K = 0, OFF_V = 3 * KT, OFF_RPB = 3 * KT + 4 * VT, ATT_LDS = OFF_RPB + 2048;
constexpr float SC_L2 = 0.08838834764831845f * 1.4426950408889634f;
constexpr float L2E = 1.4426950408889634f;
constexpr float NEGBIG = -1e30f;

__device__ __forceinline__ s16x4 vtr(const LAS char* p) { return __builtin_bit_cast(s16x4, __builtin_amdgcn_ds_read_tr16_b64_v4i16((LAS s16x4*)p)); }

template <int KIND = 0>
__device__ __forceinline__ void stage_dma(const bf16_t* __restrict__ QKV, int tok0, int kcol, int vcol, LAS char* Kt, LAS char* Vt, int wave) {
    int l; asm volatile("v_mbcnt_lo_u32_b32 %0, -1, 0\n\tv_mbcnt_hi_u32_b32 %0, -1, %0" : "=v"(l));
#pragma unroll
    for (int i = 0; i < 2; ++i) { const int blk = 2 * wave + i, r = blk * 4 + (l >> 4), p = l & 15;
        const int key = KIND ? r : ((r & ~12) | ((r & 4) << 1) | ((r & 8) >> 1));
        const bf16_t* ks = QKV + (size_t)(tok0 + key) * NQKV + kcol + ((p ^ (r & 15)) << 3);
        const bf16_t* vs = QKV + (size_t)(tok0 + r) * NQKV + vcol + ((p ^ (KIND ? ((r & 7) << 1) : ((r & 3) << 2))) << 3);
        __builtin_amdgcn_global_load_lds((const unsigned*)ks, (LAS unsigned*)(Kt + blk * 1024), 16, 0, 0);
        __builtin_amdgcn_global_load_lds((const unsigned*)vs, (LAS unsigned*)(Vt + blk * 1024), 16, 0, 0); }
}
#define ATT_WAIT_V(n) asm volatile("s_waitcnt vmcnt(" #n ")" ::: "memory")

#ifndef ATT_PV_DEPTH
#define ATT_PV_DEPTH 4
#endif
#ifndef ATT_QK_DEPTH
#define ATT_QK_DEPTH 2
#endif
#define ATT_DSR_TR(dst, addr, off) asm volatile("ds_read_b64_tr_b16 %0, %1 offset:%2" : "=v"(dst) : "v"(addr), "n"(off) : "memory")
#define ATT_DSR_128(dst, addr, off) asm volatile("ds_read_b128 %0, %1 offset:%2" : "=v"(dst) : "v"(addr), "n"(off) : "memory")
#define ATT_WAIT_L2(a, b, n) asm volatile("s_waitcnt lgkmcnt(%2)" : "+v"(a), "+v"(b) : "n"(n) : "memory")
template <int MODE, bool HASB, class Mid>
__device__ __forceinline__ void tile_qksm(const LAS char* Kt, const bf16x8 (&qf)[8], bf16x8 (&pf)[4], float& l, int lane_, unsigned M0, unsigned M1, float negC, const LAS float* brow, const Mid& mid) {
    int lane; asm volatile("v_mbcnt_lo_u32_b32 %0, -1, 0\n\tv_mbcnt_hi_u32_b32 %0, -1, %0" : "=v"(lane)); (void)lane_;
    const int r32 = lane & 31, hi = lane >> 5;
    f32x16 S0, S1;
#pragma unroll
    for (int g = 0; g < 16; ++g) { S0[g] = negC; S1[g] = negC; }
    const unsigned kb = (unsigned)(unsigned long)Kt, kz = (unsigned)r32 * 256u + (unsigned)((hi ^ (r32 & 15)) << 4);
    constexpr int KD = ATT_QK_DEPTH; bf16x8 kf[2 * KD];
#define QK_ISSUE(d) do { if constexpr ((d) < 8) { const unsigned ka = (kz ^ (unsigned)((d) << 5)) + kb; ATT_DSR_128(kf[2 * ((d) % KD)], ka, 0); ATT_DSR_128(kf[2 * ((d) % KD) + 1], ka, 8192); } } while (0)
#define QK_STEP(d) do { ATT_WAIT_L2(kf[2 * ((d) % KD)], kf[2 * ((d) % KD) + 1], 2 * (((d) + KD - 1 < 7 ? (d) + KD - 1 : 7) - (d))); \
        S0 = __builtin_amdgcn_mfma_f32_32x32x16_bf16(kf[2 * ((d) % KD)], qf[d], S0, 0, 0, 0); S1 = __builtin_amdgcn_mfma_f32_32x32x16_bf16(kf[2 * ((d) % KD) + 1], qf[d], S1, 0, 0, 0); \
        QK_ISSUE((d) + KD); __builtin_amdgcn_sched_barrier(0); } while (0)
    QK_ISSUE(0); QK_ISSUE(1); if constexpr (KD > 2) { QK_ISSUE(2); }
    QK_STEP(0); QK_STEP(1); QK_STEP(2); QK_STEP(3); QK_STEP(4); QK_STEP(5); QK_STEP(6); QK_STEP(7);
#undef QK_ISSUE
#undef QK_STEP
    mid();
    float ps = 0.f;
#define ATT_SM(S, blk, Mb) _Pragma("unroll") for (int g = 0; g < 16; ++g) { \
            const bool skip = (MODE == 2 && (blk) == 1 && g >= 8) || (MODE == 3 && (blk) == 0 && g < 8); \
            if (skip) { S[g] = 0.f; } else { \
            const int kk = (g & 7) + 8 * hi + 16 * (g >> 3) + 32 * (blk); \
            float t = S[g]; \
            if (HASB) t += brow[kk]; \
            if (MODE != 0) { const unsigned m = (unsigned)(((int)((Mb) << (31 - g))) >> 31); t = __uint_as_float((__float_as_uint(t) & m) | (0xF149F2CAu & ~m)); } \
            S[g] = __builtin_amdgcn_exp2f(t); ps += S[g]; } }
    if (MODE == 1) {
        const int q8 = (int)M0;
        if (M1 == 0u) {
#pragma unroll
            for (int g = 0; g < 16; ++g) { S0[g] = __builtin_amdgcn_exp2f(S0[g]); S1[g] = __builtin_amdgcn_exp2f(S1[g]); ps += S0[g] + S1[g]; }
        } else if (M1 == 1u) {
#pragma unroll
            for (int g = 0; g < 16; ++g) { const int kc = (g & 7) + 16 * (g >> 3);
                S0[g] = __builtin_amdgcn_exp2f(kc >= q8 ? S0[g] : NEGBIG); S1[g] = __builtin_amdgcn_exp2f(kc + 32 >= q8 ? S1[g] : NEGBIG); ps += S0[g] + S1[g]; }
        } else {
#pragma unroll
            for (int g = 0; g < 16; ++g) { const int kc = (g & 7) + 16 * (g >> 3);
                S0[g] = __builtin_amdgcn_exp2f(kc <= q8 ? S0[g] : NEGBIG); S1[g] = __builtin_amdgcn_exp2f(kc + 32 <= q8 ? S1[g] : NEGBIG); ps += S0[g] + S1[g]; }
        }
    } else {
    ATT_SM(S0, 0, M0)
    ATT_SM(S1, 1, M1)
    }
#undef ATT_SM
    l += ps;
#pragma unroll
    for (int s2 = 0; s2 < 2; ++s2) {
        u32x4 w0, w1;
#pragma unroll
        for (int j = 0; j < 4; ++j) { w0[j] = pg8::cvt_pk_bf16(S0[8 * s2 + 2 * j], S0[8 * s2 + 2 * j + 1]); w1[j] = pg8::cvt_pk_bf16(S1[8 * s2 + 2 * j], S1[8 * s2 + 2 * j + 1]); }
        pf[s2] = __builtin_bit_cast(bf16x8, w0); pf[2 + s2] = __builtin_bit_cast(bf16x8, w1);
    }
}
template <int MODE>
__device__ __forceinline__ void tile_pv(const LAS char* Vt, const bf16x8 (&pf)[4], f32x16 (&o)[4], int lane_) {
    int lane; asm volatile("v_mbcnt_lo_u32_b32 %0, -1, 0\n\tv_mbcnt_hi_u32_b32 %0, -1, %0" : "=v"(lane)); (void)lane_;
    const int hi = lane >> 5, l16 = lane & 15, gi = lane >> 4;
    const unsigned vz = (unsigned)(8 * hi + (l16 >> 2)) * 256u + (unsigned)((l16 >> 2) << 6) + (unsigned)(32 * (gi & 1) + 8 * (l16 & 3));
    constexpr int NK = (MODE >= 2) ? 12 : 16;
    unsigned vb[4];
#pragma unroll
    for (int db = 0; db < 4; ++db) vb[db] = (unsigned)(unsigned long)Vt + (vz ^ (unsigned)(db << 6));
    constexpr int PD = ATT_PV_DEPTH; s16x4 fa[PD], fb[PD];
#define PV_DB(i) (MODE >= 2 ? (i) / 3 : (i) / 4)
#define PV_KS(i) (MODE == 2 ? (i) % 3 : MODE == 3 ? 1 + (i) % 3 : (i) % 4)
#define PV_ISSUE(i) do { if constexpr ((i) < NK) { ATT_DSR_TR(fa[(i) % PD], vb[PV_DB(i)], PV_KS(i) * 4096); ATT_DSR_TR(fb[(i) % PD], vb[PV_DB(i)], PV_KS(i) * 4096 + 1024); } } while (0)
#define PV_STEP(i) do { if constexpr ((i) < NK) { ATT_WAIT_L2(fa[(i) % PD], fb[(i) % PD], 2 * (((i) + PD - 1 < NK - 1 ? (i) + PD - 1 : NK - 1) - (i))); \
        const bf16x8 vf = {fa[(i) % PD][0], fa[(i) % PD][1], fa[(i) % PD][2], fa[(i) % PD][3], fb[(i) % PD][0], fb[(i) % PD][1], fb[(i) % PD][2], fb[(i) % PD][3]}; \
        o[PV_DB(i)] = __builtin_amdgcn_mfma_f32_32x32x16_bf16(vf, pf[PV_KS(i)], o[PV_DB(i)], 0, 0, 0); PV_ISSUE((i) + PD); __builtin_amdgcn_sched_barrier(0); } } while (0)
    PV_ISSUE(0); PV_ISSUE(1); PV_ISSUE(2); PV_ISSUE(3); if constexpr (PD > 4) { PV_ISSUE(4); } if constexpr (PD > 5) { PV_ISSUE(5); }
    PV_STEP(0); PV_STEP(1); PV_STEP(2); PV_STEP(3); PV_STEP(4); PV_STEP(5); PV_STEP(6); PV_STEP(7);
    PV_STEP(8); PV_STEP(9); PV_STEP(10); PV_STEP(11); PV_STEP(12); PV_STEP(13); PV_STEP(14); PV_STEP(15);
#undef PV_DB
#undef PV_KS
#undef PV_ISSUE
#undef PV_STEP
}

__device__ __forceinline__ void store_o(const f32x16 (&o)[4], float l, bf16_t* __restrict__ orow, int lane) {
    const int hi = lane >> 5;
    const float lt = l + __shfl_xor(l, 32), inv = 1.f / lt;
    bf16_t* dst = orow + 8 * hi;
#pragma unroll
    for (int db = 0; db < 4; ++db)
#pragma unroll
        for (int gp = 0; gp < 2; ++gp) {
            u32x2 a, b;
            a.x = pg8::cvt_pk_bf16(o[db][8 * gp] * inv, o[db][8 * gp + 1] * inv); a.y = pg8::cvt_pk_bf16(o[db][8 * gp + 2] * inv, o[db][8 * gp + 3] * inv);
            b.x = pg8::cvt_pk_bf16(o[db][8 * gp + 4] * inv, o[db][8 * gp + 5] * inv); b.y = pg8::cvt_pk_bf16(o[db][8 * gp + 6] * inv, o[db][8 * gp + 7] * inv);
            { auto r = __builtin_amdgcn_permlane32_swap(a.x, b.x, false, false); a.x = r[0]; b.x = r[1]; }
            { auto r = __builtin_amdgcn_permlane32_swap(a.y, b.y, false, false); a.y = r[0]; b.y = r[1]; }
            u32x4 w; w.x = a.x; w.y = a.y; w.z = b.x; w.w = b.y;
            *(u32x4*)(dst + 32 * db + 16 * gp) = w;
        }
}
__device__ __forceinline__ float qk_bound_l2(const float* __restrict__ gq, const float* __restrict__ gk, int lane) {
    const float a = wave_max(fmaxf(fabsf(gq[lane]), fabsf(gq[lane + 64]))), b = wave_max(fmaxf(fabsf(gk[lane]), fabsf(gk[lane + 64])));
    return 1.01f * 11.313708498984761f * L2E * a * b;
}

__device__ __forceinline__ void unit_a(LAS char* L, const bf16_t* __restrict__ QKV, const float* __restrict__ sink, float cqk, bf16_t* __restrict__ OA, int ua, int tid, int wave, int lane) {
    const int b = ua >> 7, kvh = (ua >> 6) & 1, n2 = ua & 63, q0 = n2 * 64;
    const int head = kvh * 4 + (wave >> 1), qi = 32 * (wave & 1) + (lane & 31), hi = lane >> 5;
    const int tokq = b * SEQ + q0 + qi;
    bf16x8 qf[8];
    { const bf16_t* qp = QKV + (size_t)tokq * NQKV + C_QA + head * 128 + 8 * hi;
#pragma unroll
      for (int ds = 0; ds < 8; ++ds) qf[ds] = *(const bf16x8*)(qp + 16 * ds); }
    f32x16 o[4];
#pragma unroll
    for (int d = 0; d < 4; ++d)
#pragma unroll
        for (int g = 0; g < 16; ++g) o[d][g] = 0.f;
    const float sk = sink[head] * L2E, C = fmaxf(cqk, sk);
    float l = hi == 0 ? __builtin_amdgcn_exp2f(sk - C) : 0.f;
    const unsigned q8 = (unsigned)(qi - 8 * hi);
    const int t_lo = q0 >= 128 ? 0 : (q0 >= 64 ? 1 : 2), t_hi = q0 + 191 < SEQ ? 5 : (q0 + 127 < SEQ ? 4 : 3);
    const int kcol = C_KA + kvh * 128, vcol = C_VA + kvh * 128, tokb = b * SEQ + q0 - 128;
    const bool late = wave >= 4;
    bf16x8 pf[4];
    const int nt = t_hi - t_lo;
    stage_dma(QKV, tokb + 64 * t_lo, kcol, vcol, L + OFF_K, L + OFF_V, wave);
    stage_dma(QKV, tokb + 64 * (t_lo + 1), kcol, vcol, L + OFF_K + KT, L + OFF_V + VT, wave);
    ATT_WAIT_V(4); PG8_XBAR();
    int kcur = 0, kn1 = KT, kn2 = 2 * KT, vprev = 3 * VT, vcur = 0, vn1 = VT, vn2 = 2 * VT;
    for (int i = 0; i < nt; ++i) {
        const int t = t_lo + i;
        if (late && i > 0) tile_pv<1>(L + OFF_V + vprev, pf, o, lane);
        tile_qksm<1, false>(L + OFF_K + kcur, qf, pf, l, lane, q8, t == 0 ? 1u : (t == 4 ? 2u : 0u), -C, nullptr,
                            [&]() { if (i + 2 < nt) stage_dma(QKV, tokb + 64 * (t + 2), kcol, vcol, L + OFF_K + kn2, L + OFF_V + vn2, wave); });
        if (!late) tile_pv<1>(L + OFF_V + vcur, pf, o, lane);
        if (i + 2 < nt) ATT_WAIT_V(4); else ATT_WAIT_V(0);
        PG8_XBAR();
        { const int k0 = kcur; kcur = kn1; kn1 = kn2; kn2 = k0; const int v0 = vprev; vprev = vcur; vcur = vn1; vn1 = vn2; vn2 = v0; }
    }
    if (late) tile_pv<1>(L + OFF_V + vprev, pf, o, lane);
    PG8_XBAR();
    store_o(o, l, OA + (size_t)tokq * 1024 + head * 128, lane);
}

template <int HF>
__device__ __forceinline__ void unit_b(LAS char* L, const bf16_t* __restrict__ QKV, const float* __restrict__ rpb, float cqk, bf16_t* __restrict__ OB, int ub, int tid, int wave, int lane) {
    const int b = ub >> 7, h = (ub >> 4) & 7, rb = (ub >> 1) & 7; constexpr int hf = HF;
    const int qr = 8 * rb + wave, qc = 32 * hf + (lane & 31), hi = lane >> 5;
    const int tokq = b * SEQ + qr * GW + qc;
    LAS float* rp = (LAS float*)(L + OFF_RPB);
    float bmax = 0.f;
    { const float v0 = tid < 15 * 31 ? rpb[h * 15 * 31 + tid] * L2E : 0.f; if (tid < 15 * 31) rp[tid] = v0;
      bmax = wave_max(fabsf(wave < 8 ? rpb[h * 15 * 31 + (lane < 58 ? lane * 8 : 0)] : 0.f)); }
    { float mx = 0.f;
#pragma unroll
      for (int i = 0; i < 8; ++i) { const int j = lane * 8 + i; mx = fmaxf(mx, j < 15 * 31 ? fabsf(rpb[h * 15 * 31 + j]) : 0.f); }
      bmax = wave_max(mx) * L2E; }
    const float C = cqk + bmax;
    bf16x8 qf[8];
    { const bf16_t* qp = QKV + (size_t)tokq * NQKV + C_QB + h * 128 + 8 * hi;
#pragma unroll
      for (int ds = 0; ds < 8; ++ds) qf[ds] = *(const bf16x8*)(qp + 16 * ds); }
    f32x16 o[4];
#pragma unroll
    for (int d = 0; d < 4; ++d)
#pragma unroll
        for (int g = 0; g < 16; ++g) o[d][g] = 0.f;
    float l = 0.f;
    int rs = qr - 4; rs = rs < 0 ? 0 : (rs > GROWS - 8 ? GROWS - 8 : rs);
    int cs = qc - 8; cs = cs < 0 ? 0 : (cs > GW - 16 ? GW - 16 : cs);
    unsigned M0 = 0u, M1 = 0u;
#pragma unroll
    for (int g = 0; g < 16; ++g) { const int kk = (g & 7) + 8 * hi + 16 * (g >> 3);
        M0 |= ((kk >= cs && kk < cs + 16) ? 1u : 0u) << g; M1 |= ((kk + 32 >= cs && kk + 32 < cs + 16) ? 1u : 0u) << g; }
    int kr_lo = 8 * rb - 4; kr_lo = kr_lo < 0 ? 0 : (kr_lo > GROWS - 8 ? GROWS - 8 : kr_lo);
    int kr_hi = 8 * rb + 3; kr_hi = (kr_hi < 0 ? 0 : (kr_hi > GROWS - 8 ? GROWS - 8 : kr_hi)) + 8;
    const int kcol = C_KB + h * 128, vcol = C_VB + h * 128, tokb = b * SEQ;
    const bool late = wave >= 4;
    bf16x8 pf[4]; bool have = false;
    stage_dma(QKV, tokb + GW * kr_lo, kcol, vcol, L + OFF_K, L + OFF_V, wave);
    stage_dma(QKV, tokb + GW * (kr_lo + 1), kcol, vcol, L + OFF_K + KT, L + OFF_V + VT, wave);
    ATT_WAIT_V(4); PG8_XBAR();
    int kcur = 0, kn1 = KT, kn2 = 2 * KT, vprev = 3 * VT, vcur = 0, vn1 = VT, vn2 = 2 * VT;
    for (int kr = kr_lo; kr < kr_hi; ++kr) {
        if (late && have) tile_pv<2 + HF>(L + OFF_V + vprev, pf, o, lane);
        have = (kr >= rs && kr < rs + 8);
        if (have) {
            const LAS float* brow = rp + (kr - qr + 7) * 31 + 15 - qc;
            tile_qksm<2 + HF, true>(L + OFF_K + kcur, qf, pf, l, lane, M0, M1, -C, brow,
                                    [&]() { if (kr + 2 < kr_hi) stage_dma(QKV, tokb + GW * (kr + 2), kcol, vcol, L + OFF_K + kn2, L + OFF_V + vn2, wave); });
            if (!late) tile_pv<2 + HF>(L + OFF_V + vcur, pf, o, lane);
        } else if (kr + 2 < kr_hi) stage_dma(QKV, tokb + GW * (kr + 2), kcol, vcol, L + OFF_K + kn2, L + OFF_V + vn2, wave);
        if (kr + 2 < kr_hi) ATT_WAIT_V(4); else ATT_WAIT_V(0);
        PG8_XBAR();
        { const int k0 = kcur; kcur = kn1; kn1 = kn2; kn2 = k0; const int v0 = vprev; vprev = vcur; vcur = vn1; vn1 = vn2; vn2 = v0; }
    }
    if (late && have) tile_pv<2 + HF>(L + OFF_V + vprev, pf, o, lane);
    PG8_XBAR();
    store_o(o, l, OB + (size_t)tokq * 1024 + h * 128, lane);
}

template <int HF>
__device__ __forceinline__ void unit_b16(LAS char* L, const bf16_t* __restrict__ QKV, const float* __restrict__ rpb, float cqk, bf16_t* __restrict__ OB, int ub, int tid, int wave, int lane) {
    const int b = ub >> 7, h = (ub >> 4) & 7, rb = (ub >> 1) & 7;
    const int fr = lane & 15, fq = lane >> 4;
    const int qr = 8 * rb + wave;
    constexpr int KB0 = HF ? 24 : 0, KB1 = HF ? 32 : 8;
    LAS float* rp = (LAS float*)(L + OFF_RPB);
    float bmax;
    { const float v0 = tid < 15 * 31 ? rpb[h * 15 * 31 + tid] * L2E : 0.f; if (tid < 15 * 31) rp[tid] = v0; }
    { float mx = 0.f;
#pragma unroll
      for (int i = 0; i < 8; ++i) { const int j = lane * 8 + i; mx = fmaxf(mx, j < 15 * 31 ? fabsf(rpb[h * 15 * 31 + j]) : 0.f); }
      bmax = wave_max(mx) * L2E; }
    const float C = cqk + bmax;
    bf16x8 qf[2][4];
    unsigned vm = 0u;
#pragma unroll
    for (int g = 0; g < 2; ++g) { const int qc = 32 * HF + 16 * g + fr, kb = g ? KB1 : KB0;
        const bf16_t* qp = QKV + (size_t)(b * SEQ + qr * GW + qc) * NQKV + C_QB + h * 128 + 8 * fq;
#pragma unroll
        for (int dc = 0; dc < 4; ++dc) qf[g][dc] = *(const bf16x8*)(qp + 32 * dc);
        int cs = qc - 8; cs = cs < 0 ? 0 : (cs > GW - 16 ? GW - 16 : cs);
#pragma unroll
        for (int sb = 0; sb < 2; ++sb)
#pragma unroll
            for (int e = 0; e < 4; ++e) { const int kk = kb + 16 * sb + 4 * fq + e; vm |= ((kk >= cs && kk < cs + 16) ? 1u : 0u) << (8 * g + 4 * sb + e); } }
    f32x4 o[2][8];
#pragma unroll
    for (int g = 0; g < 2; ++g)
#pragma unroll
        for (int d = 0; d < 8; ++d) o[g][d] = (f32x4){0.f, 0.f, 0.f, 0.f};
    float l0 = 0.f, l1 = 0.f;
    int rs = qr - 4; rs = rs < 0 ? 0 : (rs > GROWS - 8 ? GROWS - 8 : rs);
    int kr_lo = 8 * rb - 4; kr_lo = kr_lo < 0 ? 0 : (kr_lo > GROWS - 8 ? GROWS - 8 : kr_lo);
    int kr_hi = 8 * rb + 3; kr_hi = (kr_hi < 0 ? 0 : (kr_hi > GROWS - 8 ? GROWS - 8 : kr_hi)) + 8;
    const int kcol = C_KB + h * 128, vcol = C_VB + h * 128, tokb = b * SEQ;
    stage_dma<1>(QKV, tokb + GW * kr_lo, kcol, vcol, L + OFF_K, L + OFF_V, wave);
    stage_dma<1>(QKV, tokb + GW * (kr_lo + 1), kcol, vcol, L + OFF_K + KT, L + OFF_V + VT, wave);
    ATT_WAIT_V(4); PG8_XBAR();
    int kcur = 0, kn1 = KT, kn2 = 2 * KT, vcur = 0, vn1 = VT, vn2 = 2 * VT;
    for (int kr = kr_lo; kr < kr_hi; ++kr) {
        const bool have = (kr >= rs && kr < rs + 8);
        if (have) {
            int ln; asm volatile("v_mbcnt_lo_u32_b32 %0, -1, 0\n\tv_mbcnt_hi_u32_b32 %0, -1, %0" : "=v"(ln));
            const int r_ = ln & 15, q_ = ln >> 4;
            f32x4 S[2][2];
#pragma unroll
            for (int g = 0; g < 2; ++g)
#pragma unroll
                for (int sb = 0; sb < 2; ++sb) S[g][sb] = (f32x4){-C, -C, -C, -C};
            const unsigned kbase = (unsigned)(unsigned long)(L + OFF_K + kcur);
            const unsigned kz0 = (unsigned)(KB0 + r_) * 256u + (unsigned)((q_ ^ ((KB0 + r_) & 15)) << 4), kz1 = (unsigned)(KB1 + r_) * 256u + (unsigned)((q_ ^ ((KB1 + r_) & 15)) << 4);
            bf16x8 kf[16];
#define B16_QK_ISSUE(s_) do { const unsigned ka = ((((s_) >> 2) ? kz1 : kz0) ^ (unsigned)(((s_) & 3) << 6)) + kbase; ATT_DSR_128(kf[2 * (s_)], ka, 0); ATT_DSR_128(kf[2 * (s_) + 1], ka, 4096); } while (0)
#define B16_QK_STEP(s_) do { ATT_WAIT_L2(kf[2 * (s_)], kf[2 * (s_) + 1], 2 * (7 - (s_))); \
                S[(s_) >> 2][0] = __builtin_amdgcn_mfma_f32_16x16x32_bf16(kf[2 * (s_)], qf[(s_) >> 2][(s_) & 3], S[(s_) >> 2][0], 0, 0, 0); \
                S[(s_) >> 2][1] = __builtin_amdgcn_mfma_f32_16x16x32_bf16(kf[2 * (s_) + 1], qf[(s_) >> 2][(s_) & 3], S[(s_) >> 2][1], 0, 0, 0); \
                __builtin_amdgcn_sched_barrier(0); } while (0)
            B16_QK_ISSUE(0); B16_QK_ISSUE(1); B16_QK_ISSUE(2); B16_QK_ISSUE(3); B16_QK_ISSUE(4); B16_QK_ISSUE(5); B16_QK_ISSUE(6); B16_QK_ISSUE(7);
            B16_QK_STEP(0); B16_QK_STEP(1); B16_QK_STEP(2); B16_QK_STEP(3); B16_QK_STEP(4); B16_QK_STEP(5); B16_QK_STEP(6); B16_QK_STEP(7);
#undef B16_QK_ISSUE
#undef B16_QK_STEP
            if (kr + 2 < kr_hi) stage_dma<1>(QKV, tokb + GW * (kr + 2), kcol, vcol, L + OFF_K + kn2, L + OFF_V + vn2, wave);
            const unsigned vbase = (unsigned)(unsigned long)(L + OFF_V + vcur);
            const unsigned vr0 = (unsigned)(KB0 + 4 * q_ + (r_ >> 2)), vr1 = (unsigned)(KB1 + 4 * q_ + (r_ >> 2));
            const unsigned vz0 = vr0 * 256u + ((vr0 & 7u) << 5) + (unsigned)((r_ & 3) * 8), vz1 = vr1 * 256u + ((vr1 & 7u) << 5) + (unsigned)((r_ & 3) * 8);
            s16x4 fa[8], fb[8];
#define B16_PV_ISSUE(i_) do { if constexpr ((i_) < 16) { const unsigned va = ((((i_) >> 3) ? vz1 : vz0) ^ (unsigned)(((i_) & 7) << 5)) + vbase; ATT_DSR_TR(fa[(i_) & 7], va, 0); ATT_DSR_TR(fb[(i_) & 7], va, 4096); } } while (0)
            B16_PV_ISSUE(0); B16_PV_ISSUE(1); B16_PV_ISSUE(2); B16_PV_ISSUE(3); B16_PV_ISSUE(4); B16_PV_ISSUE(5); B16_PV_ISSUE(6); B16_PV_ISSUE(7);
            bf16x8 pf[2];
#pragma unroll
            for (int g = 0; g < 2; ++g) { const int qc = 32 * HF + 16 * g + r_;
                const LAS float* brow = rp + (kr - qr + 7) * 31 + 15 - qc + (g ? KB1 : KB0) + 4 * q_;
                float ps = 0.f; float pv[8];
#pragma unroll
                for (int sb = 0; sb < 2; ++sb)
#pragma unroll
                    for (int e = 0; e < 4; ++e) { float t = S[g][sb][e] + brow[16 * sb + e];
                        t = ((vm >> (8 * g + 4 * sb + e)) & 1u) ? t : NEGBIG;
                        const float pe = __builtin_amdgcn_exp2f(t); pv[4 * sb + e] = pe; ps += pe; }
                if (g) l1 += ps; else l0 += ps;
                u32x4 w; w.x = pg8::cvt_pk_bf16(pv[0], pv[1]); w.y = pg8::cvt_pk_bf16(pv[2], pv[3]); w.z = pg8::cvt_pk_bf16(pv[4], pv[5]); w.w = pg8::cvt_pk_bf16(pv[6], pv[7]);
                pf[g] = __builtin_bit_cast(bf16x8, w); }
#define B16_PV_STEP(i_) do { ATT_WAIT_L2(fa[(i_) & 7], fb[(i_) & 7], 2 * (((i_) + 7 < 15 ? (i_) + 7 : 15) - (i_))); \
                const bf16x8 vf = {fa[(i_) & 7][0], fa[(i_) & 7][1], fa[(i_) & 7][2], fa[(i_) & 7][3], fb[(i_) & 7][0], fb[(i_) & 7][1], fb[(i_) & 7][2], fb[(i_) & 7][3]}; \
                o[(i_) >> 3][(i_) & 7] = __builtin_amdgcn_mfma_f32_16x16x32_bf16(vf, pf[(i_) >> 3], o[(i_) >> 3][(i_) & 7], 0, 0, 0); B16_PV_ISSUE((i_) + 8); __builtin_amdgcn_sched_barrier(0); } while (0)
            B16_PV_STEP(0); B16_PV_STEP(1); B16_PV_STEP(2); B16_PV_STEP(3); B16_PV_STEP(4); B16_PV_STEP(5); B16_PV_STEP(6); B16_PV_STEP(7);
            B16_PV_STEP(8); B16_PV_STEP(9); B16_PV_STEP(10); B16_PV_STEP(11); B16_PV_STEP(12); B16_PV_STEP(13); B16_PV_STEP(14); B16_PV_STEP(15);
#undef B16_PV_ISSUE
#undef B16_PV_STEP
        } else if (kr + 2 < kr_hi) stage_dma<1>(QKV, tokb + GW * (kr + 2), kcol, vcol, L + OFF_K + kn2, L + OFF_V + vn2, wave);
        if (kr + 2 < kr_hi) ATT_WAIT_V(4); else ATT_WAIT_V(0);
        PG8_XBAR();
        { const int k0 = kcur; kcur = kn1; kn1 = kn2; kn2 = k0; const int v0 = vcur; vcur = vn1; vn1 = vn2; vn2 = v0; }
    }
#pragma unroll
    for (int g = 0; g < 2; ++g) { float lt = g ? l1 : l0; lt += __shfl_xor(lt, 16); lt += __shfl_xor(lt, 32); const float inv = 1.f / lt;
        bf16_t* orow = OB + (size_t)(b * SEQ + qr * GW + 32 * HF + 16 * g + fr) * 1024 + h * 128 + 4 * fq;
#pragma unroll
        for (int db = 0; db < 8; ++db) { u32x2 w; w.x = pg8::cvt_pk_bf16(o[g][db][0] * inv, o[g][db][1] * inv); w.y = pg8::cvt_pk_bf16(o[g][db][2] * inv, o[g][db][3] * inv);
            *(u32x2*)(orow + 16 * db) = w; } }
}
}

__global__ void __launch_bounds__(NWAVES * 64, 2) mk_fwd(Args args) {
    extern __shared__ __attribute__((aligned(16))) unsigned char lds[];
    LAS unsigned char* L = (LAS unsigned char*)lds;
    volatile LAS unsigned* MISC = (volatile LAS unsigned*)(L + MISC_OFF);
    const int tid = threadIdx.x, lane = tid & 63, wave = __builtin_amdgcn_readfirstlane(tid >> 6);
    const int G = gridDim.x; const int bx = blockIdx.x; const int vcu = (G % 8 == 0) ? (bx % 8) * (G / 8) + bx / 8 : bx;
    unsigned char* ws = args.ws;
    gu32* ctl = (gu32*)(ws + WS_CTL);
    const float* x = args.in[0]; float* out = args.out;
    bf16_t* Wt = (bf16_t*)(ws + WS_W);
    bf16_t* Win_t = (bf16_t*)(ws + WS_W + WO_IN); bf16_t* Wa_t = (bf16_t*)(ws + WS_W + WO_A); bf16_t* Wb_t = (bf16_t*)(ws + WS_W + WO_B);
    bf16_t* Wo_t = (bf16_t*)(ws + WS_W + WO_OUT); bf16_t* Wup_t = (bf16_t*)(ws + WS_W + WO_UP); bf16_t* Wdn_t = (bf16_t*)(ws + WS_W + WO_DN);
    float* rope = (float*)(ws + WS_ROPE); float* RS1 = (float*)(ws + WS_RS1); float* CSC = (float*)(ws + WS_CSC); signed char* Win8_t = (signed char*)(ws + WS_W + WO_IN); float* NORMS = (float*)(ws + WS_NORMS); float* SSQ = (float*)(ws + WS_SSQ); float* HALO = (float*)(ws + WS_HALO);
    bf16_t* QKV = (bf16_t*)(ws + WS_QKV); bf16_t* Gt = (bf16_t*)(ws + WS_G); bf16_t* MG = (bf16_t*)(ws + WS_MG); bf16_t* ACT = (bf16_t*)(ws + WS_ACT); bf16_t* X1B = (bf16_t*)(ws + WS_X1B);
    bf16_t* XN = (bf16_t*)out; signed char* XN8 = (signed char*)out; bf16_t* OA = (bf16_t*)((unsigned char*)out + 64 * MiB); bf16_t* OB = (bf16_t*)((unsigned char*)out + 96 * MiB);
    (void)Wt; (void)XN; (void)Win_t;
    for (int u = tid; u < (LDS_BYTES - LDSCTL_OFF) / 4; u += NWAVES * 64) ((LAS unsigned*)(L + LDSCTL_OFF))[u] = 0u;
    __syncthreads();
    const int lo = args.ph_lo, hi = args.ph_hi;
    XcdBarrier bar; bar.bar = (unsigned*)(ctl + CW_BAR) + args.li * XCD_BAR_WORDS; bar.x = 0; bar.st = nullptr;
    if (hi - lo > 1) bar = xcd_barrier_post((unsigned*)(ctl + CW_BAR) + args.li * XCD_BAR_WORDS, MISC + 8);
#ifndef PHMASK
#define PHMASK 255
#endif
#define IN(k) (((PHMASK >> (k)) & 1) && lo <= (k) && (k) < hi)
#define SEAM(k) do { if (IN(k) && IN((k) + 1)) xcd_barrier(bar); } while (0)
#ifndef XCD_LOCAL
#define XCD_LOCAL 1
#endif
#ifndef XCD_ROTATE
#define XCD_ROTATE 1
#endif
#define XCD_ROT(c_) ((XCD_ROTATE && G == 256) ? ((c_) & 7) : 0)
#ifndef XCD_ROTATE1
#define XCD_ROTATE1 1
#endif
#define XCD_ROT1(c_) ((XCD_ROTATE1 && G == 256) ? ((c_) & 7) : 0)
#define SEAML(k) do { if (IN(k) && IN((k) + 1)) { if (modeL) xcd_barrier_local(bar); else xcd_barrier(bar); } } while (0)
    const int gw = vcu * NWAVES + wave, NGW = G * NWAVES;
#if defined(DBGT) && DBGT
#ifndef DBG_BLK
#define DBG_BLK 0
#endif
    unsigned* dbgbase = (unsigned*)(ws + WS_CTL + 512 * 1024);
#define DBGP(ph) (bx == DBG_BLK ? dbgbase + (ph) * 64 : (unsigned*)nullptr)
#else
#define DBGP(ph) ((unsigned*)nullptr)
#endif

    constexpr int I_IN = (DM / 64) * (NIN / 64), I_U = (DM / 64) * (NUP / 64), I_A = (1024 / 64) * (DM / 64), I_O = (DM / 64) * (DM / 64), I_D = (DFF / 64) * (DM / 64);
#ifndef CV_SPLIT
#define CV_SPLIT 0
#endif
    constexpr int CV_UPEND = I_IN + I_U, CV_G1 = CV_UPEND + (CV_SPLIT >= 1 ? 2 * I_A : 0) + (CV_SPLIT >= 2 ? I_O : 0), CV_ALL = CV_UPEND + 2 * I_A + I_O + I_D;
#define CV_SEL(it_, W_, N_, r_) do { int r0_ = (it_); \
        if (r0_ < I_IN) { W_ = args.in[2]; N_ = NIN; r_ = r0_; } else if ((r0_ -= I_IN) < I_U) { W_ = args.in[13]; N_ = NUP; r_ = r0_; } else if ((r0_ -= I_U) < I_A) { W_ = args.in[9]; N_ = DM; r_ = r0_; } \
        else if ((r0_ -= I_A) < I_A) { W_ = args.in[10]; N_ = DM; r_ = r0_; } else if ((r0_ -= I_A) < I_O) { W_ = args.in[11]; N_ = DM; r_ = r0_; } else { r0_ -= I_O; W_ = args.in[16]; N_ = DM; r_ = r0_; } } while (0)
#define CONVERT_ITEMS(first_, stride_, lo_, hi_) do { LAS float* scr = (LAS float*)(L + RING_OFF + wave * 16384); f32x4 cur[16]; \
        int it = (lo_) + (first_); const float* W; int N, r; \
        if (it < (hi_)) { CV_SEL(it, W, N, r); p0_item_load(cur, W, N, r, lane); } \
        for (; it < (hi_); it += (stride_)) { __builtin_assume(it >= (lo_)); \
            CV_SEL(it, W, N, r); const bool isup = (it >= I_IN) && (it < CV_UPEND); \
            p0_lds_write(cur, 64 * (r / (N >> 6)), isup ? args.in[12] : nullptr, scr, lane); \
            const int itn = it + (stride_); \
            if (itn < (hi_)) { const float* Wn; int Nn, rn; CV_SEL(itn, Wn, Nn, rn); p0_item_load(cur, Wn, Nn, rn, lane); } \
            LDS_WAIT(); asm volatile("" ::: "memory"); \
            int r0 = it; \
            if (r0 < I_IN) p0_lds_read_store<0>(Win_t, DM, NIN, scr, r0, lane); \
            else if ((r0 -= I_IN) < I_U) p0_lds_read_store<2>(Wup_t, DM, NUP, scr, r0, lane); \
            else if ((r0 -= I_U) < I_A) p0_lds_read_store<1>(Wa_t, 1024, DM, scr, r0, lane); \
            else if ((r0 -= I_A) < I_A) p0_lds_read_store<1>(Wb_t, 1024, DM, scr, r0, lane); \
            else if ((r0 -= I_A) < I_O) p0_lds_read_store<1>(Wo_t, DM, DM, scr, r0, lane); \
            else { r0 -= I_O; p0_lds_read_store<1>(Wdn_t, DFF, DM, scr, r0, lane); } \
            LDS_WAIT(); asm volatile("" ::: "memory"); \
        } } while (0)
    constexpr int P1_UNITS = (M / 256) * (NIN / 256);
    const int p1_rounds = (P1_UNITS + G - 1) / G, p1_last = P1_UNITS - (p1_rounds - 1) * G;
    const int p1_fillers = (p1_last < G) ? G - p1_last : 0;
#define P0_WIN_ONEPASS() do { \
        LAS unsigned* IMG = (LAS unsigned*)(L + RING_OFF); LAS float* CMX = (LAS float*)(L + XCH_OFF + 8192); \
        for (int blk = bx; blk < NIN / 32; blk += G) { \
            const int n0 = blk * 32, cg = lane & 7, rr = lane >> 3; \
            const float* wb = args.in[2] + (size_t)(256 * wave + 2 * rr) * NIN + n0 + 4 * cg; \
            f32x4 mx = {0.f, 0.f, 0.f, 0.f}; \
            _Pragma("unroll 1") for (int i0 = 0; i0 < 16; i0 += 4) { \
                f32x4 ra[4], rb[4]; \
                _Pragma("unroll") for (int i = 0; i < 4; ++i) { ra[i] = *(const f32x4*)(wb + (size_t)(16 * (i0 + i)) * NIN); rb[i] = *(const f32x4*)(wb + (size_t)(16 * (i0 + i) + 1) * NIN); } \
                _Pragma("unroll") for (int i = 0; i < 4; ++i) { const int kd = 128 * wave + 8 * (i0 + i) + rr; \
                    _Pragma("unroll") for (int e = 0; e < 4; ++e) { mx[e] = fmaxf(mx[e], fmaxf(fabsf(ra[i][e]), fabsf(rb[i][e]))); \
                        IMG[(4 * cg + e) * 1024 + (kd ^ (cg << 3))] = pg8::cvt_pk_bf16(ra[i][e], rb[i][e]); } } \
            } \
            _Pragma("unroll") for (int e = 0; e < 4; ++e) { mx[e] = fmaxf(mx[e], __shfl_xor(mx[e], 8)); mx[e] = fmaxf(mx[e], __shfl_xor(mx[e], 16)); mx[e] = fmaxf(mx[e], __shfl_xor(mx[e], 32)); } \
            if (rr == 0) { _Pragma("unroll") for (int e = 0; e < 4; ++e) CMX[wave * 32 + 4 * cg + e] = mx[e]; } \
            LDS_WAIT(); __syncthreads(); \
            _Pragma("unroll 1") for (int cc = 0; cc < 4; ++cc) { const int c = 4 * wave + cc, src = n0 + c, dst = map_head(src); \
                float cm = 0.f; _Pragma("unroll") for (int w8 = 0; w8 < 8; ++w8) cm = fmaxf(cm, CMX[w8 * 32 + c]); \
                cm = __uint_as_float(((unsigned)pg8::cvt_pk_bf16(cm, cm)) << 16); \
                const float inv = cm > 0.f ? 127.f / cm : 0.f; \
                if (lane == 0) CSC[dst] = cm * (1.f / 127.f); \
                signed char* orow = (signed char*)Win8_t + (size_t)dst * DM; \
                _Pragma("unroll") for (int g2 = 0; g2 < 2; ++g2) { const int g8 = lane + 64 * g2; \
                    const LAS u32x4* ip = (const LAS u32x4*)(IMG + c * 1024 + ((g8 ^ wave) << 3)); const u32x4 p0 = ip[0], p1 = ip[1]; u32x4 o; \
                    _Pragma("unroll") for (int d = 0; d < 4; ++d) { const unsigned wa = d < 2 ? p0[2 * d] : p1[2 * d - 4], wb2 = d < 2 ? p0[2 * d + 1] : p1[2 * d - 3]; \
                        const int q0 = (int)rintf(__uint_as_float(wa << 16) * inv), q1 = (int)rintf(__uint_as_float(wa & 0xffff0000u) * inv), q2 = (int)rintf(__uint_as_float(wb2 << 16) * inv), q3 = (int)rintf(__uint_as_float(wb2 & 0xffff0000u) * inv); \
                        o[d] = (unsigned)(q0 & 255) | ((unsigned)(q1 & 255) << 8) | ((unsigned)(q2 & 255) << 16) | ((unsigned)(q3 & 255) << 24); } \
                    *(u32x4*)(orow + 16 * g8) = o; } \
            } \
            LDS_WAIT(); __syncthreads(); \
        } } while (0)
    if (IN(0)) {
        const int p0part = args.pad;
        unsigned* CMAXU = (unsigned*)(ws + WS_CTL + WS_CMAX);
        if (p0part != 2) {
            P0_WIN_ONEPASS();
            CONVERT_ITEMS(gw, NGW, I_IN, (p1_fillers > 0 ? CV_G1 : CV_ALL));
            if (bx == 0) { const int k = tid >> 7, j = tid & 127; NORMS[tid] = args.in[k == 0 ? 3 : k == 1 ? 4 : k == 2 ? 6 : 7][j]; }
            const float* g = args.in[1];
            for (int m = gw; m < M; m += NGW) {
                const f32x4* xr = (const f32x4*)(x + (size_t)m * DM) + lane;
                f32x4 v[8]; float s = 0.f;
#pragma unroll
                for (int j = 0; j < 8; ++j) { v[j] = xr[64 * j]; s += (v[j].x * v[j].x + v[j].y * v[j].y) + (v[j].z * v[j].z + v[j].w * v[j].w); }
                const float rs = rsqrtf(wave_sum(s) * (1.f / DM) + EPS);
                float amax = 0.f;
#pragma unroll
                for (int j = 0; j < 8; ++j) { const f32x4 gv = ((const f32x4*)g)[lane + 64 * j]; v[j] = v[j] * rs * gv;
                    amax = fmaxf(amax, fmaxf(fmaxf(fabsf(v[j].x), fabsf(v[j].y)), fmaxf(fabsf(v[j].z), fabsf(v[j].w)))); }
                amax = wave_max(amax);
                const float inv = amax > 0.f ? 127.f / amax : 0.f;
#pragma unroll
                for (int j = 0; j < 8; ++j) { const int q0 = (int)rintf(v[j].x * inv), q1 = (int)rintf(v[j].y * inv), q2 = (int)rintf(v[j].z * inv), q3 = (int)rintf(v[j].w * inv);
                    ((unsigned*)(XN8 + (size_t)m * DM))[lane + 64 * j] = (unsigned)(q0 & 255) | ((unsigned)(q1 & 255) << 8) | ((unsigned)(q2 & 255) << 16) | ((unsigned)(q3 & 255) << 24); }
                if (lane == 0) RS1[m] = amax * (1.f / 127.f);
            }
            for (int idx = vcu * (NWAVES * 64) + tid; idx < SEQ * 64; idx += G * NWAVES * 64) {
                const int pos = idx >> 6, j = idx & 63;
                const double inv = exp2(-(double)j * (1.0 / 64.0) * 13.287712379549449);
                const double ang = (double)pos * inv;
                const double TWO_PI = 6.283185307179586476925286766559;
                const double k = rint(ang / TWO_PI);
                const float r = (float)(ang - k * TWO_PI);
                rope[idx] = cosf(r); rope[SEQ * 64 + idx] = sinf(r);
            }
        }
    }
    SEAM(0);
    if (IN(1)) {
        pg8::Gemm g{(const bf16_t*)XN8, (const bf16_t*)Win8_t, (const bf16_t*)XN8, (const bf16_t*)Win8_t, M, NIN, DM / 2, DBGP(1)};     pg8::StaticOrderT<M / 256, NIN / 256> S; S.init(G, bx, XCD_ROT1(bx));
        int pm0 = -1; { pg8::Unit u0; if (S.next(0, u0)) pm0 = u0.pm; }
        { LAS float* T = (LAS float*)(L + XCH_OFF);
          if (pm0 >= 0 && tid < 256) T[1024 + tid] = RS1[pm0 * 256 + tid];
          T[1280 + tid] = NORMS[tid];
          pg8::Unit uu; for (int i = 0; i < 9 && S.next(i, uu); ++i) if (tid < 256) T[1792 + i * 256 + tid] = CSC[uu.pn * 256 + tid];
          LDS_WAIT(); __syncthreads(); }
        pg8::EpiProj E{QKV, Gt, NORMS, rope, RS1, CSC, pm0};
#ifndef P1_EREP
#define P1_EREP 1
#endif
#ifndef P1_KREP
#define P1_KREP 1
#endif
        pg8::gemm_phase<P1_EREP, P1_KREP, true>(L + RING_OFF, L + XCH_OFF, g, S, E);
        if (p1_fillers > 0 && bx >= p1_last) CONVERT_ITEMS((bx - p1_last) * NWAVES + wave, p1_fillers * NWAVES, CV_G1, CV_ALL);
    }
    SEAM(1);
    const bool modeL = XCD_LOCAL && (hi - lo > 1) && lo <= 1 && G == 256 && MISC[8 + 3] == 1u;
    const int xr = (int)MISC[8 + 2], xx = (int)bar.x, cL = modeL ? xr * 8 + xx : bx;
    if (IN(2)) {
#if defined(ATTN_VALU) && ATTN_VALU
        LAS float* scr = (LAS float*)(L + RING_OFF + wave * 2048);
        for (int it = gw; it < M * 8; it += NGW) attn_a_item(QKV, args.in[5], OA, it, scr, lane);
        for (int it = gw; it < M * 8; it += NGW) attn_b_item(QKV, args.in[8], OB, it, scr, lane);
#else
        static_assert(att::ATT_LDS <= RING_BYTES, "attention LDS");
#ifndef ATT_B16
#define ATT_B16 1
#endif
#if ATT_B16
#define ATT_UNIT_B att::unit_b16
#else
#define ATT_UNIT_B att::unit_b
#endif
#ifndef ATT_REP_A
#define ATT_REP_A 1
#endif
#ifndef ATT_REP_B
#define ATT_REP_B 1
#endif
        const float cqa = att::qk_bound_l2(args.in[3], args.in[4], lane), cqb = att::qk_bound_l2(args.in[6], args.in[7], lane);
#if defined(ATT_PRIO) && ATT_PRIO
        if (wave >= 4) __builtin_amdgcn_s_setprio(1);
#endif
        if (modeL) {
            for (int rep = 0; rep < ATT_REP_A; ++rep)
            for (int j = 0; j < 2; ++j) { const int i = xr + 32 * j, ua = (xx >> 1) * 128 + (i >> 5) * 64 + 32 * (xx & 1) + (i & 31);
                att::unit_a((LAS char*)(L + RING_OFF), QKV, args.in[5], cqa, OA, ua, tid, wave, lane); }
            if (!(xr & 1)) { for (int rep = 0; rep < ATT_REP_B; ++rep) for (int j = 0; j < 2; ++j) { const int idx = (xr >> 1) + 16 * j, ub = (xx >> 1) * 128 + (idx >> 2) * 16 + (4 * (xx & 1) + (idx & 3)) * 2;
                ATT_UNIT_B<0>((LAS char*)(L + RING_OFF), QKV, args.in[8], cqb, OB, ub, tid, wave, lane); } }
            else { for (int j = 0; j < 2; ++j) { const int idx = (xr >> 1) + 16 * j, ub = (xx >> 1) * 128 + (idx >> 2) * 16 + (4 * (xx & 1) + (idx & 3)) * 2 + 1;
                ATT_UNIT_B<1>((LAS char*)(L + RING_OFF), QKV, args.in[8], cqb, OB, ub, tid, wave, lane); } }
        } else {
        for (int rep = 0; rep < ATT_REP_A; ++rep)
        for (int ua = vcu; ua < 512; ua += G) att::unit_a((LAS char*)(L + RING_OFF), QKV, args.in[5], cqa, OA, ua, tid, wave, lane);
        for (int rep = 0; rep < ATT_REP_B; ++rep)
        for (int ub = vcu; ub < 512; ub += G) if (!(ub & 1)) ATT_UNIT_B<0>((LAS char*)(L + RING_OFF), QKV, args.in[8], cqb, OB, ub, tid, wave, lane);
        for (int ub = vcu; ub < 512; ub += G) if (ub & 1) ATT_UNIT_B<1>((LAS char*)(L + RING_OFF), QKV, args.in[8], cqb, OB, ub, tid, wave, lane);
        }
#if defined(ATT_PRIO) && ATT_PRIO
        __builtin_amdgcn_s_setprio(0);
#endif
#endif
    }
    SEAML(2);
    if (IN(3)) {
        pg8::Gemm g{OA, Wa_t, OB, Wb_t, M, DM, 1024, DBGP(3)}; pg8::StaticOrderT<M / 256, DM / 256, 1> S; S.init(G, cL, XCD_ROT(cL));
        pg8::EpiBranch E{MG, Gt};
        pg8::gemm_phase(L + RING_OFF, L + XCH_OFF, g, S, E);
    }
    SEAML(3);
    if (IN(4)) {
        pg8::Gemm g{MG, Wo_t, MG, Wo_t, M, DM, DM, DBGP(4)}; pg8::StaticOrderT<M / 256, DM / 256> S; S.init(G, cL, XCD_ROT(cL));
        pg8::EpiOut E{x, out, X1B, SSQ};
        pg8::gemm_phase(L + RING_OFF, L + XCH_OFF, g, S, E);
    }
    SEAML(4);
    if (IN(5)) {
        pg8::Gemm g{X1B, Wup_t, X1B, Wup_t, M, NUP, DM, DBGP(5)}; pg8::StaticOrderT<M / 256, NUP / 256> S; S.init(G, cL, XCD_ROT(cL));
        int pm0 = -1; { pg8::Unit u0; if (S.next(0, u0)) pm0 = u0.pm; }
        if (pm0 >= 0 && tid < 256) { const float* sp = SSQ + (size_t)(pm0 * 256 + tid) * 8; const f32x4 a = *(const f32x4*)sp, b = *(const f32x4*)(sp + 4);
            ((LAS float*)(L + XCH_OFF + 12288))[tid] = __builtin_amdgcn_rsqf(((a[0] + a[1]) + (a[2] + a[3]) + (b[0] + b[1]) + (b[2] + b[3])) * (1.f / DM) + EPS); }
        LDS_WAIT(); __syncthreads();
        pg8::EpiUp E{ACT, HALO, SSQ, args.in[14], args.in[15], pm0};
        pg8::gemm_phase<1, 1, false, true>(L + RING_OFF, L + XCH_OFF, g, S, E);
    }
    do { if (IN(5) && IN(7)) xcd_barrier(bar); } while (0);
    if (IN(7)) {
        pg8::Gemm g{ACT, Wdn_t, ACT, Wdn_t, M, DM, DFF, DBGP(7)}; pg8::StaticOrderT<M / 256, DM / 256> S; S.init(G, cL, XCD_ROT(cL));
        { const float* cw = args.in[14]; const float* cb = args.in[15]; pg8::Unit uu; int pm_done = -1;
          for (int i = 0; S.next(i, uu); ++i) { if (uu.pm == pm_done) continue; pm_done = uu.pm; const int pm = uu.pm;
            for (int idx = tid; idx < 2 * (DFF / 4); idx += NWAVES * 64) {
                const int side = idx / (DFF / 4), j = (idx % (DFF / 4)) * 4;
                const int row = pm * 256 + (side ? 255 : 0);
                const float* hc = HALO + (size_t)(pm * 4 + (side ? 3 : 0)) * NUP;
                const float* hp = side ? HALO + (size_t)(pm * 4 + 2) * NUP : ((pm & 15) == 0 ? nullptr : HALO + (size_t)((pm - 1) * 4 + 3) * NUP);
                const float* hn = side ? ((pm & 15) == 15 ? nullptr : HALO + (size_t)((pm + 1) * 4 + 0) * NUP) : HALO + (size_t)(pm * 4 + 1) * NUP;
                f32x4 o[2];
#pragma unroll
                for (int bj = 0; bj < 2; ++bj) {
                    const int c = bj * DFF + j;
                    f32x4 a = *(const f32x4*)(cb + c) + *(const f32x4*)(cw + NUP + c) * *(const f32x4*)(hc + c);
                    if (hp) a += *(const f32x4*)(cw + c) * *(const f32x4*)(hp + c);
                    if (hn) a += *(const f32x4*)(cw + 2 * NUP + c) * *(const f32x4*)(hn + c);
                    o[bj] = a;
                }
                u32x2 w; float r[4];
#pragma unroll
                for (int e = 0; e < 4; ++e) r[e] = o[0][e] / (1.f + __expf(-o[0][e])) * o[1][e];
                w.x = pk2(r[0], r[1]); w.y = pk2(r[2], r[3]);
                *(u32x2*)(ACT + (size_t)row * DFF + j) = w;
            } }
          asm volatile("s_waitcnt vmcnt(0)" ::: "memory"); __syncthreads(); }
        pg8::EpiDown E{out, X1B};
        pg8::gemm_phase(L + RING_OFF, L + XCH_OFF, g, S, E);
    }
#if defined(DBGT) && DBGT
    if (hi - lo > 1) {
        xcd_barrier(bar);
        if (bx == DBG_BLK && tid == 0) {
            const unsigned* d = dbgbase + DBG_PH * 64; int n = 0; while (n < 16 && d[n * 4 + 3] != 0u) ++n;
            float sk = 0.f, sa = 0.f, se = 0.f, sg = 0.f;
            for (int i = 0; i < n; ++i) { sk += (float)(d[i * 4 + 1] - d[i * 4 + 0]); sa += (float)(d[i * 4 + 2] - d[i * 4 + 1]); se += (float)(d[i * 4 + 3] - d[i * 4 + 2]); if (i + 1 < n) sg += (float)(d[i * 4 + 4] - d[i * 4 + 3]); }
            const float tot = (float)(d[(n - 1) * 4 + 3] - d[0]);
            float val = DBG_METRIC == 0 ? sk / n : DBG_METRIC == 1 ? sa / n : DBG_METRIC == 2 ? se / n : DBG_METRIC == 3 ? sg / (n > 1 ? n - 1 : 1) : DBG_METRIC == 4 ? tot * 0.1f : (float)n * 100.f;
            val *= 0.01f;
            out[0] = 100.f * exp2f(val * 0.01f * 3.321928f);
        }
    }
#endif
#undef IN
#undef SEAM
}

#ifndef OPTMASK
#define OPTMASK 31
#endif
#ifndef FUSED
#define FUSED 1
#endif
extern "C" void kernel_launch(void* const* d_in, const int* in_sizes, int n_in, void* d_out, int out_size, void* d_ws, size_t ws_size, hipStream_t stream) {
    if (n_in != 17 || out_size != M * DM || ws_size < WS_END) { fprintf(stderr, "kernel_launch: unexpected shapes (n_in %d out %d ws %zu)\n", n_in, out_size, ws_size); return; }
    static int grid = 0;
    if (grid == 0) {
        int dev = 0, cus = 0, per_cu = 0;
        if (hipGetDevice(&dev) != hipSuccess || hipDeviceGetAttribute(&cus, hipDeviceAttributeMultiprocessorCount, dev) != hipSuccess) { grid = -1; return; }
        if (hipFuncSetAttribute((const void*)mk_fwd, hipFuncAttributeMaxDynamicSharedMemorySize, LDS_BYTES) != hipSuccess) { fprintf(stderr, "kernel_launch: hipFuncSetAttribute failed\n"); grid = -1; return; }
        if (hipOccupancyMaxActiveBlocksPerMultiprocessor(&per_cu, (const void*)mk_fwd, NWAVES * 64, LDS_BYTES) != hipSuccess || per_cu < 1) { fprintf(stderr, "kernel_launch: occupancy query says %d\n", per_cu); }
        (void)hipGetLastError();
        grid = cus;
    }
    if (grid < 0) return;
    const float* x = (const float*)d_in[0]; const float* norm_mix = (const float*)d_in[1]; const float* w_in = (const float*)d_in[2];
    const float* aqn = (const float*)d_in[3]; const float* akn = (const float*)d_in[4]; const float* sink = (const float*)d_in[5];
    const float* bqn = (const float*)d_in[6]; const float* bkn = (const float*)d_in[7]; const float* rpb = (const float*)d_in[8];
    const float* wba = (const float*)d_in[9]; const float* wbb = (const float*)d_in[10]; const float* w_out = (const float*)d_in[11];
    const float* norm_ffn = (const float*)d_in[12]; const float* w_up = (const float*)d_in[13]; const float* conv_w = (const float*)d_in[14];
    const float* conv_b = (const float*)d_in[15]; const float* w_down = (const float*)d_in[16];
    unsigned char* ws = (unsigned char*)d_ws; float* out = (float*)d_out;
    float* rope = (float*)(ws + WS_ROPE);
    bf16_t* QKV = (bf16_t*)(ws + WS_QKV); bf16_t* G = (bf16_t*)(ws + WS_G); bf16_t* MG = (bf16_t*)(ws + WS_MG); bf16_t* ACT = (bf16_t*)(ws + WS_ACT);
    bf16_t* X1B = (bf16_t*)(ws + WS_X1B); bf16_t* UCH = (bf16_t*)(ws + WS_UCH);
    bf16_t* XN = (bf16_t*)d_out; bf16_t* OA = (bf16_t*)((unsigned char*)d_out + 64 * MiB); bf16_t* OB = (bf16_t*)((unsigned char*)d_out + 96 * MiB);
    (void)hipMemsetAsync(ws + WS_CTL, 0, WS_CTL_ZERO, stream);
    Args a{};
    for (int i = 0; i < 17; ++i) a.in[i] = (const float*)d_in[i];
    a.out = out; a.ws = ws;
    int li = 0;
#ifndef DUP
#define DUP -1
#endif
#define MK(lo_, hi_) do { for (int rep_ = 0; rep_ < (((lo_) == DUP && (hi_) == DUP + 1) ? 2 : 1); ++rep_) { a.ph_lo = (lo_); a.ph_hi = (hi_); a.li = li++; hipLaunchKernelGGL(mk_fwd, dim3(grid), dim3(NWAVES * 64), LDS_BYTES, stream, a); } } while (0)
    if (FUSED && OPTMASK == 31) { MK(0, N_PHASES); return; }
    if (OPTMASK & 1) { a.pad = 1; MK(0, 1); a.pad = 2; MK(0, 1); a.pad = 0; MK(1, 2);
#if defined(PROBE) && PROBE == 1
        { nv::NEpi e = nv::mk_epi(0, QKV, NQKV, nullptr, 0, nullptr, nullptr, 0); nv::k_ngemm<<<4096, 256, 0, stream>>>(XN, DM, w_in, NIN, M, NQKV, DM, e); }
        nv::k_proj_post<<<2048, 256, 0, stream>>>(QKV, G, aqn, akn, bqn, bkn, rope, 1, 0);
#elif defined(PROBE) && PROBE == 2
        { nv::NEpi e = nv::mk_epi(0, G, NGATE, nullptr, 0, nullptr, nullptr, 0); nv::k_ngemm<<<4096, 256, 0, stream>>>(XN, DM, w_in + NQKV, NIN, M, NGATE, DM, e); }
        nv::k_proj_post<<<2048, 256, 0, stream>>>(QKV, G, aqn, akn, bqn, bkn, rope, 0, 1);
#endif
    }
    else {
        if (OPTMASK) { a.pad = 1; MK(0, 1); a.pad = 2; MK(0, 1); a.pad = 0; }
        nv::k_rope_table<<<SEQ * 64 / 256, 256, 0, stream>>>(rope);
        nv::k_rmsnorm_rows<<<2048, 256, 0, stream>>>(x, norm_mix, XN, M);
        { nv::NEpi e = nv::mk_epi(0, QKV, NQKV, nullptr, 0, nullptr, nullptr, 0); nv::k_ngemm<<<4096, 256, 0, stream>>>(XN, DM, w_in, NIN, M, NQKV, DM, e); }
        { nv::NEpi e = nv::mk_epi(0, G, NGATE, nullptr, 0, nullptr, nullptr, 0); nv::k_ngemm<<<4096, 256, 0, stream>>>(XN, DM, w_in + NQKV, NIN, M, NGATE, DM, e); }
        nv::k_proj_post<<<2048, 256, 0, stream>>>(QKV, G, aqn, akn, bqn, bkn, rope, 1, 1);
    }
    if (OPTMASK & 2) MK(2, 3);
    else { nv::k_attn_a<<<4096, 256, 0, stream>>>(QKV, sink, OA); nv::k_attn_b<<<4096, 256, 0, stream>>>(QKV, rpb, OB); }
    if (OPTMASK & 4) MK(3, 4);
    else {
        { nv::NEpi e = nv::mk_epi(1, MG, DM, G, NGATE, nullptr, nullptr, 0); nv::k_ngemm<<<4096, 256, 0, stream>>>(OA, 1024, wba, DM, M, DM, 1024, e); }
        { nv::NEpi e = nv::mk_epi(2, MG, DM, G + 2048, NGATE, nullptr, nullptr, 0); nv::k_ngemm<<<4096, 256, 0, stream>>>(OB, 1024, wbb, DM, M, DM, 1024, e); }
    }
    if (OPTMASK & 8) { MK(4, 5); MK(5, 6); MK(6, 7); }
    else {
        { nv::NEpi e = nv::mk_epi(3, nullptr, 0, nullptr, 0, x, out, DM); nv::k_ngemm<<<4096, 256, 0, stream>>>(MG, DM, w_out, DM, M, DM, DM, e); }
        nv::k_rmsnorm_rows<<<2048, 256, 0, stream>>>(out, norm_ffn, X1B, M);
        for (int b = 0; b < BATCH; ++b) {
            nv::NEpi e = nv::mk_epi(0, UCH, NUP, nullptr, 0, nullptr, nullptr, 0);
            nv::k_ngemm<<<4096, 256, 0, stream>>>(X1B + (size_t)b * SEQ * DM, DM, w_up, NUP, SEQ, NUP, DM, e);
            nv::k_conv_glu<<<4096, 256, 0, stream>>>(UCH, conv_w, conv_b, ACT + (size_t)b * SEQ * DFF);
        }
    }
    if (OPTMASK & 16) MK(7, 8);
    else { nv::NEpi e = nv::mk_epi(3, nullptr, 0, nullptr, 0, out, out, DM); nv::k_ngemm<<<4096, 256, 0, stream>>>(ACT, DFF, w_down, DM, M, DM, DFF, e); }
#undef MK
}
```
